# Optimizing an MI355X kernel written in HIP

```python
import jax, jax.numpy as jnp
from jax import lax
import numpy as np

D_MODEL = 1024
BATCH = 32
SEQ = 2048
DEPTH = 1

HEAD_DIM = 64
ATTN_HEADS = 8
ATTN_KV_HEADS = 2
ATTN_GROUP = ATTN_HEADS // ATTN_KV_HEADS
ATTN_DIM = ATTN_HEADS * HEAD_DIM
KV_DIM = ATTN_KV_HEADS * HEAD_DIM
WINDOW = 128
BLOCK = WINDOW
ROPE_THETA = 10000.0

RWKV_HEADS = 8
RWKV_HEAD = 64
RWKV_DIM = RWKV_HEADS * RWKV_HEAD
DECAY_LORA = 64
ICLR_LORA = 64
GATE_LORA = 160
RWKV_GN_EPS = 64e-5
RWKV_IN = 3 * RWKV_DIM + DECAY_LORA + ICLR_LORA + GATE_LORA

IN_COLS = ATTN_DIM + 2 * KV_DIM + RWKV_IN + 2 * D_MODEL

PEER_HEADS = 8
N_KEYS = 128
N_EXPERTS = N_KEYS * N_KEYS
PEER_QDIM = 128
PEER_HALF = PEER_QDIM // 2
PEER_TOPK = 16
PEER_SEL = PEER_HEADS * PEER_TOPK
PEER_CHUNK = 128

NORM_EPS = 1e-5
NEG_INF = -1e30

kernel_name = 'hybrid_swa_rwkv7_peer_block'


def rms_norm(x, w):
    xf = x.astype(jnp.float32)
    y = xf * lax.rsqrt(jnp.mean(xf * xf, axis=-1, keepdims=True) + NORM_EPS)
    return (y * w.astype(jnp.float32)).astype(x.dtype)


def rope(x, pos):
    inv = ROPE_THETA ** (-jnp.arange(0, HEAD_DIM, 2, dtype=jnp.float32) / HEAD_DIM)
    ang = pos.astype(jnp.float32)[:, None] * inv[None, :]
    cos = jnp.cos(ang)[None, :, None, :]
    sin = jnp.sin(ang)[None, :, None, :]
    x1, x2 = jnp.split(x, 2, axis=-1)
    return jnp.concatenate([x1 * cos - x2 * sin, x2 * cos + x1 * sin], axis=-1)


def prev_block(t):
    return jnp.concatenate([jnp.zeros_like(t[:, :1]), t[:, :-1]], axis=1)


def sliding_window_attention(q, k, v, sinks):
    b, s = q.shape[0], q.shape[1]
    nb = s // BLOCK
    qb = q.reshape(b, nb, BLOCK, ATTN_KV_HEADS, ATTN_GROUP, HEAD_DIM)
    kb = k.reshape(b, nb, BLOCK, ATTN_KV_HEADS, HEAD_DIM)
    vb = v.reshape(b, nb, BLOCK, ATTN_KV_HEADS, HEAD_DIM)
    kb = jnp.concatenate([prev_block(kb), kb], axis=2)
    vb = jnp.concatenate([prev_block(vb), vb], axis=2)
    logits = jnp.einsum('bnqhgd,bnkhd->bnhgqk', qb, kb) * (HEAD_DIM ** -0.5)
    qi = jnp.arange(BLOCK)[:, None] + BLOCK
    kj = jnp.arange(2 * BLOCK)[None, :]
    diff = qi - kj
    band = (diff >= 0) & (diff < WINDOW)
    valid = (jnp.arange(nb)[:, None] * BLOCK + kj - BLOCK) >= 0
    mask = band[None] & valid[:, None, :]
    logits = jnp.where(mask[None, :, None, None], logits, NEG_INF)
    sink = sinks.astype(jnp.float32).reshape(ATTN_KV_HEADS, ATTN_GROUP)[None, None, :, :, None, None]
    m = jnp.maximum(jnp.max(logits, axis=-1, keepdims=True), sink)
    p = jnp.exp(logits - m)
    probs = p / (jnp.sum(p, axis=-1, keepdims=True) + jnp.exp(sink - m))
    out = jnp.einsum('bnhgqk,bnkhd->bnqhgd', probs, vb)
    return out.reshape(b, s, ATTN_DIM)


def token_shift(z, mu):
    z_prev = jnp.concatenate([jnp.zeros_like(z[:, :1]), z[:, :-1]], axis=1)
    return z + mu * (z_prev - z)


def to_heads(t):
    return t.reshape(t.shape[0], t.shape[1], RWKV_HEADS, RWKV_HEAD)


def rwkv7_time_mix(zr, w0, w2, a0, a2, g2, k_k, k_a, r_k, ln_w, ln_b):
    f32 = jnp.float32
    b, s = zr.shape[0], zr.shape[1]
    cuts = [RWKV_DIM, 2 * RWKV_DIM, 3 * RWKV_DIM, 3 * RWKV_DIM + DECAY_LORA,
            3 * RWKV_DIM + DECAY_LORA + ICLR_LORA]
    r, k, v, w_lo, a_lo, g_lo = jnp.split(zr, cuts, axis=-1)
    r, k, v = r.astype(f32), k.astype(f32), v.astype(f32)
    w = -jax.nn.softplus(-(w0 + jnp.tanh(w_lo) @ w2).astype(f32)) - 0.5
    decay = jnp.exp(-jnp.exp(w))
    a = jax.nn.sigmoid((a0 + a_lo @ a2).astype(f32))
    g = (jax.nn.sigmoid(g_lo) @ g2).astype(f32)
    kk = to_heads(k * k_k.astype(f32))
    kk = kk / jnp.maximum(jnp.sqrt(jnp.sum(kk * kk, axis=-1, keepdims=True)), 1e-12)
    k = k * (1.0 + (a - 1.0) * k_a.astype(f32))
    rh, kh, vh, wh, ah = to_heads(r), to_heads(k), to_heads(v), to_heads(decay), to_heads(a)

    def step(state, inp):
        r_t, w_t, k_t, v_t, kk_t, a_t = inp
        sa = jnp.einsum('bhvk,bhk->bhv', state, -kk_t)
        state = (state * w_t[:, :, None, :]
                 + sa[..., None] * (kk_t * a_t)[:, :, None, :]
                 + v_t[..., None] * k_t[:, :, None, :])
        return state, jnp.einsum('bhvk,bhk->bhv', state, r_t)

    tm = lambda t: jnp.swapaxes(t, 0, 1)
    state0 = jnp.zeros((b, RWKV_HEADS, RWKV_HEAD, RWKV_HEAD), f32)
    _, y = lax.scan(step, state0, (tm(rh), tm(wh), tm(kh), tm(vh), tm(kk), tm(ah)))
    y = tm(y)
    mean = jnp.mean(y, axis=-1, keepdims=True)
    var = jnp.mean(jnp.square(y - mean), axis=-1, keepdims=True)
    y = ((y - mean) * lax.rsqrt(var + RWKV_GN_EPS)).reshape(b, s, RWKV_DIM)
    y = y * ln_w.astype(f32) + ln_b.astype(f32)
    bonus = jnp.sum(rh * kh * r_k.astype(f32), axis=-1, keepdims=True) * vh
    y = y + bonus.reshape(b, s, RWKV_DIM)
    return (y * g).astype(zr.dtype)


def peer_ffn(xn, wq, subkeys, u_tab, v_tab):
    f32 = jnp.float32
    b, s, d = xn.shape
    t = b * s
    xt = xn.reshape(t, d)
    q = (xt @ wq).reshape(t, PEER_HEADS, 2, PEER_HALF)
    sc = jnp.einsum('thpd,hpnd->thpn', q, subkeys).astype(f32)
    s1, i1 = lax.top_k(sc[:, :, 0], PEER_TOPK)
    s2, i2 = lax.top_k(sc[:, :, 1], PEER_TOPK)
    cand = (s1[..., :, None] + s2[..., None, :]).reshape(t, PEER_HEADS, PEER_TOPK * PEER_TOPK)
    cidx = (i1[..., :, None] * N_KEYS + i2[..., None, :]).reshape(t, PEER_HEADS, PEER_TOPK * PEER_TOPK)
    top, pos = lax.top_k(cand, PEER_TOPK)
    idx = jnp.take_along_axis(cidx, pos, axis=-1)
    gate = jax.nn.softmax(top, axis=-1)
    nc = t // PEER_CHUNK

    def expert_block(args):
        xc, ic, gc = args
        hpre = jnp.einsum('ckd,cd->ck', u_tab[ic], xc).astype(f32)
        act = jax.nn.gelu(hpre, approximate=False) * gc
        return jnp.einsum('ck,ckd->cd', act.astype(v_tab.dtype), v_tab[ic])

    out = lax.map(expert_block, (xt.reshape(nc, PEER_CHUNK, d),
                                 idx.reshape(nc, PEER_CHUNK, PEER_SEL),
                                 gate.reshape(nc, PEER_CHUNK, PEER_SEL)))
    return out.reshape(b, s, d).astype(xn.dtype)


def setup_inputs(seed: int = 0) -> dict:
    key = jax.random.key(seed)
    ks = jax.random.split(key, 24)
    L = DEPTH
    f32 = jnp.float32
    nrm = lambda k, shape, scale: jax.random.normal(k, shape, f32) * scale
    return {
        'x': nrm(ks[0], (BATCH, SEQ, D_MODEL), 1.0),
        'norm_mix_w': 1.0 + nrm(ks[1], (L, D_MODEL), 0.02),
        'w_in': nrm(ks[2], (L, D_MODEL, IN_COLS), D_MODEL ** -0.5),
        'shift_mu': jax.random.uniform(ks[3], (L, RWKV_IN), f32),
        'attn_sinks': nrm(ks[4], (L, ATTN_HEADS), 0.5),
        'decay_w0': -1.0 + nrm(ks[5], (L, RWKV_DIM), 0.5),
        'decay_w2': nrm(ks[6], (L, DECAY_LORA, RWKV_DIM), 0.1 * DECAY_LORA ** -0.5),
        'iclr_a0': nrm(ks[7], (L, RWKV_DIM), 0.1),
        'iclr_a2': nrm(ks[8], (L, ICLR_LORA, RWKV_DIM), 0.5 * ICLR_LORA ** -0.5),
        'gate_g2': nrm(ks[9], (L, GATE_LORA, RWKV_DIM), GATE_LORA ** -0.5),
        'k_k': 0.85 + nrm(ks[10], (L, RWKV_DIM), 0.02),
        'k_a': 1.0 + nrm(ks[11], (L, RWKV_DIM), 0.02),
        'r_k': nrm(ks[12], (L, RWKV_HEADS, RWKV_HEAD), 0.1),
        'ln_x_w': 1.0 + nrm(ks[13], (L, RWKV_DIM), 0.02),
        'ln_x_b': nrm(ks[14], (L, RWKV_DIM), 0.02),
        'proj_attn': nrm(ks[15], (L, ATTN_DIM, D_MODEL), ATTN_DIM ** -0.5),
        'proj_rwkv': nrm(ks[16], (L, RWKV_DIM, D_MODEL), RWKV_DIM ** -0.5),
        'w_out': nrm(ks[17], (L, D_MODEL, D_MODEL), D_MODEL ** -0.5),
        'norm_ffn_w': 1.0 + nrm(ks[18], (L, D_MODEL), 0.02),
        'peer_wq': nrm(ks[19], (L, D_MODEL, PEER_HEADS * PEER_QDIM), D_MODEL ** -0.5),
        'peer_subkeys': nrm(ks[20], (L, PEER_HEADS, 2, N_KEYS, PEER_HALF), PEER_HALF ** -0.5),
        'peer_u': nrm(ks[21], (L, N_EXPERTS, D_MODEL), D_MODEL ** -0.5),
        'peer_v': nrm(ks[22], (L, N_EXPERTS, D_MODEL), PEER_HEADS ** -0.5),
        'norm_final_w': 1.0 + nrm(ks[23], (D_MODEL,), 0.02),
    }


def reference(x, norm_mix_w, w_in, shift_mu, attn_sinks, decay_w0, decay_w2, iclr_a0, iclr_a2,
              gate_g2, k_k, k_a, r_k, ln_x_w, ln_x_b, proj_attn, proj_rwkv, w_out, norm_ffn_w,
              peer_wq, peer_subkeys, peer_u, peer_v, norm_final_w):
    f32 = jnp.float32
    b, s = x.shape[0], x.shape[1]
    pos = jnp.arange(s, dtype=jnp.int32)
    o1 = ATTN_DIM
    o2 = o1 + KV_DIM
    o3 = o2 + KV_DIM
    o4 = o3 + RWKV_IN
    o5 = o4 + D_MODEL
    h = x
    for l in range(DEPTH):
        xn = rms_norm(h, norm_mix_w[l])
        z = xn @ w_in[l]
        q = rope(z[..., :o1].reshape(b, s, ATTN_HEADS, HEAD_DIM).astype(f32), pos)
        k = rope(z[..., o1:o2].reshape(b, s, ATTN_KV_HEADS, HEAD_DIM).astype(f32), pos)
        v = z[..., o2:o3].reshape(b, s, ATTN_KV_HEADS, HEAD_DIM).astype(f32)
        y_attn = sliding_window_attention(q, k, v, attn_sinks[l]).astype(h.dtype)
        zr = token_shift(z[..., o3:o4], shift_mu[l])
        y_rwkv = rwkv7_time_mix(zr, decay_w0[l], decay_w2[l], iclr_a0[l], iclr_a2[l], gate_g2[l],
                                k_k[l], k_a[l], r_k[l], ln_x_w[l], ln_x_b[l]).astype(h.dtype)
        g_attn = jax.nn.sigmoid(z[..., o4:o5])
        g_rwkv = jax.nn.sigmoid(z[..., o5:])
        merged = g_attn * (y_attn @ proj_attn[l]) + g_rwkv * (y_rwkv @ proj_rwkv[l])
        h = h + merged @ w_out[l]
        h = h + peer_ffn(rms_norm(h, norm_ffn_w[l]), peer_wq[l], peer_subkeys[l], peer_u[l], peer_v[l])
    return rms_norm(h, norm_final_w)
```

```cpp
#include <hip/hip_runtime.h>
#include <cstdio>
#include <cstdint>
namespace pg8 {
#define PG8_LAS __attribute__((address_space(3)))
typedef unsigned short bf16_t;
typedef short bf16x8 __attribute__((ext_vector_type(8)));
typedef float f32x4 __attribute__((ext_vector_type(4)));
typedef unsigned u32x4 __attribute__((ext_vector_type(4)));
constexpr int BM = 256, BK = 64, HALF = 128, HTB = HALF * BK * 2  , STAGE_BYTES = 8 * HTB, NXCD = 8, WGM = 8;

__host__ __device__ __forceinline__ int lds_byte(int r, int c) { const int st = (r >> 4) * 2 + (c >> 5), rr = r & 15, cc = c & 31, ob = rr * 64 + cc * 2; return st * 1024 + (ob ^ (((ob >> 9) & 1) << 5)); }
__host__ __device__ __forceinline__ void stage_rc(int b, int& R, int& C) { const int st = b / 1024, sb = b % 1024, swz = sb ^ (((sb >> 9) & 1) << 5); R = (st >> 1) * 16 + swz / 64; C = (st & 1) * 32 + (swz % 64) / 2; }
__host__ __device__ __forceinline__ int perm32(int rho) { const int n = rho >> 4, i = rho & 15; return 8 * (i >> 2) + 4 * n + (i & 3); }

struct Unit { int pm, pn; };
struct Gemm { const bf16_t* A; const bf16_t* Bt; int M, N, K; };

struct StaticOrder {
    int nM, nN, nwg, G, c;
    __host__ __device__ void init(int M, int N, int G_, int c_) { nM = M / BM; nN = N / BM; nwg = nM * nN; G = G_; c = c_; }
    __host__ __device__ bool next(int i, Unit& u) const {
        const long L = (long)i * G + c; if (L >= nwg) return false;
        int wgid = (int)L; { const int q = nwg / NXCD, r = nwg % NXCD, xcd = wgid % NXCD, off = wgid / NXCD; wgid = (xcd < r ? xcd * (q + 1) : r * (q + 1) + (xcd - r) * q) + off; }
        const int nig = WGM * nN, gid = wgid / nig, fm = gid * WGM, gsz = (nM - fm) < WGM ? (nM - fm) : WGM;
        u.pm = fm + ((wgid % nig) % gsz); u.pn = (wgid % nig) / gsz; return true;
    }
    __device__ __forceinline__ void a_ready(const Unit&) const {}
    __device__ __forceinline__ void done(const Unit&) const {}
};

__device__ __forceinline__ unsigned cvt_pk_bf16(float lo, float hi) { unsigned r; asm volatile("v_cvt_pk_bf16_f32 %0, %1, %2" : "=v"(r) : "v"(lo), "v"(hi)); return r; }
typedef float f32x2 __attribute__((ext_vector_type(2)));
__device__ __forceinline__ f32x2 gelu_pk(f32x2 v) {
    const f32x2 av = __builtin_elementwise_abs(v), d = av * 0.2316418882f + 1.0f;
    f32x2 t; t.x = __builtin_amdgcn_rcpf(d.x); t.y = __builtin_amdgcn_rcpf(d.y);
    f32x2 q = t * 0.5307027145f + (-0.7265760135f); q = q * t + 0.7107068705f; q = q * t + (-0.142248368f); q = q * t + 0.127414796f; q = q * t;
    const f32x2 s = (v * v) * (-0.72134752044f);
    f32x2 e; e.x = __builtin_amdgcn_exp2f(s.x); e.y = __builtin_amdgcn_exp2f(s.y);
    const f32x2 m = v * (q * e), r = v - m;
    f32x2 o; o.x = v.x < 0.f ? m.x : r.x; o.y = v.y < 0.f ? m.y : r.y; return o;
}

__device__ __forceinline__ float sigm(float x) { return __builtin_amdgcn_rcpf(1.0f + __builtin_amdgcn_exp2f(-1.4426950408889634f * x)); }
__device__ __forceinline__ u32x4 pack8(const f32x4 v0, const f32x4 v1) { u32x4 w; w.x = cvt_pk_bf16(v0[0], v0[1]); w.y = cvt_pk_bf16(v0[2], v0[3]); w.z = cvt_pk_bf16(v1[0], v1[1]); w.w = cvt_pk_bf16(v1[2], v1[3]); return w; }
__device__ __forceinline__ float bflo(unsigned w) { return __builtin_bit_cast(float, w << 16); }
__device__ __forceinline__ float bfhi(unsigned w) { return __builtin_bit_cast(float, w & 0xffff0000u); }

struct EpiZ {
    static constexpr bool PERM = true, AFTER_DRAIN = false;
    bf16_t *QKV, *RKV, *LORA, *GA, *GB; const float* cs; float qscale;
    __device__ __forceinline__ void operator()(const f32x4 (&acc)[2][2][4][2], const Unit& u, int wr, int wc, int fr, int fq) const {
        const int pn = u.pn;
        bf16_t* base; int ld, colt, mode;
        if (pn < 3)       { base = QKV;  ld = 768;  colt = pn * 256;        mode = (pn < 2) ? 1 : 2; }
        else if (pn < 9)  { base = RKV;  ld = 1536; colt = (pn - 3) * 256;  mode = 0; }
        else if (pn < 11) { base = LORA; ld = 512;  colt = (pn - 9) * 256;  mode = 0; }
        else if (pn < 15) { base = GA;   ld = 1024; colt = (pn - 11) * 256; mode = 3; }
        else              { base = GB;   ld = 1024; colt = (pn - 15) * 256; mode = 3; }
        const int row0 = u.pm * BM + wr * 64 + fr, col0 = colt + wc * 32 + 8 * fq;
        const int i0 = 16 * (wc & 1) + 4 * fq;
#pragma unroll
        for (int ai = 0; ai < 2; ++ai)
#pragma unroll
            for (int m = 0; m < 4; ++m) {
                const int row = row0 + ai * HALF + m * 16;
                bf16_t* rowp = base + (size_t)row * ld + col0;
                f32x4 c0 = (f32x4){1.f, 0.f, 1.f, 0.f}, c1 = c0;
                if (mode == 1 || mode == 2) { const f32x4* cp = (const f32x4*)(cs + ((size_t)(row & 2047) * 32 + i0) * 2); c0 = cp[0]; c1 = cp[1]; }
#pragma unroll
                for (int bj = 0; bj < 2; ++bj) {
                    f32x4 v0 = acc[ai][bj][m][0], v1 = acc[ai][bj][m][1];
                    if (mode == 1 || (mode == 2 && bj == 0)) {
                        f32x4 r0, r1;
                        r0[0] = v0[0] * c0[0] - v0[1] * c0[1]; r0[1] = v0[1] * c0[0] + v0[0] * c0[1];
                        r0[2] = v0[2] * c0[2] - v0[3] * c0[3]; r0[3] = v0[3] * c0[2] + v0[2] * c0[3];
                        r1[0] = v1[0] * c1[0] - v1[1] * c1[1]; r1[1] = v1[1] * c1[0] + v1[0] * c1[1];
                        r1[2] = v1[2] * c1[2] - v1[3] * c1[3]; r1[3] = v1[3] * c1[2] + v1[2] * c1[3];
                        if (mode == 1) { r0 = r0 * qscale; r1 = r1 * qscale; }
                        v0 = r0; v1 = r1;
                    } else if (mode == 3) {
#pragma unroll
                        for (int e = 0; e < 4; ++e) { v0[e] = sigm(v0[e]); v1[e] = sigm(v1[e]); }
                    }
                    *(u32x4*)(rowp + bj * HALF) = pack8(v0, v1);
                }
            }
    }
};
struct EpiDAG {
    static constexpr bool PERM = true, AFTER_DRAIN = false;
    bf16_t* DAG; const float* w0; const float* a0;
    __device__ __forceinline__ void operator()(const f32x4 (&acc)[2][2][4][2], const Unit& u, int wr, int wc, int fr, int fq) const {
        const int pn = u.pn, mode = pn >> 1;
        const int row0 = u.pm * BM + wr * 64 + fr, col0 = pn * BM + wc * 32 + 8 * fq;
#pragma unroll
        for (int bj = 0; bj < 2; ++bj) {
            f32x4 b0 = (f32x4){0.f, 0.f, 0.f, 0.f}, b1 = b0;
            if (mode == 0) { b0 = *(const f32x4*)(w0 + col0 + bj * HALF); b1 = *(const f32x4*)(w0 + col0 + bj * HALF + 4); }
            else if (mode == 1) { b0 = *(const f32x4*)(a0 + (col0 - 512) + bj * HALF); b1 = *(const f32x4*)(a0 + (col0 - 512) + bj * HALF + 4); }
            const float sc = (mode == 0) ? 0.6065306597126334f : 1.0f;
#pragma unroll
            for (int ai = 0; ai < 2; ++ai)
#pragma unroll
                for (int m = 0; m < 4; ++m) {
                    bf16_t* rowp = DAG + (size_t)(row0 + ai * HALF + m * 16) * 1536 + col0 + bj * HALF;
                    f32x4 v0 = acc[ai][bj][m][0] + b0, v1 = acc[ai][bj][m][1] + b1;
                    if (mode < 2) {
#pragma unroll
                        for (int e = 0; e < 4; ++e) { v0[e] = sigm(v0[e]) * sc; v1[e] = sigm(v1[e]) * sc; }
                    }
                    *(u32x4*)rowp = pack8(v0, v1);
                    asm volatile("" ::: "memory");
                }
        }
    }
};
template <int SECOND> struct EpiGate {
    static constexpr bool PERM = true, AFTER_DRAIN = false;
    bf16_t* G; const bf16_t* G2;
    __device__ __forceinline__ void operator()(const f32x4 (&acc)[2][2][4][2], const Unit& u, int wr, int wc, int fr, int fq) const {
        const int row0 = u.pm * BM + wr * 64 + fr, col0 = u.pn * BM + wc * 32 + 8 * fq;
#pragma unroll
        for (int ai = 0; ai < 2; ++ai)
#pragma unroll
            for (int m = 0; m < 4; ++m) {
                const size_t off = (size_t)(row0 + ai * HALF + m * 16) * 1024 + col0;
#pragma unroll
                for (int bj = 0; bj < 2; ++bj) {
                    const u32x4 g = *(const u32x4*)(G + off + bj * HALF);
                    f32x4 v0 = acc[ai][bj][m][0], v1 = acc[ai][bj][m][1];
                    if (SECOND) {
                        const u32x4 h = *(const u32x4*)(G2 + off + bj * HALF);
                        v0[0] = bflo(g.x) + bflo(h.x) * v0[0]; v0[1] = bfhi(g.x) + bfhi(h.x) * v0[1]; v0[2] = bflo(g.y) + bflo(h.y) * v0[2]; v0[3] = bfhi(g.y) + bfhi(h.y) * v0[3];
                        v1[0] = bflo(g.z) + bflo(h.z) * v1[0]; v1[1] = bfhi(g.z) + bfhi(h.z) * v1[1]; v1[2] = bflo(g.w) + bflo(h.w) * v1[2]; v1[3] = bfhi(g.w) + bfhi(h.w) * v1[3];
                    } else {
                        v0[0] *= bflo(g.x); v0[1] *= bfhi(g.x); v0[2] *= bflo(g.y); v0[3] *= bfhi(g.y);
                        v1[0] *= bflo(g.z); v1[1] *= bfhi(g.z); v1[2] *= bflo(g.w); v1[3] *= bfhi(g.w);
                    }
                    *(u32x4*)(G + off + bj * HALF) = pack8(v0, v1);
                }
            }
    }
};
struct EpiH {
    static constexpr bool PERM = true, AFTER_DRAIN = false;
    const float* X; float* Hf; bf16_t* HB; float* ssq;
    __device__ __forceinline__ void operator()(const f32x4 (&acc)[2][2][4][2], const Unit& u, int wr, int wc, int fr, int fq) const {
        const int row0 = u.pm * BM + wr * 64 + fr, col0 = u.pn * BM + wc * 32 + 8 * fq;
#pragma unroll
        for (int ai = 0; ai < 2; ++ai)
#pragma unroll
            for (int m = 0; m < 4; ++m) {
                const int row = row0 + ai * HALF + m * 16;
                const size_t off = (size_t)row * 1024 + col0;
                float s = 0.f;
#pragma unroll
                for (int bj = 0; bj < 2; ++bj) {
                    const f32x4 x0 = *(const f32x4*)(X + off + bj * HALF), x1 = *(const f32x4*)(X + off + bj * HALF + 4);
#ifdef DBG_NO_MIX
                    const f32x4 v0 = x0, v1 = x1;
#else
                    const f32x4 v0 = acc[ai][bj][m][0] + x0, v1 = acc[ai][bj][m][1] + x1;
#endif
                    *(f32x4*)(Hf + off + bj * HALF) = v0; *(f32x4*)(Hf + off + bj * HALF + 4) = v1;
                    *(u32x4*)(HB + off + bj * HALF) = pack8(v0, v1);
                    s += (v0[0] * v0[0] + v0[1] * v0[1]) + (v0[2] * v0[2] + v0[3] * v0[3]) + (v1[0] * v1[0] + v1[1] * v1[1]) + (v1[2] * v1[2] + v1[3] * v1[3]);
                }
                s += __shfl_xor(s, 16); s += __shfl_xor(s, 32);
                if (fq == 0) unsafeAtomicAdd(ssq + row, s);
            }
    }
};
struct EpiPlain {
    static constexpr bool PERM = true, AFTER_DRAIN = false;
    bf16_t* O; int ldc;
    __device__ __forceinline__ void operator()(const f32x4 (&acc)[2][2][4][2], const Unit& u, int wr, int wc, int fr, int fq) const {
        const int row0 = u.pm * BM + wr * 64 + fr, col0 = u.pn * BM + wc * 32 + 8 * fq;
#pragma unroll
        for (int ai = 0; ai < 2; ++ai)
#pragma unroll
            for (int m = 0; m < 4; ++m) { bf16_t* rowp = O + (size_t)(row0 + ai * HALF + m * 16) * ldc + col0;
#pragma unroll
                for (int bj = 0; bj < 2; ++bj) *(u32x4*)(rowp + bj * HALF) = pack8(acc[ai][bj][m][0], acc[ai][bj][m][1]); }
    }
};

template <class Epi, class Sched, bool ALIGN_EPI = false, bool SP2 = false>
__device__ __forceinline__ void gemm_phase(PG8_LAS unsigned char* lds, const Gemm g, const Sched& S, const Epi& E) {
    const int tid = threadIdx.x, wid = __builtin_amdgcn_readfirstlane(tid >> 6), lane = tid & 63, wr = wid >> 2, wc = wid & 3, fr = lane & 15, fq = lane >> 4;
    const int K = g.K, nt = K / BK;
    unsigned voffA[2], voffB[2];
#pragma unroll
    for (int i = 0; i < 2; ++i) { int R, C; stage_rc(tid * 16 + i * 8192, R, C); const int Rb = Epi::PERM ? ((R & ~31) + perm32(R & 31)) : R;
        voffA[i] = (unsigned)(R * K + C) * 2u; voffB[i] = (unsigned)(Rb * K + C) * 2u; }
    const size_t kstep = (size_t)(BK * 2);
    const size_t hstep = (size_t)HALF * K * 2;
    const size_t tstep = 2 * hstep;
    const unsigned ldsw = (unsigned)wid * 1024u;
    const int aoff = lds_byte(wr * 64 + fr, fq * 8), boff = lds_byte(wc * 32 + fr, fq * 8);
#define PG8_SA(b, h) (((b) * 2 + (h)) * HTB)
#define PG8_SB(b, h) ((4 + (b) * 2 + (h)) * HTB)
#define PG8_STAGE(bufoff, gbase, voff) do { _Pragma("unroll") for (int _i = 0; _i < 2; ++_i) \
        __builtin_amdgcn_global_load_lds((const unsigned*)((const char*)(gbase) + (voff)[_i]), (PG8_LAS unsigned*)(lds + (bufoff) + ldsw + _i * 8192), 16, 0, 0); } while (0)
#define PG8_LDA(dst, b, h) do { _Pragma("unroll") for (int m = 0; m < 4; ++m) _Pragma("unroll") for (int k = 0; k < 2; ++k) dst[m][k] = *(const PG8_LAS bf16x8*)(lds + PG8_SA(b, h) + aoff + m * 2048 + k * 1024); } while (0)
#define PG8_LDB(dst, b, h) do { _Pragma("unroll") for (int n = 0; n < 2; ++n) _Pragma("unroll") for (int k = 0; k < 2; ++k) dst[n][k] = *(const PG8_LAS bf16x8*)(lds + PG8_SB(b, h) + boff + n * 2048 + k * 1024); } while (0)
#define PG8_MMA(ai, bj, At, Bt) do { __builtin_amdgcn_s_setprio(1); _Pragma("unroll") for (int m = 0; m < 4; ++m) _Pragma("unroll") for (int n = 0; n < 2; ++n) _Pragma("unroll") for (int k = 0; k < 2; ++k) \
        acc[ai][bj][m][n] = __builtin_amdgcn_mfma_f32_16x16x32_bf16(Bt[n][k], At[m][k], acc[ai][bj][m][n], 0, 0, 0); __builtin_amdgcn_s_setprio(0); } while (0)
#define PG8_WAIT_V(n) asm volatile("s_waitcnt vmcnt(" #n ")" ::: "memory")
#define PG8_WAIT_L(n) asm volatile("s_waitcnt lgkmcnt(" #n ")" ::: "memory")
#define PG8_BAR __builtin_amdgcn_s_barrier()
#define PG8_SCHED __builtin_amdgcn_sched_barrier(0)
    Unit cur, nxt; int ui = 0;
    if (!S.next(0, cur)) return;
    f32x4 acc[2][2][4][2];
#pragma unroll
    for (int a = 0; a < 2; ++a)
#pragma unroll
        for (int b = 0; b < 2; ++b)
#pragma unroll
            for (int m = 0; m < 4; ++m)
#pragma unroll
                for (int n = 0; n < 2; ++n) acc[a][b][m][n] = (f32x4){0.f, 0.f, 0.f, 0.f};
    bf16x8 At[4][2], B0[2][2], B1[2][2];
    const char* cA = (const char*)g.A + (size_t)cur.pm * tstep; const char* cB = (const char*)g.Bt + (size_t)cur.pn * tstep;
    S.a_ready(cur);
    if constexpr (SP2) {
        PG8_STAGE(PG8_SB(0, 0), cB, voffB); PG8_STAGE(PG8_SB(0, 1), cB + hstep, voffB); PG8_STAGE(PG8_SA(0, 0), cA, voffA); PG8_STAGE(PG8_SA(0, 1), cA + hstep, voffA);
        if (wr == 1) PG8_BAR;
        PG8_WAIT_V(2); PG8_BAR;
        PG8_STAGE(PG8_SB(1, 0), cB + kstep, voffB); PG8_STAGE(PG8_SA(1, 0), cA + kstep, voffA); PG8_STAGE(PG8_SB(1, 1), cB + hstep + kstep, voffB);
        PG8_WAIT_V(6); PG8_BAR;
    } else {
        PG8_STAGE(PG8_SB(0, 0), cB, voffB); PG8_STAGE(PG8_SA(0, 0), cA, voffA); PG8_STAGE(PG8_SB(0, 1), cB + hstep, voffB); PG8_STAGE(PG8_SA(0, 1), cA + hstep, voffA);
        if (wr == 1) PG8_BAR;
        PG8_WAIT_V(4); PG8_BAR;
        PG8_STAGE(PG8_SB(1, 0), cB + kstep, voffB); PG8_STAGE(PG8_SA(1, 0), cA + kstep, voffA); PG8_STAGE(PG8_SB(1, 1), cB + hstep + kstep, voffB);
        PG8_WAIT_V(6); PG8_BAR;
    }
    for (;;) {
        const bool has_next = S.next(ui + 1, nxt);
        const char* nA = has_next ? (const char*)g.A + (size_t)nxt.pm * tstep : cA; const char* nB = has_next ? (const char*)g.Bt + (size_t)nxt.pn * tstep : cB;
#pragma unroll 1
        for (int t = 0; t < nt; t += 2) {
            const bool last = (t == nt - 2);
            const char* a1 = cA + (size_t)(t + 1) * kstep;
            const char* a2 = last ? nA : cA + (size_t)(t + 2) * kstep; const char* b2 = last ? nB : cB + (size_t)(t + 2) * kstep;
            const char* a3 = a2 + kstep; const char* b3 = b2 + kstep;
            if (last && has_next) S.a_ready(nxt);
            if constexpr (SP2) {
            PG8_LDB(B0, 0, 0); PG8_LDB(B1, 0, 1); PG8_SCHED; PG8_LDA(At, 0, 0); PG8_STAGE(PG8_SA(1, 1), a1 + hstep, voffA);
            PG8_WAIT_V(8); PG8_WAIT_L(0); PG8_BAR; PG8_MMA(0, 0, At, B0); PG8_MMA(0, 1, At, B1); PG8_BAR; PG8_SCHED;
            PG8_LDA(At, 0, 1); PG8_STAGE(PG8_SB(0, 0), b2, voffB); PG8_STAGE(PG8_SB(0, 1), b2 + hstep, voffB); PG8_STAGE(PG8_SA(0, 0), a2, voffA);
            PG8_WAIT_V(8); PG8_WAIT_L(0); PG8_BAR; PG8_MMA(1, 0, At, B0); PG8_MMA(1, 1, At, B1); PG8_BAR; PG8_SCHED;
            PG8_LDB(B0, 1, 0); PG8_LDB(B1, 1, 1); PG8_SCHED; PG8_LDA(At, 1, 0); PG8_STAGE(PG8_SA(0, 1), a2 + hstep, voffA);
            PG8_WAIT_V(8); PG8_WAIT_L(0); PG8_BAR; PG8_MMA(0, 0, At, B0); PG8_MMA(0, 1, At, B1); PG8_BAR; PG8_SCHED;
            PG8_LDA(At, 1, 1); PG8_STAGE(PG8_SB(1, 0), b3, voffB); PG8_STAGE(PG8_SB(1, 1), b3 + hstep, voffB); PG8_STAGE(PG8_SA(1, 0), a3, voffA);
            PG8_WAIT_V(8); PG8_WAIT_L(0); PG8_BAR; PG8_MMA(1, 0, At, B0); PG8_MMA(1, 1, At, B1); PG8_BAR; PG8_SCHED;
            } else {
            PG8_LDB(B0, 0, 0); PG8_SCHED; PG8_LDA(At, 0, 0); PG8_STAGE(PG8_SA(1, 1), a1 + hstep, voffA);
            PG8_WAIT_L(8); PG8_BAR; PG8_WAIT_L(0); PG8_MMA(0, 0, At, B0); PG8_BAR; PG8_SCHED;
            PG8_LDB(B1, 0, 1); PG8_STAGE(PG8_SB(0, 0), b2, voffB);
            PG8_BAR; PG8_WAIT_L(0); PG8_MMA(0, 1, At, B1); PG8_BAR;
            PG8_LDA(At, 0, 1); PG8_STAGE(PG8_SA(0, 0), a2, voffA);
            PG8_BAR; PG8_WAIT_L(0); PG8_MMA(1, 0, At, B0); PG8_BAR; PG8_SCHED;
            PG8_STAGE(PG8_SB(0, 1), b2 + hstep, voffB);
            PG8_WAIT_V(6); PG8_BAR; PG8_MMA(1, 1, At, B1); PG8_BAR;
            PG8_LDB(B0, 1, 0); PG8_SCHED; PG8_LDA(At, 1, 0); PG8_STAGE(PG8_SA(0, 1), a2 + hstep, voffA);
            PG8_WAIT_L(8); PG8_BAR; PG8_WAIT_L(0); PG8_MMA(0, 0, At, B0); PG8_BAR; PG8_SCHED;
            PG8_LDB(B1, 1, 1); PG8_STAGE(PG8_SB(1, 0), b3, voffB);
            PG8_BAR; PG8_WAIT_L(0); PG8_MMA(0, 1, At, B1); PG8_BAR;
            PG8_LDA(At, 1, 1); PG8_STAGE(PG8_SA(1, 0), a3, voffA);
            PG8_BAR; PG8_WAIT_L(0); PG8_MMA(1, 0, At, B0); PG8_BAR; PG8_SCHED;
            PG8_STAGE(PG8_SB(1, 1), b3 + hstep, voffB);
            PG8_WAIT_V(6); PG8_BAR; PG8_MMA(1, 1, At, B1); PG8_BAR;
            }
        }
        if constexpr (ALIGN_EPI) { if (wr == 0) PG8_BAR; }
        if constexpr (!Epi::AFTER_DRAIN) { E(acc, cur, wr, wc, fr, fq); S.done(cur); }
        if (!has_next) break;
#pragma unroll
        for (int a = 0; a < 2; ++a)
#pragma unroll
            for (int b = 0; b < 2; ++b)
#pragma unroll
                for (int m = 0; m < 4; ++m)
#pragma unroll
                    for (int n = 0; n < 2; ++n) acc[a][b][m][n] = (f32x4){0.f, 0.f, 0.f, 0.f};
        cur = nxt; cA = nA; cB = nB; ++ui;
        if constexpr (ALIGN_EPI) { if (wr == 1) PG8_BAR; }
    }
    PG8_WAIT_V(0);
    if constexpr (!ALIGN_EPI) { if (wr == 0) PG8_BAR; }
    PG8_BAR;
    if constexpr (Epi::AFTER_DRAIN) { E.fused(acc, cur, wr, wc, fr, fq, lds, wid, lane); S.done(cur); }
#undef PG8_SA
#undef PG8_SB
#undef PG8_STAGE
#undef PG8_LDA
#undef PG8_LDB
#undef PG8_MMA
#undef PG8_WAIT_V
#undef PG8_WAIT_L
#undef PG8_BAR
#undef PG8_SCHED
}
}
#define GAS __attribute__((address_space(1)))
#define LAS __attribute__((address_space(3)))
typedef unsigned short bf16;
typedef unsigned v4u __attribute__((ext_vector_type(4)));
typedef float f32x4 __attribute__((ext_vector_type(4)));
typedef short bf16x8 __attribute__((ext_vector_type(8)));
typedef GAS unsigned gu32;
typedef GAS unsigned long long gu64;
#define RLX_AGENT __ATOMIC_RELAXED, __HIP_MEMORY_SCOPE_AGENT
#define LDS_WAIT() asm volatile("s_waitcnt lgkmcnt(0)" ::: "memory")
#define VM_WAIT() asm volatile("s_waitcnt vmcnt(0)" ::: "memory")
__device__ __forceinline__ unsigned long long rt() { return __builtin_amdgcn_s_memrealtime(); }
__device__ __forceinline__ unsigned f2bf(float f) { unsigned u = __builtin_bit_cast(unsigned, f); return (u + 0x7fffu + ((u >> 16) & 1u)) >> 16; }
__device__ __forceinline__ unsigned pk2(float lo, float hi) { return f2bf(lo) | (f2bf(hi) << 16); }

#define XB_TMO      128
#define XB_XCNT(j)  (256  + 64 * (j))
#define XB_XSUB(j)  (1280 + 64 * (j))
#define XB_XGEN(j)  (2304 + 64 * (j))
#define XB_TOP      3328
#define XB_TOPGEN   3392
#define XCD_BAR_WORDS 3456
#define XB_SPIN_CAP (1u << 22)

__device__ __forceinline__ unsigned xb_ld(unsigned* p)              { return __hip_atomic_load(p, __ATOMIC_RELAXED, __HIP_MEMORY_SCOPE_AGENT); }
__device__ __forceinline__ unsigned xb_add(unsigned* p, unsigned v) { return __hip_atomic_fetch_add(p, v, __ATOMIC_RELAXED, __HIP_MEMORY_SCOPE_AGENT); }
__device__ __forceinline__ unsigned xb_xcc_id() { return (unsigned)__builtin_amdgcn_s_getreg((3 << 11) | 20) & 0xFu; }
#define XB_SPIN(cond, bar) do { unsigned _sp = 0; while (cond) { __builtin_amdgcn_s_sleep(1); \
    if ((++_sp & 255u) == 0u) { if (xb_ld(&(bar)[XB_TMO])) break; if (_sp > XB_SPIN_CAP) { atomicAdd(&(bar)[XB_TMO], 1u); break; } } } } while (0)

struct XcdBarrier {
    unsigned* bar; unsigned x;
    volatile LAS unsigned* st;
};

__device__ __forceinline__ XcdBarrier xcd_barrier_post(unsigned* bar, volatile LAS unsigned* st) {
    XcdBarrier b; b.bar = bar; b.x = xb_xcc_id(); b.st = st;
    if (threadIdx.x == 0) (void)xb_add(&bar[XB_XCNT(b.x)], 1u);
    return b;
}
__device__ __forceinline__ void xcd_barrier_complete(unsigned* bar, unsigned x, unsigned& nloc, unsigned& nx) {
    const unsigned G = gridDim.x * gridDim.y * gridDim.z;
    unsigned sum, cnt, mine, sp = 0u;
    for (;;) {
        sum = 0u; cnt = 0u; mine = 0u;
#pragma unroll
        for (unsigned j = 0; j < 16; ++j) { const unsigned c = xb_ld(&bar[XB_XCNT(j)]); sum += c; cnt += (c > 0u) ? 1u : 0u; mine = (j == x) ? c : mine; }
        if (sum == G) break;
        __builtin_amdgcn_s_sleep(1);
        if ((++sp & 255u) == 0u) { if (xb_ld(&bar[XB_TMO])) break; if (sp > XB_SPIN_CAP) { atomicAdd(&bar[XB_TMO], 1u); break; } }
    }
    nloc = mine > 0u ? mine : 1u; nx = cnt > 0u ? cnt : 1u;
}

__device__ __forceinline__ void xcd_barrier(const XcdBarrier& b) {
    asm volatile("s_waitcnt vmcnt(0)" ::: "memory");
    __syncthreads();
    if (threadIdx.x == 0) {
        unsigned* bar = b.bar;
        __builtin_amdgcn_s_waitcnt(0);
        unsigned nloc = b.st[0], nx = b.st[1];
        if (nloc == 0u) { xcd_barrier_complete(bar, b.x, nloc, nx); b.st[0] = nloc; b.st[1] = nx; }
        const unsigned old = xb_add(&bar[XB_XSUB(b.x)], 1u);
        const unsigned gen = old / nloc;
        if (old + 1u == (gen + 1u) * nloc) {
            __builtin_amdgcn_fence(__ATOMIC_RELEASE, "agent");
            asm volatile("s_waitcnt vmcnt(0)" ::: "memory");
            const unsigned og = xb_add(&bar[XB_TOP], 1u);
            const unsigned tg = og / nx;
            if (og + 1u == (tg + 1u) * nx) xb_add(&bar[XB_TOPGEN], 1u);
            else XB_SPIN(xb_ld(&bar[XB_TOPGEN]) == tg, bar);
            __builtin_amdgcn_fence(__ATOMIC_ACQUIRE, "agent");
            xb_add(&bar[XB_XGEN(b.x)], 1u);
            asm volatile("s_waitcnt vmcnt(0)" ::: "memory");
        } else {
            XB_SPIN(xb_ld(&bar[XB_XGEN(b.x)]) == gen, bar);
            __builtin_amdgcn_fence(__ATOMIC_ACQUIRE, "agent");
            asm volatile("s_waitcnt vmcnt(0)" ::: "memory");
        }
    }
    __syncthreads();
}

constexpr int NWAVES = 8;
constexpr int BATCH = 32, SEQ = 2048, D = 1024, M = BATCH * SEQ;
constexpr int IN_COLS = 4640, NZ = 4864;
constexpr int NEXP = 16384;
constexpr float NORM_EPS = 1e-5f, GN_EPS = 64e-5f, LOG2E = 1.4426950408889634f;
constexpr float QSCALE = 0.125f * LOG2E;

constexpr size_t MiB = 1u << 20;
constexpr size_t WS_CTL = 0, CTL_ZERO_BYTES = 64 * 1024;
constexpr size_t WS_ROPE = 1 * MiB;
constexpr size_t WS_SSQ = 1 * MiB + 512 * 1024;
constexpr size_t WS_WIN = 2 * MiB;
constexpr size_t WS_PA = 12 * MiB, WS_PB = 13 * MiB, WS_WOUT = 14 * MiB, WS_WQ = 16 * MiB, WS_LW = 18 * MiB;
constexpr size_t WS_SK = 19 * MiB + 512 * 1024;
constexpr size_t WS_UT = 20 * MiB, WS_VT = 52 * MiB;
constexpr size_t WS_XN = 84 * MiB;
constexpr size_t WS_LA = 84 * MiB;
constexpr size_t WS_YA = 132 * MiB;
constexpr size_t WS_IDX = 84 * MiB, WS_GATE = 116 * MiB;
constexpr size_t WS_QKV = 212 * MiB;
constexpr size_t WS_YB = 212 * MiB;
constexpr size_t WS_RKV = 308 * MiB;
constexpr size_t WS_HB = 308 * MiB;
constexpr size_t WS_LORA = 500 * MiB;
constexpr size_t WS_GA = 564 * MiB, WS_GB = 692 * MiB;
constexpr size_t WS_DAG = 820 * MiB;
constexpr size_t WS_QP = 820 * MiB;
constexpr size_t WS_END = 1012 * MiB;
constexpr int CW_BAR = 4096;

constexpr int RING_BYTES = 131072;
constexpr int LDSCTL_OFF = RING_BYTES, MISC_OFF = LDSCTL_OFF + 320;
constexpr int LDS_BYTES = 147456;

typedef float f32x2 __attribute__((ext_vector_type(2)));
typedef float f32x16 __attribute__((ext_vector_type(16)));
typedef unsigned u32x2 __attribute__((ext_vector_type(2)));
typedef __bf16 bf16x2_t __attribute__((ext_vector_type(2)));

__device__ __forceinline__ float bf2f(unsigned b) { return __builtin_bit_cast(float, b << 16); }
__device__ __forceinline__ float bf_lo(unsigned w) { return __builtin_bit_cast(float, w << 16); }
__device__ __forceinline__ float bf_hi(unsigned w) { return __builtin_bit_cast(float, w & 0xffff0000u); }
template <int CTRL> __device__ __forceinline__ float dppf(float x) { return __builtin_bit_cast(float, __builtin_amdgcn_update_dpp(0, __builtin_bit_cast(int, x), CTRL, 0xF, 0xF, true)); }
__device__ __forceinline__ float allreduce16(float x) { x += dppf<0xB1>(x); x += dppf<0x4E>(x); x += dppf<0x141>(x); x += dppf<0x140>(x); return x; }
__device__ __forceinline__ float wave_sum(float v) {
#pragma unroll
    for (int o = 1; o < 64; o <<= 1) v += __shfl_xor(v, o);
    return v;
}
__device__ __forceinline__ bf16x2_t as_bf2(unsigned w) { return __builtin_bit_cast(bf16x2_t, w); }
__device__ __forceinline__ float u2f(unsigned w) { return __builtin_bit_cast(float, w); }
__device__ __forceinline__ unsigned f2u(float f) { return __builtin_bit_cast(unsigned, f); }
__device__ __forceinline__ float gelu_erf(float v) {
    const float av = __builtin_fabsf(v), t = __builtin_amdgcn_rcpf(av * 0.2316418882f + 1.0f);
    float q = t * 0.5307027145f + (-0.7265760135f); q = q * t + 0.7107068705f; q = q * t + (-0.142248368f); q = q * t + 0.127414796f; q = q * t;
    const float e = __builtin_amdgcn_exp2f((v * v) * (-0.72134752044f));
    const float m = v * (q * e);
    return v < 0.f ? m : v - m;
}

struct Frame {
    LAS unsigned char* lds;
    volatile LAS unsigned* MISC;
    gu32* ctl;
    int tid, lane, wave, vcu, G;
    const float* in[24]; float* out;
    float *ROPE, *SSQ;
    bf16 *WIN, *PA, *PB, *WOUT, *WQ, *LW, *SK, *UT, *VT, *XN, *LA, *YA, *QKV, *YB, *RKV, *HB, *LORA, *GA, *GB, *DAG, *QP;
    int* IDX; float* GATE;
};
enum { I_X = 0, I_NMW, I_WIN, I_MU, I_SINK, I_W0, I_W2, I_A0, I_A2, I_G2, I_KK, I_KA, I_RK, I_LNW, I_LNB, I_PA, I_PB, I_WOUT, I_NFW, I_WQ, I_SUBK, I_U, I_V, I_NFINAL };

struct SrcWin { const float* w; __device__ __forceinline__ float operator()(int k, int n) const {
    int src;
    if (n < 640) { const int hd = n >> 6, j = n & 63; src = hd * 64 + ((j & 1) ? 32 + (j >> 1) : (j >> 1)); }
    else if (n < 2592) src = n;
    else if (n < 2816) return 0.f;
    else src = n - 224;
    return w[(size_t)k * IN_COLS + src]; } };
struct SrcPlain { const float* w; int N; __device__ __forceinline__ float operator()(int k, int n) const { return w[(size_t)k * N + n]; } };
struct SrcWq { const float* w; const float* s; __device__ __forceinline__ float operator()(int k, int n) const { return w[(size_t)k * 1024 + n] * s[k]; } };
struct SrcLora { const float *w2, *a2, *g2; __device__ __forceinline__ float operator()(int k, int n) const {
    if (n < 512) return k < 64 ? w2[k * 512 + n] : 0.f;
    if (n < 1024) return (k >= 64 && k < 128) ? a2[(k - 64) * 512 + (n - 512)] : 0.f;
    return (k >= 128 && k < 288) ? g2[(k - 128) * 512 + (n - 1024)] : 0.f; } };
template <int N, int K, class F_> __device__ __forceinline__ void transpose_w(bf16* dst, const F_& f, int gtid, int nthr) {
    for (int id = gtid; id < N * (K / 8); id += nthr) {
        const int n = id % N, k0 = (id / N) * 8;
        float v[8];
#pragma unroll
        for (int j = 0; j < 8; ++j) v[j] = f(k0 + j, n);
        v4u o; o.x = pk2(v[0], v[1]); o.y = pk2(v[2], v[3]); o.z = pk2(v[4], v[5]); o.w = pk2(v[6], v[7]);
        *(v4u*)(dst + (size_t)n * K + k0) = o;
    }
}
__device__ __forceinline__ void p0_prologue(Frame& F) {
    const int gtid = F.vcu * (NWAVES * 64) + F.tid, nthr = F.G * NWAVES * 64;
    const int gw = F.vcu * NWAVES + F.wave, NGW = F.G * NWAVES;
    transpose_w<NZ, 1024>(F.WIN, SrcWin{F.in[I_WIN]}, gtid, nthr);
    transpose_w<1024, 512>(F.PA, SrcPlain{F.in[I_PA], 1024}, gtid, nthr);
    transpose_w<1024, 512>(F.PB, SrcPlain{F.in[I_PB], 1024}, gtid, nthr);
    transpose_w<1024, 1024>(F.WOUT, SrcPlain{F.in[I_WOUT], 1024}, gtid, nthr);
    transpose_w<1024, 1024>(F.WQ, SrcWq{F.in[I_WQ], F.in[I_NFW]}, gtid, nthr);
    transpose_w<1536, 384>(F.LW, SrcLora{F.in[I_W2], F.in[I_A2], F.in[I_G2]}, gtid, nthr);
    for (int id = gtid; id < 16 * 128 * 64 / 8; id += nthr) {
        const f32x4 a = *(const f32x4*)(F.in[I_SUBK] + (size_t)id * 8), b = *(const f32x4*)(F.in[I_SUBK] + (size_t)id * 8 + 4);
        v4u o; o.x = pk2(a[0], a[1]); o.y = pk2(a[2], a[3]); o.z = pk2(b[0], b[1]); o.w = pk2(b[2], b[3]);
        *(v4u*)(F.SK + (size_t)id * 8) = o;
    }
    for (int id = gtid; id < NEXP * 1024 / 8; id += nthr) {
        const int d0 = (id & 127) * 8;
        const f32x4 w0 = *(const f32x4*)(F.in[I_NFW] + d0), w1 = *(const f32x4*)(F.in[I_NFW] + d0 + 4);
        const f32x4 a = *(const f32x4*)(F.in[I_U] + (size_t)id * 8) * w0, b = *(const f32x4*)(F.in[I_U] + (size_t)id * 8 + 4) * w1;
        v4u o; o.x = pk2(a[0], a[1]); o.y = pk2(a[2], a[3]); o.z = pk2(b[0], b[1]); o.w = pk2(b[2], b[3]);
        *(v4u*)(F.UT + (size_t)id * 8) = o;
        const f32x4 c = *(const f32x4*)(F.in[I_V] + (size_t)id * 8), d = *(const f32x4*)(F.in[I_V] + (size_t)id * 8 + 4);
        v4u p; p.x = pk2(c[0], c[1]); p.y = pk2(c[2], c[3]); p.z = pk2(d[0], d[1]); p.w = pk2(d[2], d[3]);
        *(v4u*)(F.VT + (size_t)id * 8) = p;
    }
    for (int id = gtid; id < SEQ * 32; id += nthr) {
        const int t = id >> 5, i = id & 31;
        const double inv = exp2(-(double)i * (13.287712379549449 / 32.0));
        double rev = (double)t * inv * 0.15915494309189535; rev -= floor(rev);
        F.ROPE[2 * id] = __builtin_amdgcn_cosf((float)rev); F.ROPE[2 * id + 1] = __builtin_amdgcn_sinf((float)rev);
    }
    for (int id = gtid; id < M; id += nthr) F.SSQ[id] = 0.f;
    const GAS f32x4* wv = (const GAS f32x4*)F.in[I_NMW] + F.lane;
    f32x4 nw[4];
#pragma unroll
    for (int j = 0; j < 4; ++j) nw[j] = wv[64 * j];
    for (int m = gw; m < M; m += NGW) {
        const GAS f32x4* xr = (const GAS f32x4*)(F.in[I_X] + (size_t)m * D) + F.lane;
        f32x4 v[4]; float s = 0.f;
#pragma unroll
        for (int j = 0; j < 4; ++j) { v[j] = xr[64 * j]; s += (v[j].x * v[j].x + v[j].y * v[j].y) + (v[j].z * v[j].z + v[j].w * v[j].w); }
        const float rstd = 1.0f / sqrtf(wave_sum(s) * (1.f / D) + NORM_EPS);
        GAS unsigned long long* o8 = (GAS unsigned long long*)(F.XN + (size_t)m * D) + F.lane;
#pragma unroll
        for (int j = 0; j < 4; ++j) { const f32x4 y = v[j] * rstd * nw[j]; o8[64 * j] = (unsigned long long)pk2(y.x, y.y) | ((unsigned long long)pk2(y.z, y.w) << 32); }
    }
}

__device__ __forceinline__ void attn_phase(Frame& F) {
    LAS bf16* Ks = (LAS bf16*)F.lds;
    LAS bf16* Vt = (LAS bf16*)(F.lds + 256 * 144);
    const int lane = F.lane, wave = F.wave, r32 = lane & 31, hh = lane >> 5;
    for (int unit = F.vcu; unit < BATCH * 2 * 16; unit += F.G) {
        const int b = unit >> 5, kvh = (unit >> 4) & 1, qb = unit & 15;
        const size_t rowbase = (size_t)b * SEQ + qb * 128;
#pragma unroll
        for (int i = 0; i < 4; ++i) {
            const int c = F.tid + 512 * i, key = c >> 3, piece = c & 7;
            v4u kv = (v4u){0u, 0u, 0u, 0u}, vv = kv;
            if (qb > 0 || key >= 128) { const bf16* src = F.QKV + (rowbase + key - 128) * 768 + kvh * 64 + piece * 8; kv = *(const v4u*)(src + 512); vv = *(const v4u*)(src + 640); }
            *(LAS v4u*)(Ks + key * 72 + piece * 8) = kv;
            LAS bf16* vd = Vt + (piece * 8) * 260 + key;
            vd[0 * 260] = (bf16)(vv.x & 0xffffu); vd[1 * 260] = (bf16)(vv.x >> 16); vd[2 * 260] = (bf16)(vv.y & 0xffffu); vd[3 * 260] = (bf16)(vv.y >> 16);
            vd[4 * 260] = (bf16)(vv.z & 0xffffu); vd[5 * 260] = (bf16)(vv.z >> 16); vd[6 * 260] = (bf16)(vv.w & 0xffffu); vd[7 * 260] = (bf16)(vv.w >> 16);
        }
        __syncthreads();
        const int head = kvh * 4 + (wave >> 1);
        const float sink2 = F.in[I_SINK][head] * LOG2E;
#pragma unroll 1
        for (int qq = 0; qq < 2; ++qq) {
            const int qg = (wave & 1) * 64 + qq * 32, qi = qg + r32;
            const bf16* qp = F.QKV + (rowbase + qi) * 768 + head * 64 + 8 * hh;
            bf16x8 bq[4];
#pragma unroll
            for (int s = 0; s < 4; ++s) bq[s] = *(const bf16x8*)(qp + 16 * s);
            const int kt0 = qg >> 5;
            f32x16 sc[5];
#pragma unroll
            for (int i = 0; i < 5; ++i) {
                f32x16 a_ = {};
#pragma unroll
                for (int s = 0; s < 4; ++s) { const bf16x8 ka = *(const LAS bf16x8*)(Ks + ((kt0 + i) * 32 + r32) * 72 + 16 * s + 8 * hh); a_ = __builtin_amdgcn_mfma_f32_32x32x16_bf16(ka, bq[s], a_, 0, 0, 0); }
                sc[i] = a_;
            }
            float mx = sink2;
#pragma unroll
            for (int i = 0; i < 5; ++i)
#pragma unroll
                for (int r = 0; r < 16; ++r) {
                    const int kj = (kt0 + i) * 32 + (r & 3) + 8 * (r >> 2) + 4 * hh, dk = kj - qi;
                    const bool ok = (dk >= 1) && (dk <= 128) && (qb > 0 || kj >= 128);
                    const float s = ok ? sc[i][r] : -1e30f; sc[i][r] = s; mx = fmaxf(mx, s);
                }
            mx = fmaxf(mx, __shfl_xor(mx, 32));
            float sum = 0.f;
#pragma unroll
            for (int i = 0; i < 5; ++i)
#pragma unroll
                for (int r = 0; r < 16; ++r) { const float p = __builtin_amdgcn_exp2f(sc[i][r] - mx); sc[i][r] = p; sum += p; }
            sum += __shfl_xor(sum, 32); sum += __builtin_amdgcn_exp2f(sink2 - mx);
            const float inv = 1.0f / sum;
            f32x16 o0 = {}, o1 = {};
#pragma unroll
            for (int i = 0; i < 5; ++i)
#pragma unroll
                for (int s2 = 0; s2 < 2; ++s2) {
                    v4u pw;
                    pw.x = pk2(sc[i][8 * s2 + 0] * inv, sc[i][8 * s2 + 1] * inv); pw.y = pk2(sc[i][8 * s2 + 2] * inv, sc[i][8 * s2 + 3] * inv);
                    pw.z = pk2(sc[i][8 * s2 + 4] * inv, sc[i][8 * s2 + 5] * inv); pw.w = pk2(sc[i][8 * s2 + 6] * inv, sc[i][8 * s2 + 7] * inv);
                    const bf16x8 pa = __builtin_bit_cast(bf16x8, pw);
                    const int kb = (kt0 + i) * 32 + 16 * s2 + 4 * hh;
                    const u32x2 l0 = *(const LAS u32x2*)(Vt + r32 * 260 + kb), h0 = *(const LAS u32x2*)(Vt + r32 * 260 + kb + 8);
                    const u32x2 l1 = *(const LAS u32x2*)(Vt + (32 + r32) * 260 + kb), h1 = *(const LAS u32x2*)(Vt + (32 + r32) * 260 + kb + 8);
                    const bf16x8 b0 = __builtin_bit_cast(bf16x8, (v4u){l0.x, l0.y, h0.x, h0.y}), b1 = __builtin_bit_cast(bf16x8, (v4u){l1.x, l1.y, h1.x, h1.y});
                    o0 = __builtin_amdgcn_mfma_f32_32x32x16_bf16(pa, b0, o0, 0, 0, 0);
                    o1 = __builtin_amdgcn_mfma_f32_32x32x16_bf16(pa, b1, o1, 0, 0, 0);
                }
#pragma unroll
            for (int r = 0; r < 16; ++r) {
                const int qrow = (r & 3) + 8 * (r >> 2) + 4 * hh;
                bf16* op = F.YA + (rowbase + qg + qrow) * 512 + head * 64 + r32;
                op[0] = (bf16)f2bf(o0[r]); op[32] = (bf16)f2bf(o1[r]);
            }
        }
        __syncthreads();
    }
}

__device__ __forceinline__ void lora_prep_phase(Frame& F) {
    const int gtid = F.vcu * (NWAVES * 64) + F.tid, nthr = F.G * NWAVES * 64;
    for (int id = gtid; id < M * 48; id += nthr) {
        const int row = id / 48, ch = id % 48, c0 = ch * 8;
        v4u o = (v4u){0u, 0u, 0u, 0u};
        if (c0 < 288) {
            const v4u zc = *(const v4u*)(F.LORA + (size_t)row * 512 + c0);
            v4u zp = (v4u){0u, 0u, 0u, 0u};
            if ((row & (SEQ - 1)) != 0) zp = *(const v4u*)(F.LORA + (size_t)(row - 1) * 512 + c0);
            const float* mu = F.in[I_MU] + 1536 + c0;
            const unsigned zcw[4] = {zc.x, zc.y, zc.z, zc.w}, zpw[4] = {zp.x, zp.y, zp.z, zp.w};
            float v[8];
#pragma unroll
            for (int j = 0; j < 8; ++j) {
                const float zc_ = (j & 1) ? bf_hi(zcw[j >> 1]) : bf_lo(zcw[j >> 1]), zp_ = (j & 1) ? bf_hi(zpw[j >> 1]) : bf_lo(zpw[j >> 1]);
                const float z = zc_ + mu[j] * (zp_ - zc_);
                float f;
                if (c0 < 64) f = 1.0f - 2.0f * __builtin_amdgcn_rcpf(__builtin_amdgcn_exp2f(2.0f * LOG2E * z) + 1.0f);
                else if (c0 < 128) f = z;
                else f = __builtin_amdgcn_rcpf(1.0f + __builtin_amdgcn_exp2f(-LOG2E * z));
                v[j] = f;
            }
            o.x = pk2(v[0], v[1]); o.y = pk2(v[2], v[3]); o.z = pk2(v[4], v[5]); o.w = pk2(v[6], v[7]);
        }
        *(v4u*)(F.LA + (size_t)row * 384 + c0) = o;
    }
}

__device__ __forceinline__ void scan_phase(Frame& F) {
    LAS float* L = (LAS float*)F.lds;
    constexpr int BUF = 12288, O_R = 0, O_W = 2048, O_KP = 4096, O_KK = 6144, O_BB = 8192, O_V = 10240, O_Y = 2 * BUF, O_BON = 2 * BUF + 2048;
    const int tid = F.tid, lane = F.lane, wave = F.wave;
    const int tt = tid >> 4, d4 = (tid & 15) * 4;
    const int kg = lane & 15, vg = wave * 4 + (lane >> 4);
    for (int unit = F.vcu; unit < BATCH * 8; unit += F.G) {
        const int b = unit >> 3, h = unit & 7, hc = h * 64 + d4;
        const f32x4 mu_r = *(const f32x4*)(F.in[I_MU] + hc), mu_k = *(const f32x4*)(F.in[I_MU] + 512 + hc), mu_v = *(const f32x4*)(F.in[I_MU] + 1024 + hc);
        const f32x4 ckk = *(const f32x4*)(F.in[I_KK] + hc), cka = *(const f32x4*)(F.in[I_KA] + hc), crk = *(const f32x4*)(F.in[I_RK] + hc);
        const f32x4 lnw = *(const f32x4*)(F.in[I_LNW] + hc), lnb = *(const f32x4*)(F.in[I_LNB] + hc);
        f32x2 S00 = {0.f, 0.f}, S01 = {0.f, 0.f}, S10 = {0.f, 0.f}, S11 = {0.f, 0.f};
        u32x2 zr, zk, zv, pr, pk, pv, ew, aa;
#define SCAN_LOAD(c) do { const size_t row_ = (size_t)b * SEQ + (c) * 32 + tt; const bf16* rp_ = F.RKV + row_ * 1536 + hc; \
            zr = *(const u32x2*)(rp_); zk = *(const u32x2*)(rp_ + 512); zv = *(const u32x2*)(rp_ + 1024); \
            if ((c) * 32 + tt > 0) { pr = *(const u32x2*)(rp_ - 1536); pk = *(const u32x2*)(rp_ - 1536 + 512); pv = *(const u32x2*)(rp_ - 1536 + 1024); } else { pr = (u32x2){0u, 0u}; pk = pr; pv = pr; } \
            const bf16* dp_ = F.DAG + row_ * 1536 + hc; ew = *(const u32x2*)(dp_); aa = *(const u32x2*)(dp_ + 512); } while (0)
#define UNPK4(w) ((f32x4){bf_lo((w).x), bf_hi((w).x), bf_lo((w).y), bf_hi((w).y)})
#define SCAN_PREP(c) do { LAS float* Lb_ = L + ((c) & 1) * BUF + tt * 64 + d4; \
            const f32x4 r0_ = UNPK4(zr), k0_ = UNPK4(zk), v0_ = UNPK4(zv); \
            const f32x4 r_ = r0_ + mu_r * (UNPK4(pr) - r0_), k_ = k0_ + mu_k * (UNPK4(pk) - k0_), v_ = v0_ + mu_v * (UNPK4(pv) - v0_); \
            const f32x4 a_ = UNPK4(aa), e_ = UNPK4(ew); \
            f32x4 kk_ = k_ * ckk; const float n2_ = allreduce16((kk_.x * kk_.x + kk_.y * kk_.y) + (kk_.z * kk_.z + kk_.w * kk_.w)); \
            kk_ = kk_ * (1.0f / fmaxf(sqrtf(n2_), 1e-12f)); \
            const f32x4 kp_ = k_ * (1.0f + (a_ - 1.0f) * cka); \
            f32x4 dc_; dc_.x = __builtin_amdgcn_exp2f(-LOG2E * e_.x); dc_.y = __builtin_amdgcn_exp2f(-LOG2E * e_.y); dc_.z = __builtin_amdgcn_exp2f(-LOG2E * e_.z); dc_.w = __builtin_amdgcn_exp2f(-LOG2E * e_.w); \
            const f32x4 rk_ = r_ * kp_ * crk; const float bon_ = allreduce16((rk_.x + rk_.y) + (rk_.z + rk_.w)); \
            *(LAS f32x4*)(Lb_ + O_R) = r_; *(LAS f32x4*)(Lb_ + O_W) = dc_; *(LAS f32x4*)(Lb_ + O_KP) = kp_; *(LAS f32x4*)(Lb_ + O_KK) = kk_; *(LAS f32x4*)(Lb_ + O_BB) = kk_ * a_; *(LAS f32x4*)(Lb_ + O_V) = v_; \
            if ((tid & 15) == 0) L[O_BON + ((c) & 1) * 32 + tt] = bon_; } while (0)
        SCAN_LOAD(0); SCAN_PREP(0);
        __syncthreads();
#pragma unroll 1
        for (int c = 0; c < SEQ / 32; ++c) {
            if (c + 1 < SEQ / 32) SCAN_LOAD(c + 1);
            const LAS float* Lb = L + (c & 1) * BUF;
#pragma unroll 4
            for (int t = 0; t < 32; ++t) {
                const f32x4 rr = *(const LAS f32x4*)(Lb + O_R + t * 64 + 4 * kg), ww = *(const LAS f32x4*)(Lb + O_W + t * 64 + 4 * kg), kp = *(const LAS f32x4*)(Lb + O_KP + t * 64 + 4 * kg);
                const f32x4 kk = *(const LAS f32x4*)(Lb + O_KK + t * 64 + 4 * kg), bb = *(const LAS f32x4*)(Lb + O_BB + t * 64 + 4 * kg);
                const f32x2 vv = *(const LAS f32x2*)(Lb + O_V + t * 64 + 2 * vg);
                const f32x2 kk0 = {kk.x, kk.y}, kk1 = {kk.z, kk.w}, ww0 = {ww.x, ww.y}, ww1 = {ww.z, ww.w}, bb0 = {bb.x, bb.y}, bb1 = {bb.z, bb.w}, kp0 = {kp.x, kp.y}, kp1 = {kp.z, kp.w}, rr0 = {rr.x, rr.y}, rr1 = {rr.z, rr.w};
                f32x2 t0 = S00 * kk0 + S01 * kk1, t1 = S10 * kk0 + S11 * kk1;
                const float sa0 = allreduce16(t0.x + t0.y), sa1 = allreduce16(t1.x + t1.y);
                S00 = S00 * ww0 - sa0 * bb0 + vv.x * kp0; S01 = S01 * ww1 - sa0 * bb1 + vv.x * kp1;
                S10 = S10 * ww0 - sa1 * bb0 + vv.y * kp0; S11 = S11 * ww1 - sa1 * bb1 + vv.y * kp1;
                t0 = S00 * rr0 + S01 * rr1; t1 = S10 * rr0 + S11 * rr1;
                const float y0 = allreduce16(t0.x + t0.y), y1 = allreduce16(t1.x + t1.y);
                if (kg == 0) *(LAS f32x2*)(L + O_Y + t * 64 + 2 * vg) = (f32x2){y0, y1};
            }
            __syncthreads();
            {
                const size_t row = (size_t)b * SEQ + c * 32 + tt;
                const u32x2 gw_ = *(const u32x2*)(F.DAG + row * 1536 + 1024 + hc);
                const f32x4 y = *(const LAS f32x4*)(L + O_Y + tt * 64 + d4);
                const float mean = allreduce16((y.x + y.y) + (y.z + y.w)) * (1.f / 64.f);
                const f32x4 dy = y - mean;
                const float var = allreduce16((dy.x * dy.x + dy.y * dy.y) + (dy.z * dy.z + dy.w * dy.w)) * (1.f / 64.f);
                const float rs = 1.0f / sqrtf(var + GN_EPS);
                const f32x4 vsh = *(const LAS f32x4*)(Lb + O_V + tt * 64 + d4);
                const float bon = L[O_BON + (c & 1) * 32 + tt];
                f32x4 o = (dy * rs * lnw + lnb + bon * vsh) * UNPK4(gw_);
                u32x2 ow; ow.x = pk2(o.x, o.y); ow.y = pk2(o.z, o.w);
                *(u32x2*)(F.YB + row * 512 + hc) = ow;
            }
            if (c + 1 < SEQ / 32) SCAN_PREP(c + 1);
            __syncthreads();
        }
#undef SCAN_LOAD
#undef SCAN_PREP
    }
}

#define CE(i, j) do { const unsigned a_ = x[i], b_ = x[j]; x[i] = a_ > b_ ? a_ : b_; x[j] = a_ > b_ ? b_ : a_; } while (0)
__device__ __forceinline__ void sort16(unsigned (&x)[16]) {
    CE(0,1); CE(2,3); CE(0,2); CE(1,3); CE(1,2); CE(4,5); CE(6,7); CE(4,6); CE(5,7); CE(5,6); CE(0,4); CE(2,6); CE(2,4); CE(1,5); CE(3,7); CE(3,5); CE(1,2); CE(3,4); CE(5,6);
    CE(8,9); CE(10,11); CE(8,10); CE(9,11); CE(9,10); CE(12,13); CE(14,15); CE(12,14); CE(13,15); CE(13,14); CE(8,12); CE(10,14); CE(10,12); CE(9,13); CE(11,15); CE(11,13); CE(9,10); CE(11,12); CE(13,14);
    CE(0,8); CE(4,12); CE(4,8); CE(2,10); CE(6,14); CE(6,10); CE(2,4); CE(6,8); CE(10,12); CE(1,9); CE(5,13); CE(5,9); CE(3,11); CE(7,15); CE(7,11); CE(3,5); CE(7,9); CE(11,13);
    CE(1,2); CE(3,4); CE(5,6); CE(7,8); CE(9,10); CE(11,12); CE(13,14);
}
__device__ __forceinline__ void merge16(unsigned (&x)[16], const unsigned (&y)[16]) {
#pragma unroll
    for (int i = 0; i < 16; ++i) x[i] = x[i] > y[15 - i] ? x[i] : y[15 - i];
    CE(0,8); CE(1,9); CE(2,10); CE(3,11); CE(4,12); CE(5,13); CE(6,14); CE(7,15); CE(0,4); CE(1,5); CE(2,6); CE(3,7); CE(8,12); CE(9,13); CE(10,14); CE(11,15);
    CE(0,2); CE(1,3); CE(4,6); CE(5,7); CE(8,10); CE(9,11); CE(12,14); CE(13,15); CE(0,1); CE(2,3); CE(4,5); CE(6,7); CE(8,9); CE(10,11); CE(12,13); CE(14,15);
}
#undef CE
__device__ __forceinline__ unsigned f2key(float f) { const unsigned u = __builtin_bit_cast(unsigned, f); return u ^ ((unsigned)((int)u >> 31) | 0x80000000u); }
__device__ __forceinline__ float key2f(unsigned k) { return __builtin_bit_cast(float, (k & 0x80000000u) ? (k ^ 0x80000000u) : ~k); }
__device__ __forceinline__ unsigned lut16(const unsigned (&p)[4], unsigned i) {
    const unsigned q = i >> 2; const unsigned w = q == 0 ? p[0] : q == 1 ? p[1] : q == 2 ? p[2] : p[3];
    return (w >> ((i & 3u) * 8u)) & 0xffu;
}
__device__ __forceinline__ void peer_half_topk(const bf16* SKhp, const bf16* qrow, int r32, int hh, unsigned (&T)[16]) {
    bf16x8 bq[4];
#pragma unroll
    for (int s = 0; s < 4; ++s) bq[s] = *(const bf16x8*)(qrow + 16 * s + 8 * hh);
    unsigned G_[16];
#pragma unroll
    for (int i = 0; i < 16; ++i) T[i] = 0u;
#pragma unroll 1
    for (int nt = 0; nt < 4; ++nt) {
        f32x16 acc = {};
#pragma unroll
        for (int s = 0; s < 4; ++s) { const bf16x8 a = *(const bf16x8*)(SKhp + (nt * 32 + r32) * 64 + 16 * s + 8 * hh); acc = __builtin_amdgcn_mfma_f32_32x32x16_bf16(a, bq[s], acc, 0, 0, 0); }
#pragma unroll
        for (int r = 0; r < 16; ++r) { const unsigned n = nt * 32 + (r & 3) + 8 * (r >> 2) + 4 * hh; G_[r] = (f2key(acc[r]) & ~0x7fu) | n; }
        sort16(G_);
        merge16(T, G_);
    }
#pragma unroll
    for (int i = 0; i < 16; ++i) G_[i] = (unsigned)__shfl_xor((int)T[i], 32);
    merge16(T, G_);
}
__device__ __forceinline__ void peer_topk_phase(Frame& F) {
    const int lane = F.lane, wave = F.wave, r32 = lane & 31, hh = lane >> 5;
    for (int unit = F.vcu; unit < M / 256; unit += F.G) {
        const int tok = unit * 256 + wave * 32 + r32;
        const float rstd = 1.0f / sqrtf(F.SSQ[tok] * (1.f / D) + NORM_EPS);
#pragma unroll 1
        for (int h = 0; h < 8; ++h) {
            unsigned T1[16], T2[16];
            peer_half_topk(F.SK + (size_t)(h * 2 + 0) * 128 * 64, F.QP + (size_t)tok * 1024 + h * 128, r32, hh, T1);
            peer_half_topk(F.SK + (size_t)(h * 2 + 1) * 128 * 64, F.QP + (size_t)tok * 1024 + h * 128 + 64, r32, hh, T2);
            float v1[16], v2[16]; unsigned p1[4] = {0u, 0u, 0u, 0u}, p2[4] = {0u, 0u, 0u, 0u};
#pragma unroll
            for (int i = 0; i < 16; ++i) { v1[i] = key2f(T1[i] & ~0x7fu); v2[i] = key2f(T2[i] & ~0x7fu); p1[i >> 2] |= (T1[i] & 0x7fu) << ((i & 3) * 8); p2[i >> 2] |= (T2[i] & 0x7fu) << ((i & 3) * 8); }
            unsigned C[16], Gc[16];
#define CK(i, j) ((f2key(v1[i] + v2[j]) & ~0xffu) | (unsigned)((i) * 16 + (j)))
            Gc[0] = CK(0,0); Gc[1] = CK(0,1); Gc[2] = CK(0,2); Gc[3] = CK(0,3); Gc[4] = CK(0,4); Gc[5] = CK(0,5); Gc[6] = CK(0,6); Gc[7] = CK(0,7); Gc[8] = CK(0,8); Gc[9] = CK(0,9); Gc[10] = CK(0,10); Gc[11] = CK(0,11); Gc[12] = CK(0,12); Gc[13] = CK(0,13); Gc[14] = CK(0,14); Gc[15] = CK(0,15);
            sort16(Gc);
            _Pragma("unroll") for (int e = 0; e < 16; ++e) C[e] = Gc[e];
            Gc[0] = CK(1,0); Gc[1] = CK(1,1); Gc[2] = CK(1,2); Gc[3] = CK(1,3); Gc[4] = CK(1,4); Gc[5] = CK(1,5); Gc[6] = CK(1,6); Gc[7] = CK(1,7); Gc[8] = CK(2,0); Gc[9] = CK(2,1); Gc[10] = CK(2,2); Gc[11] = CK(2,3); Gc[12] = CK(2,4); Gc[13] = CK(3,0); Gc[14] = CK(3,1); Gc[15] = CK(3,2);
            sort16(Gc);
            merge16(C, Gc);
            Gc[0] = CK(3,3); Gc[1] = CK(4,0); Gc[2] = CK(4,1); Gc[3] = CK(4,2); Gc[4] = CK(5,0); Gc[5] = CK(5,1); Gc[6] = CK(6,0); Gc[7] = CK(6,1); Gc[8] = CK(7,0); Gc[9] = CK(7,1); Gc[10] = CK(8,0); Gc[11] = CK(9,0); Gc[12] = CK(10,0); Gc[13] = CK(11,0); Gc[14] = CK(12,0); Gc[15] = CK(13,0);
            sort16(Gc);
            merge16(C, Gc);
            Gc[0] = CK(14,0); Gc[1] = CK(15,0); Gc[2] = 0u; Gc[3] = 0u; Gc[4] = 0u; Gc[5] = 0u; Gc[6] = 0u; Gc[7] = 0u; Gc[8] = 0u; Gc[9] = 0u; Gc[10] = 0u; Gc[11] = 0u; Gc[12] = 0u; Gc[13] = 0u; Gc[14] = 0u; Gc[15] = 0u;
            sort16(Gc);
            merge16(C, Gc);
#undef CK
            float gsum = 0.f, gv[16]; int ex[16];
            const float top = key2f(C[0] & ~0xffu) * rstd;
#pragma unroll
            for (int k = 0; k < 16; ++k) {
                const float e = __builtin_amdgcn_exp2f((key2f(C[k] & ~0xffu) * rstd - top) * LOG2E); gv[k] = e; gsum += e;
                ex[k] = (int)(lut16(p1, (C[k] >> 4) & 15u) * 128u + lut16(p2, C[k] & 15u));
            }
            const float ginv = 1.0f / gsum;
            int* ip = F.IDX + (size_t)tok * 128 + h * 16 + hh * 8; float* gp = F.GATE + (size_t)tok * 128 + h * 16 + hh * 8;
            typedef int i32x4 __attribute__((ext_vector_type(4)));
            i32x4 i0, i1; f32x4 g0, g1;
#pragma unroll
            for (int k = 0; k < 4; ++k) { i0[k] = hh ? ex[8 + k] : ex[k]; i1[k] = hh ? ex[12 + k] : ex[4 + k]; g0[k] = (hh ? gv[8 + k] : gv[k]) * ginv; g1[k] = (hh ? gv[12 + k] : gv[4 + k]) * ginv; }
            *(i32x4*)ip = i0; *(i32x4*)(ip + 4) = i1; *(f32x4*)gp = g0; *(f32x4*)(gp + 4) = g1;
        }
    }
}

__device__ __forceinline__ void peer_gather_phase(Frame& F) {
    const int lane = F.lane, rw = lane >> 4, c = lane & 15;
    const int gw = F.vcu * NWAVES + F.wave, NGW = F.G * NWAVES;
    const float* wfin = F.in[I_NFINAL];
#pragma unroll 1
    for (int tok = gw; tok < M; tok += NGW) {
        const bf16* hb = F.HB + (size_t)tok * 1024 + c * 8;
        v4u hv[8];
#pragma unroll
        for (int k = 0; k < 8; ++k) hv[k] = *(const v4u*)(hb + k * 128);
        const float rstd = 1.0f / sqrtf(F.SSQ[tok] * (1.f / D) + NORM_EPS);
        const int id0 = F.IDX[(size_t)tok * 128 + rw * 32 + c], id1 = F.IDX[(size_t)tok * 128 + rw * 32 + 16 + c];
        const float ga0 = F.GATE[(size_t)tok * 128 + rw * 32 + c], ga1 = F.GATE[(size_t)tok * 128 + rw * 32 + 16 + c];
        float out[64];
#pragma unroll
        for (int i = 0; i < 64; ++i) out[i] = 0.f;
#pragma unroll 1
        for (int ps = 0; ps < 32; ++ps) {
            const int srcl = (lane & 48) | (ps & 15);
            const int e = __shfl(ps < 16 ? id0 : id1, srcl); const float gt = __shfl(ps < 16 ? ga0 : ga1, srcl);
            const bf16* up = F.UT + (size_t)e * 1024 + c * 8; const bf16* vp = F.VT + (size_t)e * 1024 + c * 8;
            v4u uu[8], vv[8];
#pragma unroll
            for (int k = 0; k < 8; ++k) uu[k] = *(const v4u*)(up + k * 128);
#pragma unroll
            for (int k = 0; k < 8; ++k) vv[k] = *(const v4u*)(vp + k * 128);
            float dot = 0.f;
#pragma unroll
            for (int k = 0; k < 8; ++k) {
                dot = __builtin_amdgcn_fdot2_f32_bf16(as_bf2(uu[k].x), as_bf2(hv[k].x), dot, false);
                dot = __builtin_amdgcn_fdot2_f32_bf16(as_bf2(uu[k].y), as_bf2(hv[k].y), dot, false);
                dot = __builtin_amdgcn_fdot2_f32_bf16(as_bf2(uu[k].z), as_bf2(hv[k].z), dot, false);
                dot = __builtin_amdgcn_fdot2_f32_bf16(as_bf2(uu[k].w), as_bf2(hv[k].w), dot, false);
            }
            dot = allreduce16(dot);
            const float act = gelu_erf(dot * rstd) * gt;
            const unsigned ab = f2bf(act);
            const bf16x2_t alo = as_bf2(ab), ahi = as_bf2(ab << 16);
#pragma unroll
            for (int k = 0; k < 8; ++k) {
                const unsigned w_[4] = {vv[k].x, vv[k].y, vv[k].z, vv[k].w};
#pragma unroll
                for (int q = 0; q < 4; ++q) {
                    out[k * 8 + 2 * q] = __builtin_amdgcn_fdot2_f32_bf16(as_bf2(w_[q]), alo, out[k * 8 + 2 * q], false);
                    out[k * 8 + 2 * q + 1] = __builtin_amdgcn_fdot2_f32_bf16(as_bf2(w_[q]), ahi, out[k * 8 + 2 * q + 1], false);
                }
            }
        }
        float s1[32];
#pragma unroll
        for (int i = 0; i < 32; ++i) { const auto r_ = __builtin_amdgcn_permlane16_swap(f2u(out[i]), f2u(out[i + 32]), false, false); const unsigned ra_ = r_[0], rb_ = r_[1]; s1[i] = u2f(ra_) + u2f(rb_); }
        float s2[16];
#pragma unroll
        for (int i = 0; i < 16; ++i) { const auto r_ = __builtin_amdgcn_permlane32_swap(f2u(s1[i]), f2u(s1[i + 16]), false, false); const unsigned ra_ = r_[0], rb_ = r_[1]; s2[i] = u2f(ra_) + u2f(rb_); }
        const int kb = 4 * (rw & 1) + 2 * (rw >> 1);
        float* orow = F.out + (size_t)tok * 1024 + c * 8;
        f32x4 hq[4]; float ss = 0.f;
#pragma unroll
        for (int kq = 0; kq < 2; ++kq)
#pragma unroll
            for (int hf = 0; hf < 2; ++hf) {
                f32x4 x = *(const f32x4*)(orow + (kb + kq) * 128 + hf * 4);
#pragma unroll
#ifdef DBG_NO_PEER
                for (int e = 0; e < 4; ++e) { ss += x[e] * x[e]; }
#else
                for (int e = 0; e < 4; ++e) { x[e] += s2[kq * 8 + hf * 4 + e]; ss += x[e] * x[e]; }
#endif
                hq[kq * 2 + hf] = x;
            }
        const float rf = 1.0f / sqrtf(wave_sum(ss) * (1.f / D) + NORM_EPS);
#pragma unroll
        for (int kq = 0; kq < 2; ++kq)
#pragma unroll
            for (int hf = 0; hf < 2; ++hf) {
                const f32x4 w = *(const f32x4*)(wfin + (kb + kq) * 128 + c * 8 + hf * 4);
                *(f32x4*)(orow + (kb + kq) * 128 + hf * 4) = hq[kq * 2 + hf] * rf * w;
            }
    }
}

#ifndef MK_N_LAUNCHES
#define MK_N_LAUNCHES 1
#endif
constexpr int N_PHASES = 10;
struct Args { const float* in[24]; float* out; unsigned char* ws; int ph_lo, ph_hi; };
__global__ void __launch_bounds__(NWAVES * 64, 2) mega_fwd(Args args) {
    extern __shared__ __attribute__((aligned(16))) unsigned char lds[];
    Frame F;
    F.lds = (LAS unsigned char*)lds;
    F.MISC = (volatile LAS unsigned*)(F.lds + MISC_OFF);
    F.tid = threadIdx.x; F.lane = F.tid & 63; F.wave = __builtin_amdgcn_readfirstlane(F.tid >> 6);
    F.G = gridDim.x; { const int bx = blockIdx.x; F.vcu = (F.G % 8 == 0) ? (bx % 8) * (F.G / 8) + bx / 8 : bx; }
    unsigned char* ws = args.ws;
    F.ctl = (gu32*)(ws + WS_CTL);
#pragma unroll
    for (int i = 0; i < 24; ++i) F.in[i] = args.in[i];
    F.out = args.out;
    F.ROPE = (float*)(ws + WS_ROPE); F.SSQ = (float*)(ws + WS_SSQ);
    F.WIN = (bf16*)(ws + WS_WIN); F.PA = (bf16*)(ws + WS_PA); F.PB = (bf16*)(ws + WS_PB); F.WOUT = (bf16*)(ws + WS_WOUT); F.WQ = (bf16*)(ws + WS_WQ); F.LW = (bf16*)(ws + WS_LW);
    F.SK = (bf16*)(ws + WS_SK); F.UT = (bf16*)(ws + WS_UT); F.VT = (bf16*)(ws + WS_VT); F.XN = (bf16*)(ws + WS_XN); F.LA = (bf16*)(ws + WS_LA); F.YA = (bf16*)(ws + WS_YA);
    F.QKV = (bf16*)(ws + WS_QKV); F.YB = (bf16*)(ws + WS_YB); F.RKV = (bf16*)(ws + WS_RKV); F.HB = (bf16*)(ws + WS_HB); F.LORA = (bf16*)(ws + WS_LORA);
    F.GA = (bf16*)(ws + WS_GA); F.GB = (bf16*)(ws + WS_GB); F.DAG = (bf16*)(ws + WS_DAG); F.QP = (bf16*)(ws + WS_QP);
    F.IDX = (int*)(ws + WS_IDX); F.GATE = (float*)(ws + WS_GATE);
    for (int u = F.tid; u < (LDS_BYTES - LDSCTL_OFF) / 4; u += NWAVES * 64) ((LAS unsigned*)(F.lds + LDSCTL_OFF))[u] = 0u;
    __syncthreads();
    XcdBarrier bar; bar.bar = (unsigned*)(F.ctl + CW_BAR); bar.x = 0; bar.st = nullptr;
    const bool multi = (args.ph_hi - args.ph_lo) > 1;
    if (multi) bar = xcd_barrier_post((unsigned*)(F.ctl + CW_BAR), F.MISC + 8);
    const int lo = args.ph_lo, hi = args.ph_hi;
#ifndef PH_MASK
#define PH_MASK 0x3ff
#endif
#define IN(k) ((((PH_MASK) >> (k)) & 1) && lo <= (k) && (k) < hi)
#define SEAM(k) do { if (IN(k) && IN((k) + 1)) xcd_barrier(bar); } while (0)
    if (IN(0)) { p0_prologue(F); }
    SEAM(0);
    if (IN(1)) {
        pg8::Gemm g{F.XN, F.WIN, M, NZ, D}; pg8::StaticOrder S; S.init(M, NZ, F.G, (int)blockIdx.x);
        pg8::EpiZ E{F.QKV, F.RKV, F.LORA, F.GA, F.GB, F.ROPE, QSCALE};
        pg8::gemm_phase<pg8::EpiZ, pg8::StaticOrder, true, true>(F.lds, g, S, E);
    }
    SEAM(1);
    if (IN(2)) { attn_phase(F); lora_prep_phase(F); }
    SEAM(2);
    if (IN(3)) {
#ifndef P3_NO_A
        { pg8::Gemm g{F.LA, F.LW, M, 1536, 384}; pg8::StaticOrder S; S.init(M, 1536, F.G, (int)blockIdx.x);
          pg8::EpiDAG E{F.DAG, F.in[I_W0], F.in[I_A0]};
          pg8::gemm_phase<pg8::EpiDAG, pg8::StaticOrder, true, true>(F.lds, g, S, E); }
#endif
#ifndef P3_NO_B
        { pg8::Gemm g{F.YA, F.PA, M, 1024, 512}; pg8::StaticOrder S; S.init(M, 1024, F.G, (int)blockIdx.x);
          pg8::EpiGate<0> E{F.GA, nullptr};
          pg8::gemm_phase<pg8::EpiGate<0>, pg8::StaticOrder, true, true>(F.lds, g, S, E); }
#endif
    }
    SEAM(3);
    if (IN(4)) { scan_phase(F); }
    SEAM(4);
    if (IN(5)) {
        pg8::Gemm g{F.YB, F.PB, M, 1024, 512}; pg8::StaticOrder S; S.init(M, 1024, F.G, (int)blockIdx.x);
        pg8::EpiGate<1> E{F.GA, F.GB};
        pg8::gemm_phase<pg8::EpiGate<1>, pg8::StaticOrder, true, true>(F.lds, g, S, E);
    }
    SEAM(5);
    if (IN(6)) {
        pg8::Gemm g{F.GA, F.WOUT, M, 1024, 1024}; pg8::StaticOrder S; S.init(M, 1024, F.G, (int)blockIdx.x);
        pg8::EpiH E{F.in[I_X], F.out, F.HB, F.SSQ};
        pg8::gemm_phase<pg8::EpiH, pg8::StaticOrder, true, true>(F.lds, g, S, E);
    }
    SEAM(6);
    if (IN(7)) {
        pg8::Gemm g{F.HB, F.WQ, M, 1024, 1024}; pg8::StaticOrder S; S.init(M, 1024, F.G, (int)blockIdx.x);
        pg8::EpiPlain E{F.QP, 1024};
        pg8::gemm_phase<pg8::EpiPlain, pg8::StaticOrder, true, true>(F.lds, g, S, E);
    }
    SEAM(7);
    if (IN(8)) { peer_topk_phase(F); }
    SEAM(8);
    if (IN(9)) { peer_gather_phase(F); }
#undef IN
#undef SEAM
}

extern "C" void kernel_launch(void* const* d_in, const int* in_sizes, int n_in, void* d_out, int out_size, void* d_ws, size_t ws_size, hipStream_t stream) {
    static int grid = 0;
    if (grid == 0) {
        if (n_in != 24 || in_sizes[0] != M * D || out_size != M * D || ws_size < WS_END) { fprintf(stderr, "kernel_launch: unexpected problem (n_in %d, in0 %d, out %d, ws %zu < %zu); nothing launched\n", n_in, n_in > 0 ? in_sizes[0] : -1, out_size, ws_size, (size_t)WS_END); grid = -1; return; }
        int dev = 0, cus = 0, per_cu = 0;
        if (hipGetDevice(&dev) != hipSuccess || hipDeviceGetAttribute(&cus, hipDeviceAttributeMultiprocessorCount, dev) != hipSuccess) { fprintf(stderr, "kernel_launch: device query failed\n"); grid = -1; return; }
        if (hipFuncSetAttribute((const void*)mega_fwd, hipFuncAttributeMaxDynamicSharedMemorySize, LDS_BYTES) != hipSuccess) { fprintf(stderr, "kernel_launch: hipFuncSetAttribute failed\n"); grid = -1; return; }
        if (hipOccupancyMaxActiveBlocksPerMultiprocessor(&per_cu, (const void*)mega_fwd, NWAVES * 64, LDS_BYTES) != hipSuccess || per_cu < 1)
            fprintf(stderr, "kernel_launch: note: occupancy query reports %d workgroups per CU\n", per_cu);
        (void)hipGetLastError();
        grid = cus;
    }
    if (grid < 0) return;
    if (hipMemsetAsync((char*)d_ws + WS_CTL, 0, CTL_ZERO_BYTES, stream) != hipSuccess) { fprintf(stderr, "kernel_launch: memset failed\n"); return; }
    Args a{};
    for (int i = 0; i < 24; ++i) a.in[i] = (const float*)d_in[i];
    a.out = (float*)d_out; a.ws = (unsigned char*)d_ws;
#if MK_N_LAUNCHES == 1
    a.ph_lo = 0; a.ph_hi = N_PHASES;
    hipLaunchKernelGGL(mega_fwd, dim3(grid), dim3(NWAVES * 64), LDS_BYTES, stream, a);
#else
    for (int p = 0; p < N_PHASES; ++p) { a.ph_lo = p; a.ph_hi = p + 1; hipLaunchKernelGGL(mega_fwd, dim3(grid), dim3(NWAVES * 64), LDS_BYTES, stream, a); }
#endif
    const hipError_t le = hipPeekAtLastError();
    if (le != hipSuccess) fprintf(stderr, "kernel_launch: launch failed: %s\n", hipGetErrorName(le));
}
```

```cpp
#include <hip/hip_runtime.h>
#include <cstdio>
#include <cstdint>
namespace pg8 {
#define PG8_LAS __attribute__((address_space(3)))
typedef unsigned short bf16_t;
typedef short bf16x8 __attribute__((ext_vector_type(8)));
typedef float f32x4 __attribute__((ext_vector_type(4)));
typedef unsigned u32x4 __attribute__((ext_vector_type(4)));
constexpr int BM = 256, BK = 64, HALF = 128, HTB = HALF * BK * 2  , STAGE_BYTES = 8 * HTB, NXCD = 8, WGM = 8;

__host__ __device__ __forceinline__ int lds_byte(int r, int c) { const int st = (r >> 4) * 2 + (c >> 5), rr = r & 15, cc = c & 31, ob = rr * 64 + cc * 2; return st * 1024 + (ob ^ (((ob >> 9) & 1) << 5)); }
__host__ __device__ __forceinline__ void stage_rc(int b, int& R, int& C) { const int st = b / 1024, sb = b % 1024, swz = sb ^ (((sb >> 9) & 1) << 5); R = (st >> 1) * 16 + swz / 64; C = (st & 1) * 32 + (swz % 64) / 2; }
__host__ __device__ __forceinline__ int perm32(int rho) { const int n = rho >> 4, i = rho & 15; return 8 * (i >> 2) + 4 * n + (i & 3); }

struct Unit { int pm, pn; };
struct Gemm { const bf16_t* A; const bf16_t* Bt; int M, N, K; };

struct StaticOrder {
    int nM, nN, nwg, G, c;
    __host__ __device__ void init(int M, int N, int G_, int c_) { nM = M / BM; nN = N / BM; nwg = nM * nN; G = G_; c = c_; }
    __host__ __device__ bool next(int i, Unit& u) const {
        const long L = (long)i * G + c; if (L >= nwg) return false;
        int wgid = (int)L; { const int q = nwg / NXCD, r = nwg % NXCD, xcd = wgid % NXCD, off = wgid / NXCD; wgid = (xcd < r ? xcd * (q + 1) : r * (q + 1) + (xcd - r) * q) + off; }
        const int nig = WGM * nN, gid = wgid / nig, fm = gid * WGM, gsz = (nM - fm) < WGM ? (nM - fm) : WGM;
        u.pm = fm + ((wgid % nig) % gsz); u.pn = (wgid % nig) / gsz; return true;
    }
    __device__ __forceinline__ void a_ready(const Unit&) const {}
    __device__ __forceinline__ void done(const Unit&) const {}
};

__device__ __forceinline__ unsigned cvt_pk_bf16(float lo, float hi) { unsigned r; asm volatile("v_cvt_pk_bf16_f32 %0, %1, %2" : "=v"(r) : "v"(lo), "v"(hi)); return r; }
typedef float f32x2 __attribute__((ext_vector_type(2)));
__device__ __forceinline__ f32x2 gelu_pk(f32x2 v) {
    const f32x2 av = __builtin_elementwise_abs(v), d = av * 0.2316418882f + 1.0f;
    f32x2 t; t.x = __builtin_amdgcn_rcpf(d.x); t.y = __builtin_amdgcn_rcpf(d.y);
    f32x2 q = t * 0.5307027145f + (-0.7265760135f); q = q * t + 0.7107068705f; q = q * t + (-0.142248368f); q = q * t + 0.127414796f; q = q * t;
    const f32x2 s = (v * v) * (-0.72134752044f);
    f32x2 e; e.x = __builtin_amdgcn_exp2f(s.x); e.y = __builtin_amdgcn_exp2f(s.y);
    const f32x2 m = v * (q * e), r = v - m;
    f32x2 o; o.x = v.x < 0.f ? m.x : r.x; o.y = v.y < 0.f ? m.y : r.y; return o;
}

__device__ __forceinline__ float sigm(float x) { return __builtin_amdgcn_rcpf(1.0f + __builtin_amdgcn_exp2f(-1.4426950408889634f * x)); }
__device__ __forceinline__ u32x4 pack8(const f32x4 v0, const f32x4 v1) { u32x4 w; w.x = cvt_pk_bf16(v0[0], v0[1]); w.y = cvt_pk_bf16(v0[2], v0[3]); w.z = cvt_pk_bf16(v1[0], v1[1]); w.w = cvt_pk_bf16(v1[2], v1[3]); return w; }
__device__ __forceinline__ float bflo(unsigned w) { return __builtin_bit_cast(float, w << 16); }
__device__ __forceinline__ float bfhi(unsigned w) { return __builtin_bit_cast(float, w & 0xffff0000u); }

struct EpiZ {
    static constexpr bool PERM = true, AFTER_DRAIN = false;
    bf16_t *QKV, *RKV, *LORA, *GA, *GB; const float* cs; float qscale;
    __device__ __forceinline__ void operator()(const f32x4 (&acc)[2][2][4][2], const Unit& u, int wr, int wc, int fr, int fq) const {
        const int pn = u.pn;
        bf16_t* base; int ld, colt, mode;
        if (pn < 3)       { base = QKV;  ld = 768;  colt = pn * 256;        mode = (pn < 2) ? 1 : 2; }
        else if (pn < 9)  { base = RKV;  ld = 1536; colt = (pn - 3) * 256;  mode = 0; }
        else if (pn < 11) { base = LORA; ld = 512;  colt = (pn - 9) * 256;  mode = 0; }
        else if (pn < 15) { base = GA;   ld = 1024; colt = (pn - 11) * 256; mode = 3; }
        else              { base = GB;   ld = 1024; colt = (pn - 15) * 256; mode = 3; }
        const int row0 = u.pm * BM + wr * 64 + fr, col0 = colt + wc * 32 + 8 * fq;
        const int i0 = 16 * (wc & 1) + 4 * fq;
#pragma unroll
        for (int ai = 0; ai < 2; ++ai)
#pragma unroll
            for (int m = 0; m < 4; ++m) {
                const int row = row0 + ai * HALF + m * 16;
                bf16_t* rowp = base + (size_t)row * ld + col0;
                f32x4 c0 = (f32x4){1.f, 0.f, 1.f, 0.f}, c1 = c0;
                if (mode == 1 || mode == 2) { const f32x4* cp = (const f32x4*)(cs + ((size_t)(row & 2047) * 32 + i0) * 2); c0 = cp[0]; c1 = cp[1]; }
#pragma unroll
                for (int bj = 0; bj < 2; ++bj) {
                    f32x4 v0 = acc[ai][bj][m][0], v1 = acc[ai][bj][m][1];
                    if (mode == 1 || (mode == 2 && bj == 0)) {
                        f32x4 r0, r1;
                        r0[0] = v0[0] * c0[0] - v0[1] * c0[1]; r0[1] = v0[1] * c0[0] + v0[0] * c0[1];
                        r0[2] = v0[2] * c0[2] - v0[3] * c0[3]; r0[3] = v0[3] * c0[2] + v0[2] * c0[3];
                        r1[0] = v1[0] * c1[0] - v1[1] * c1[1]; r1[1] = v1[1] * c1[0] + v1[0] * c1[1];
                        r1[2] = v1[2] * c1[2] - v1[3] * c1[3]; r1[3] = v1[3] * c1[2] + v1[2] * c1[3];
                        if (mode == 1) { r0 = r0 * qscale; r1 = r1 * qscale; }
                        v0 = r0; v1 = r1;
                    } else if (mode == 3) {
#pragma unroll
                        for (int e = 0; e < 4; ++e) { v0[e] = sigm(v0[e]); v1[e] = sigm(v1[e]); }
                    }
                    if (base == RKV) {
                        const int j = col0 + bj * HALF, which = j >> 9, hh = (j >> 6) & 7, d = j & 63;
                        *(u32x4*)(RKV + ((size_t)(((row >> 11) * 8 + hh) * 2048 + (row & 2047))) * 192 + which * 64 + d) = pack8(v0, v1);
                    } else
                    *(u32x4*)(rowp + bj * HALF) = pack8(v0, v1);
                }
            }
    }
};
struct EpiDAG {
    static constexpr bool PERM = true, AFTER_DRAIN = false;
    bf16_t* DAG; const float* w0; const float* a0;
    __device__ __forceinline__ void operator()(const f32x4 (&acc)[2][2][4][2], const Unit& u, int wr, int wc, int fr, int fq) const {
        const int pn = u.pn, mode = pn >> 1;
        const int row0 = u.pm * BM + wr * 64 + fr, col0 = pn * BM + wc * 32 + 8 * fq;
#pragma unroll
        for (int bj = 0; bj < 2; ++bj) {
            f32x4 b0 = (f32x4){0.f, 0.f, 0.f, 0.f}, b1 = b0;
            if (mode == 0) { b0 = *(const f32x4*)(w0 + col0 + bj * HALF); b1 = *(const f32x4*)(w0 + col0 + bj * HALF + 4); }
            else if (mode == 1) { b0 = *(const f32x4*)(a0 + (col0 - 512) + bj * HALF); b1 = *(const f32x4*)(a0 + (col0 - 512) + bj * HALF + 4); }
            const float sc = (mode == 0) ? 0.6065306597126334f : 1.0f;
#pragma unroll
            for (int ai = 0; ai < 2; ++ai)
#pragma unroll
                for (int m = 0; m < 4; ++m) {
                    const int row = row0 + ai * HALF + m * 16, j = col0 + bj * HALF;
                    bf16_t* rowp = DAG + ((size_t)(((row >> 11) * 8 + ((j >> 6) & 7)) * 2048 + (row & 2047))) * 192 + (j >> 9) * 64 + (j & 63);
                    f32x4 v0 = acc[ai][bj][m][0] + b0, v1 = acc[ai][bj][m][1] + b1;
                    if (mode < 2) {
#pragma unroll
                        for (int e = 0; e < 4; ++e) { v0[e] = sigm(v0[e]) * sc; v1[e] = sigm(v1[e]) * sc; }
                    }
                    *(u32x4*)rowp = pack8(v0, v1);
                    asm volatile("" ::: "memory");
                }
        }
    }
};
template <int SECOND> struct EpiGate {
    static constexpr bool PERM = true, AFTER_DRAIN = false;
    bf16_t* G; const bf16_t* G2;
    __device__ __forceinline__ void operator()(const f32x4 (&acc)[2][2][4][2], const Unit& u, int wr, int wc, int fr, int fq) const {
        const int row0 = u.pm * BM + wr * 64 + fr, col0 = u.pn * BM + wc * 32 + 8 * fq;
#pragma unroll
        for (int ai = 0; ai < 2; ++ai)
#pragma unroll
            for (int m = 0; m < 4; ++m) {
                const size_t off = (size_t)(row0 + ai * HALF + m * 16) * 1024 + col0;
#pragma unroll
                for (int bj = 0; bj < 2; ++bj) {
                    const u32x4 g = *(const u32x4*)(G + off + bj * HALF);
                    f32x4 v0 = acc[ai][bj][m][0], v1 = acc[ai][bj][m][1];
                    if (SECOND) {
                        const u32x4 h = *(const u32x4*)(G2 + off + bj * HALF);
                        v0[0] = bflo(g.x) + bflo(h.x) * v0[0]; v0[1] = bfhi(g.x) + bfhi(h.x) * v0[1]; v0[2] = bflo(g.y) + bflo(h.y) * v0[2]; v0[3] = bfhi(g.y) + bfhi(h.y) * v0[3];
                        v1[0] = bflo(g.z) + bflo(h.z) * v1[0]; v1[1] = bfhi(g.z) + bfhi(h.z) * v1[1]; v1[2] = bflo(g.w) + bflo(h.w) * v1[2]; v1[3] = bfhi(g.w) + bfhi(h.w) * v1[3];
                    } else {
                        v0[0] *= bflo(g.x); v0[1] *= bfhi(g.x); v0[2] *= bflo(g.y); v0[3] *= bfhi(g.y);
                        v1[0] *= bflo(g.z); v1[1] *= bfhi(g.z); v1[2] *= bflo(g.w); v1[3] *= bfhi(g.w);
                    }
                    *(u32x4*)(G + off + bj * HALF) = pack8(v0, v1);
                }
            }
    }
};
struct EpiH {
    static constexpr bool PERM = true, AFTER_DRAIN = false;
    const float* X; float* Hf; bf16_t* HB; float* ssq;
    __device__ __forceinline__ void operator()(const f32x4 (&acc)[2][2][4][2], const Unit& u, int wr, int wc, int fr, int fq) const {
        const int row0 = u.pm * BM + wr * 64 + fr, col0 = u.pn * BM + wc * 32 + 8 * fq;
#pragma unroll
        for (int ai = 0; ai < 2; ++ai)
#pragma unroll
            for (int m = 0; m < 4; ++m) {
                const int row = row0 + ai * HALF + m * 16;
                const size_t off = (size_t)row * 1024 + col0;
                float s = 0.f;
#pragma unroll
                for (int bj = 0; bj < 2; ++bj) {
                    const f32x4 x0 = *(const f32x4*)(X + off + bj * HALF), x1 = *(const f32x4*)(X + off + bj * HALF + 4);
#ifdef DBG_NO_MIX
                    const f32x4 v0 = x0, v1 = x1;
#else
                    const f32x4 v0 = acc[ai][bj][m][0] + x0, v1 = acc[ai][bj][m][1] + x1;
#endif
                    *(u32x4*)(HB + off + bj * HALF) = pack8(v0, v1);
                    s += (v0[0] * v0[0] + v0[1] * v0[1]) + (v0[2] * v0[2] + v0[3] * v0[3]) + (v1[0] * v1[0] + v1[1] * v1[1]) + (v1[2] * v1[2] + v1[3] * v1[3]);
                }
                s += __shfl_xor(s, 16); s += __shfl_xor(s, 32);
                if (fq == 0) unsafeAtomicAdd(ssq + row, s);
            }
    }
};
struct EpiPlain {
    static constexpr bool PERM = true, AFTER_DRAIN = false;
    bf16_t* O; int ldc;
    __device__ __forceinline__ void operator()(const f32x4 (&acc)[2][2][4][2], const Unit& u, int wr, int wc, int fr, int fq) const {
        const int row0 = u.pm * BM + wr * 64 + fr, col0 = u.pn * BM + wc * 32 + 8 * fq;
#pragma unroll
        for (int ai = 0; ai < 2; ++ai)
#pragma unroll
            for (int m = 0; m < 4; ++m) { bf16_t* rowp = O + (size_t)(row0 + ai * HALF + m * 16) * ldc + col0;
#pragma unroll
                for (int bj = 0; bj < 2; ++bj) *(u32x4*)(rowp + bj * HALF) = pack8(acc[ai][bj][m][0], acc[ai][bj][m][1]); }
    }
};

template <class Epi, class Sched, bool ALIGN_EPI = false, bool SP2 = false>
__device__ __forceinline__ void gemm_phase(PG8_LAS unsigned char* lds, const Gemm g, const Sched& S, const Epi& E) {
    const int tid = threadIdx.x, wid = __builtin_amdgcn_readfirstlane(tid >> 6), lane = tid & 63, wr = wid >> 2, wc = wid & 3, fr = lane & 15, fq = lane >> 4;
    const int K = g.K, nt = K / BK;
    unsigned voffA[2], voffB[2];
#pragma unroll
    for (int i = 0; i < 2; ++i) { int R, C; stage_rc(tid * 16 + i * 8192, R, C); const int Rb = Epi::PERM ? ((R & ~31) + perm32(R & 31)) : R;
        voffA[i] = (unsigned)(R * K + C) * 2u; voffB[i] = (unsigned)(Rb * K + C) * 2u; }
    const size_t kstep = (size_t)(BK * 2);
    const size_t hstep = (size_t)HALF * K * 2;
    const size_t tstep = 2 * hstep;
    const unsigned ldsw = (unsigned)wid * 1024u;
    const int aoff = lds_byte(wr * 64 + fr, fq * 8), boff = lds_byte(wc * 32 + fr, fq * 8);
#define PG8_SA(b, h) (((b) * 2 + (h)) * HTB)
#define PG8_SB(b, h) ((4 + (b) * 2 + (h)) * HTB)
#define PG8_STAGE(bufoff, gbase, voff) do { _Pragma("unroll") for (int _i = 0; _i < 2; ++_i) \
        __builtin_amdgcn_global_load_lds((const unsigned*)((const char*)(gbase) + (voff)[_i]), (PG8_LAS unsigned*)(lds + (bufoff) + ldsw + _i * 8192), 16, 0, 0); } while (0)
#define PG8_LDA(dst, b, h) do { _Pragma("unroll") for (int m = 0; m < 4; ++m) _Pragma("unroll") for (int k = 0; k < 2; ++k) dst[m][k] = *(const PG8_LAS bf16x8*)(lds + PG8_SA(b, h) + aoff + m * 2048 + k * 1024); } while (0)
#define PG8_LDB(dst, b, h) do { _Pragma("unroll") for (int n = 0; n < 2; ++n) _Pragma("unroll") for (int k = 0; k < 2; ++k) dst[n][k] = *(const PG8_LAS bf16x8*)(lds + PG8_SB(b, h) + boff + n * 2048 + k * 1024); } while (0)
#define PG8_MMA(ai, bj, At, Bt) do { __builtin_amdgcn_s_setprio(1); _Pragma("unroll") for (int m = 0; m < 4; ++m) _Pragma("unroll") for (int n = 0; n < 2; ++n) _Pragma("unroll") for (int k = 0; k < 2; ++k) \
        acc[ai][bj][m][n] = __builtin_amdgcn_mfma_f32_16x16x32_bf16(Bt[n][k], At[m][k], acc[ai][bj][m][n], 0, 0, 0); __builtin_amdgcn_s_setprio(0); } while (0)
#define PG8_WAIT_V(n) asm volatile("s_waitcnt vmcnt(" #n ")" ::: "memory")
#define PG8_WAIT_L(n) asm volatile("s_waitcnt lgkmcnt(" #n ")" ::: "memory")
#define PG8_BAR __builtin_amdgcn_s_barrier()
#define PG8_SCHED __builtin_amdgcn_sched_barrier(0)
    Unit cur, nxt; int ui = 0;
    if (!S.next(0, cur)) return;
    f32x4 acc[2][2][4][2];
#pragma unroll
    for (int a = 0; a < 2; ++a)
#pragma unroll
        for (int b = 0; b < 2; ++b)
#pragma unroll
            for (int m = 0; m < 4; ++m)
#pragma unroll
                for (int n = 0; n < 2; ++n) acc[a][b][m][n] = (f32x4){0.f, 0.f, 0.f, 0.f};
    bf16x8 At[4][2], B0[2][2], B1[2][2];
    const char* cA = (const char*)g.A + (size_t)cur.pm * tstep; const char* cB = (const char*)g.Bt + (size_t)cur.pn * tstep;
    S.a_ready(cur);
    if constexpr (SP2) {
        PG8_STAGE(PG8_SB(0, 0), cB, voffB); PG8_STAGE(PG8_SB(0, 1), cB + hstep, voffB); PG8_STAGE(PG8_SA(0, 0), cA, voffA); PG8_STAGE(PG8_SA(0, 1), cA + hstep, voffA);
        if (wr == 1) PG8_BAR;
        PG8_WAIT_V(2); PG8_BAR;
        PG8_STAGE(PG8_SB(1, 0), cB + kstep, voffB); PG8_STAGE(PG8_SA(1, 0), cA + kstep, voffA); PG8_STAGE(PG8_SB(1, 1), cB + hstep + kstep, voffB);
        PG8_WAIT_V(6); PG8_BAR;
    } else {
        PG8_STAGE(PG8_SB(0, 0), cB, voffB); PG8_STAGE(PG8_SA(0, 0), cA, voffA); PG8_STAGE(PG8_SB(0, 1), cB + hstep, voffB); PG8_STAGE(PG8_SA(0, 1), cA + hstep, voffA);
        if (wr == 1) PG8_BAR;
        PG8_WAIT_V(4); PG8_BAR;
        PG8_STAGE(PG8_SB(1, 0), cB + kstep, voffB); PG8_STAGE(PG8_SA(1, 0), cA + kstep, voffA); PG8_STAGE(PG8_SB(1, 1), cB + hstep + kstep, voffB);
        PG8_WAIT_V(6); PG8_BAR;
    }
    for (;;) {
        const bool has_next = S.next(ui + 1, nxt);
        const char* nA = has_next ? (const char*)g.A + (size_t)nxt.pm * tstep : cA; const char* nB = has_next ? (const char*)g.Bt + (size_t)nxt.pn * tstep : cB;
#pragma unroll 1
        for (int t = 0; t < nt; t += 2) {
            const bool last = (t == nt - 2);
            const char* a1 = cA + (size_t)(t + 1) * kstep;
            const char* a2 = last ? nA : cA + (size_t)(t + 2) * kstep; const char* b2 = last ? nB : cB + (size_t)(t + 2) * kstep;
            const char* a3 = a2 + kstep; const char* b3 = b2 + kstep;
            if (last && has_next) S.a_ready(nxt);
            if constexpr (SP2) {
            PG8_LDB(B0, 0, 0); PG8_LDB(B1, 0, 1); PG8_SCHED; PG8_LDA(At, 0, 0); PG8_STAGE(PG8_SA(1, 1), a1 + hstep, voffA);
            PG8_WAIT_V(8); PG8_WAIT_L(0); PG8_BAR; PG8_MMA(0, 0, At, B0); PG8_MMA(0, 1, At, B1); PG8_BAR; PG8_SCHED;
            PG8_LDA(At, 0, 1); PG8_STAGE(PG8_SB(0, 0), b2, voffB); PG8_STAGE(PG8_SB(0, 1), b2 + hstep, voffB); PG8_STAGE(PG8_SA(0, 0), a2, voffA);
            PG8_WAIT_V(8); PG8_WAIT_L(0); PG8_BAR; PG8_MMA(1, 0, At, B0); PG8_MMA(1, 1, At, B1); PG8_BAR; PG8_SCHED;
            PG8_LDB(B0, 1, 0); PG8_LDB(B1, 1, 1); PG8_SCHED; PG8_LDA(At, 1, 0); PG8_STAGE(PG8_SA(0, 1), a2 + hstep, voffA);
            PG8_WAIT_V(8); PG8_WAIT_L(0); PG8_BAR; PG8_MMA(0, 0, At, B0); PG8_MMA(0, 1, At, B1); PG8_BAR; PG8_SCHED;
            PG8_LDA(At, 1, 1); PG8_STAGE(PG8_SB(1, 0), b3, voffB); PG8_STAGE(PG8_SB(1, 1), b3 + hstep, voffB); PG8_STAGE(PG8_SA(1, 0), a3, voffA);
            PG8_WAIT_V(8); PG8_WAIT_L(0); PG8_BAR; PG8_MMA(1, 0, At, B0); PG8_MMA(1, 1, At, B1); PG8_BAR; PG8_SCHED;
            } else {
            PG8_LDB(B0, 0, 0); PG8_SCHED; PG8_LDA(At, 0, 0); PG8_STAGE(PG8_SA(1, 1), a1 + hstep, voffA);
            PG8_WAIT_L(8); PG8_BAR; PG8_WAIT_L(0); PG8_MMA(0, 0, At, B0); PG8_BAR; PG8_SCHED;
            PG8_LDB(B1, 0, 1); PG8_STAGE(PG8_SB(0, 0), b2, voffB);
            PG8_BAR; PG8_WAIT_L(0); PG8_MMA(0, 1, At, B1); PG8_BAR;
            PG8_LDA(At, 0, 1); PG8_STAGE(PG8_SA(0, 0), a2, voffA);
            PG8_BAR; PG8_WAIT_L(0); PG8_MMA(1, 0, At, B0); PG8_BAR; PG8_SCHED;
            PG8_STAGE(PG8_SB(0, 1), b2 + hstep, voffB);
            PG8_WAIT_V(6); PG8_BAR; PG8_MMA(1, 1, At, B1); PG8_BAR;
            PG8_LDB(B0, 1, 0); PG8_SCHED; PG8_LDA(At, 1, 0); PG8_STAGE(PG8_SA(0, 1), a2 + hstep, voffA);
            PG8_WAIT_L(8); PG8_BAR; PG8_WAIT_L(0); PG8_MMA(0, 0, At, B0); PG8_BAR; PG8_SCHED;
            PG8_LDB(B1, 1, 1); PG8_STAGE(PG8_SB(1, 0), b3, voffB);
            PG8_BAR; PG8_WAIT_L(0); PG8_MMA(0, 1, At, B1); PG8_BAR;
            PG8_LDA(At, 1, 1); PG8_STAGE(PG8_SA(1, 0), a3, voffA);
            PG8_BAR; PG8_WAIT_L(0); PG8_MMA(1, 0, At, B0); PG8_BAR; PG8_SCHED;
            PG8_STAGE(PG8_SB(1, 1), b3 + hstep, voffB);
            PG8_WAIT_V(6); PG8_BAR; PG8_MMA(1, 1, At, B1); PG8_BAR;
            }
        }
        if constexpr (ALIGN_EPI) { if (wr == 0) PG8_BAR; }
        if constexpr (!Epi::AFTER_DRAIN) { E(acc, cur, wr, wc, fr, fq); S.done(cur); }
        if (!has_next) break;
#pragma unroll
        for (int a = 0; a < 2; ++a)
#pragma unroll
            for (int b = 0; b < 2; ++b)
#pragma unroll
                for (int m = 0; m < 4; ++m)
#pragma unroll
                    for (int n = 0; n < 2; ++n) acc[a][b][m][n] = (f32x4){0.f, 0.f, 0.f, 0.f};
        cur = nxt; cA = nA; cB = nB; ++ui;
        if constexpr (ALIGN_EPI) { if (wr == 1) PG8_BAR; }
    }
    PG8_WAIT_V(0);
    if constexpr (!ALIGN_EPI) { if (wr == 0) PG8_BAR; }
    PG8_BAR;
    if constexpr (Epi::AFTER_DRAIN) { E.fused(acc, cur, wr, wc, fr, fq, lds, wid, lane); S.done(cur); }
#undef PG8_SA
#undef PG8_SB
#undef PG8_STAGE
#undef PG8_LDA
#undef PG8_LDB
#undef PG8_MMA
#undef PG8_WAIT_V
#undef PG8_WAIT_L
#undef PG8_BAR
#undef PG8_SCHED
}
}
#define GAS __attribute__((address_space(1)))
#define LAS __attribute__((address_space(3)))
typedef unsigned short bf16;
typedef unsigned v4u __attribute__((ext_vector_type(4)));
typedef float f32x4 __attribute__((ext_vector_type(4)));
typedef short bf16x8 __attribute__((ext_vector_type(8)));
typedef GAS unsigned gu32;
typedef GAS unsigned long long gu64;
#define RLX_AGENT __ATOMIC_RELAXED, __HIP_MEMORY_SCOPE_AGENT
#define LDS_WAIT() asm volatile("s_waitcnt lgkmcnt(0)" ::: "memory")
#define VM_WAIT() asm volatile("s_waitcnt vmcnt(0)" ::: "memory")
__device__ __forceinline__ unsigned long long rt() { return __builtin_amdgcn_s_memrealtime(); }
__device__ __forceinline__ unsigned f2bf(float f) { unsigned u = __builtin_bit_cast(unsigned, f); return (u + 0x7fffu + ((u >> 16) & 1u)) >> 16; }
__device__ __forceinline__ unsigned pk2(float lo, float hi) { return f2bf(lo) | (f2bf(hi) << 16); }

#define XB_TMO      128
#define XB_XCNT(j)  (256  + 64 * (j))
#define XB_XSUB(j)  (1280 + 64 * (j))
#define XB_XGEN(j)  (2304 + 64 * (j))
#define XB_TOP      3328
#define XB_TOPGEN   3392
#define XCD_BAR_WORDS 3456
#define XB_SPIN_CAP (1u << 22)

__device__ __forceinline__ unsigned xb_ld(unsigned* p)              { return __hip_atomic_load(p, __ATOMIC_RELAXED, __HIP_MEMORY_SCOPE_AGENT); }
__device__ __forceinline__ unsigned xb_add(unsigned* p, unsigned v) { return __hip_atomic_fetch_add(p, v, __ATOMIC_RELAXED, __HIP_MEMORY_SCOPE_AGENT); }
__device__ __forceinline__ unsigned xb_xcc_id() { return (unsigned)__builtin_amdgcn_s_getreg((3 << 11) | 20) & 0xFu; }
#define XB_SPIN(cond, bar) do { unsigned _sp = 0; while (cond) { __builtin_amdgcn_s_sleep(1); \
    if ((++_sp & 255u) == 0u) { if (xb_ld(&(bar)[XB_TMO])) break; if (_sp > XB_SPIN_CAP) { atomicAdd(&(bar)[XB_TMO], 1u); break; } } } } while (0)

struct XcdBarrier {
    unsigned* bar; unsigned x;
    volatile LAS unsigned* st;
};

__device__ __forceinline__ XcdBarrier xcd_barrier_post(unsigned* bar, volatile LAS unsigned* st) {
    XcdBarrier b; b.bar = bar; b.x = xb_xcc_id(); b.st = st;
    if (threadIdx.x == 0) (void)xb_add(&bar[XB_XCNT(b.x)], 1u);
    return b;
}
__device__ __forceinline__ void xcd_barrier_complete(unsigned* bar, unsigned x, unsigned& nloc, unsigned& nx) {
    const unsigned G = gridDim.x * gridDim.y * gridDim.z;
    unsigned sum, cnt, mine, sp = 0u;
    for (;;) {
        sum = 0u; cnt = 0u; mine = 0u;
#pragma unroll
        for (unsigned j = 0; j < 16; ++j) { const unsigned c = xb_ld(&bar[XB_XCNT(j)]); sum += c; cnt += (c > 0u) ? 1u : 0u; mine = (j == x) ? c : mine; }
        if (sum == G) break;
        __builtin_amdgcn_s_sleep(1);
        if ((++sp & 255u) == 0u) { if (xb_ld(&bar[XB_TMO])) break; if (sp > XB_SPIN_CAP) { atomicAdd(&bar[XB_TMO], 1u); break; } }
    }
    nloc = mine > 0u ? mine : 1u; nx = cnt > 0u ? cnt : 1u;
}

__device__ __forceinline__ void xcd_barrier(const XcdBarrier& b) {
    asm volatile("s_waitcnt vmcnt(0)" ::: "memory");
    __syncthreads();
    if (threadIdx.x == 0) {
        unsigned* bar = b.bar;
        __builtin_amdgcn_s_waitcnt(0);
        unsigned nloc = b.st[0], nx = b.st[1];
        if (nloc == 0u) { xcd_barrier_complete(bar, b.x, nloc, nx); b.st[0] = nloc; b.st[1] = nx; }
        const unsigned old = xb_add(&bar[XB_XSUB(b.x)], 1u);
        const unsigned gen = old / nloc;
        if (old + 1u == (gen + 1u) * nloc) {
            __builtin_amdgcn_fence(__ATOMIC_RELEASE, "agent");
            asm volatile("s_waitcnt vmcnt(0)" ::: "memory");
            const unsigned og = xb_add(&bar[XB_TOP], 1u);
            const unsigned tg = og / nx;
            if (og + 1u == (tg + 1u) * nx) xb_add(&bar[XB_TOPGEN], 1u);
            else XB_SPIN(xb_ld(&bar[XB_TOPGEN]) == tg, bar);
            __builtin_amdgcn_fence(__ATOMIC_ACQUIRE, "agent");
            xb_add(&bar[XB_XGEN(b.x)], 1u);
            asm volatile("s_waitcnt vmcnt(0)" ::: "memory");
        } else {
            XB_SPIN(xb_ld(&bar[XB_XGEN(b.x)]) == gen, bar);
            __builtin_amdgcn_fence(__ATOMIC_ACQUIRE, "agent");
            asm volatile("s_waitcnt vmcnt(0)" ::: "memory");
        }
    }
    __syncthreads();
}

#ifndef DUP_PHASE
#define DUP_PHASE -1
#endif
constexpr int NWAVES = 8;
constexpr int BATCH = 32, SEQ = 2048, D = 1024, M = BATCH * SEQ;
constexpr int IN_COLS = 4640, NZ = 4864;
constexpr int NEXP = 16384;
constexpr float NORM_EPS = 1e-5f, GN_EPS = 64e-5f, LOG2E = 1.4426950408889634f;
constexpr float QSCALE = 0.125f * LOG2E;
constexpr float U6_SCALE = 64.0f, V6_SCALE = 5.656854249f, H8_SCALE = 16.0f, A8_SCALE = 64.0f;
#ifndef U_FP4
#define U_FP4 1
#endif
#ifndef V_FP4
#define V_FP4 1
#endif
constexpr int U_ROW = U_FP4 ? 512 : 768, V_ROW = V_FP4 ? 512 : 768;

constexpr size_t MiB = 1u << 20;
constexpr size_t WS_CTL = 0, CTL_ZERO_BYTES = 64 * 1024;
constexpr size_t WS_ROPE = 1 * MiB;
constexpr size_t WS_SSQ = 1 * MiB + 512 * 1024;
constexpr size_t WS_WIN = 2 * MiB;
constexpr size_t WS_PA = 12 * MiB, WS_PB = 13 * MiB, WS_WOUT = 14 * MiB, WS_WQ = 16 * MiB, WS_LW = 18 * MiB;
constexpr size_t WS_SK = 19 * MiB + 512 * 1024;
constexpr size_t WS_U8 = 20 * MiB, WS_V8 = 36 * MiB;
constexpr size_t WS_XN = 84 * MiB;
constexpr size_t WS_LA = 84 * MiB;
constexpr size_t WS_YA = 132 * MiB;
constexpr size_t WS_IDX = 84 * MiB, WS_GATE = 116 * MiB;
constexpr size_t WS_QKV = 212 * MiB;
constexpr size_t WS_YB = 212 * MiB;
constexpr size_t WS_RKV = 308 * MiB;
constexpr size_t WS_HB = 308 * MiB;
constexpr size_t WS_LORA = 500 * MiB;
constexpr size_t WS_GA = 564 * MiB, WS_GB = 692 * MiB;
constexpr size_t WS_DAG = 820 * MiB;
constexpr size_t WS_QP = 820 * MiB;
constexpr size_t WS_END = 1012 * MiB;
constexpr int CW_BAR = 4096, CW_RND = 8192;

constexpr int RING_BYTES = 131072;
constexpr int LDSCTL_OFF = RING_BYTES, MISC_OFF = LDSCTL_OFF + 320;
constexpr int LDS_BYTES = 147456;

typedef float f32x2 __attribute__((ext_vector_type(2)));
typedef float f32x16 __attribute__((ext_vector_type(16)));
typedef unsigned u32x2 __attribute__((ext_vector_type(2)));
typedef __bf16 bf16x2_t __attribute__((ext_vector_type(2)));
typedef float v16f __attribute__((ext_vector_type(16)));
typedef float v32f __attribute__((ext_vector_type(32)));
typedef unsigned v6u __attribute__((ext_vector_type(6)));

__device__ __forceinline__ float bf2f(unsigned b) { return __builtin_bit_cast(float, b << 16); }
__device__ __forceinline__ float bf_lo(unsigned w) { return __builtin_bit_cast(float, w << 16); }
__device__ __forceinline__ float bf_hi(unsigned w) { return __builtin_bit_cast(float, w & 0xffff0000u); }
template <int CTRL> __device__ __forceinline__ float dppf(float x) { return __builtin_bit_cast(float, __builtin_amdgcn_update_dpp(0, __builtin_bit_cast(int, x), CTRL, 0xF, 0xF, true)); }
__device__ __forceinline__ float allreduce16(float x) { x += dppf<0xB1>(x); x += dppf<0x4E>(x); x += dppf<0x141>(x); x += dppf<0x140>(x); return x; }
__device__ __forceinline__ float wave_sum(float v) {
#pragma unroll
    for (int o = 1; o < 64; o <<= 1) v += __shfl_xor(v, o);
    return v;
}
__device__ __forceinline__ bf16x2_t as_bf2(unsigned w) { return __builtin_bit_cast(bf16x2_t, w); }
__device__ __forceinline__ float u2f(unsigned w) { return __builtin_bit_cast(float, w); }
__device__ __forceinline__ unsigned f2u(float f) { return __builtin_bit_cast(unsigned, f); }
__device__ __forceinline__ float wave_allreduce(float x) {
    x = allreduce16(x);
    { const auto r = __builtin_amdgcn_permlane16_swap(f2u(x), f2u(x), false, false); const unsigned a = r[0], b = r[1]; x = u2f(a) + u2f(b); }
    { const auto r = __builtin_amdgcn_permlane32_swap(f2u(x), f2u(x), false, false); const unsigned a = r[0], b = r[1]; x = u2f(a) + u2f(b); }
    return x;
}
__device__ __forceinline__ float gelu_erf(float v) {
    const float av = __builtin_fabsf(v), t = __builtin_amdgcn_rcpf(av * 0.2316418882f + 1.0f);
    float q = t * 0.5307027145f + (-0.7265760135f); q = q * t + 0.7107068705f; q = q * t + (-0.142248368f); q = q * t + 0.127414796f; q = q * t;
    const float e = __builtin_amdgcn_exp2f((v * v) * (-0.72134752044f));
    const float m = v * (q * e);
    return v < 0.f ? m : v - m;
}

__device__ __forceinline__ float sfma(float a, float b, float c) { float d; asm("v_fma_f32 %0, %1, %2, %3" : "=v"(d) : "v"(a), "v"(b), "v"(c)); return d; }
__device__ __forceinline__ float smul(float a, float b) { float d; asm("v_mul_f32 %0, %1, %2" : "=v"(d) : "v"(a), "v"(b)); return d; }
__device__ __forceinline__ v6u pack_fp6(const v16f x, const v16f y) { v6u p = __builtin_amdgcn_cvt_scalef32_2xpk16_fp6_f32(x, y, 1.0f); asm volatile("" : "+v"(p) : "v"(x), "v"(y)); return p; }
__device__ __forceinline__ v32f unpack_fp6(const v6u p) { const v32f f = __builtin_amdgcn_cvt_scalef32_pk32_f32_fp6(p, 1.0f); asm volatile("" :: "v"(p)); return f; }
struct Frame {
    LAS unsigned char* lds;
    volatile LAS unsigned* MISC;
    gu32* ctl;
    int tid, lane, wave, vcu, G, rnd_nloc, rnd_x;
    const float* in[24]; float* out;
    float *ROPE, *SSQ;
    bf16 *WIN, *PA, *PB, *WOUT, *WQ, *LW, *SK, *XN, *LA, *YA, *QKV, *YB, *RKV, *HB, *LORA, *GA, *GB, *DAG, *QP;
    int* IDX; float* GATE; unsigned char *U8, *V8;
};
enum { I_X = 0, I_NMW, I_WIN, I_MU, I_SINK, I_W0, I_W2, I_A0, I_A2, I_G2, I_KK, I_KA, I_RK, I_LNW, I_LNB, I_PA, I_PB, I_WOUT, I_NFW, I_WQ, I_SUBK, I_U, I_V, I_NFINAL };

struct SrcWin { const float* w; __device__ __forceinline__ float operator()(int k, int n) const {
    int src;
    if (n < 640) { const int hd = n >> 6, j = n & 63; src = hd * 64 + ((j & 1) ? 32 + (j >> 1) : (j >> 1)); }
    else if (n < 2592) src = n;
    else if (n < 2816) return 0.f;
    else src = n - 224;
    return w[(size_t)k * IN_COLS + src]; } };
struct SrcPlain { const float* w; int N; __device__ __forceinline__ float operator()(int k, int n) const { return w[(size_t)k * N + n]; } };
struct SrcWq { const float* w; const float* s; __device__ __forceinline__ float operator()(int k, int n) const { return w[(size_t)k * 1024 + n] * s[k]; } };
struct SrcLora { const float *w2, *a2, *g2; __device__ __forceinline__ float operator()(int k, int n) const {
    if (n < 512) return k < 64 ? w2[k * 512 + n] : 0.f;
    if (n < 1024) return (k >= 64 && k < 128) ? a2[(k - 64) * 512 + (n - 512)] : 0.f;
    return (k >= 128 && k < 288) ? g2[(k - 128) * 512 + (n - 1024)] : 0.f; } };
template <int N, int K, class F_> __device__ __forceinline__ void transpose_w(bf16* dst, const F_& f, int gtid, int nthr) {
    for (int id = gtid; id < N * (K / 8); id += nthr) {
        const int n = id % N, k0 = (id / N) * 8;
        float v[8];
#pragma unroll
        for (int j = 0; j < 8; ++j) v[j] = f(k0 + j, n);
        v4u o; o.x = pk2(v[0], v[1]); o.y = pk2(v[2], v[3]); o.z = pk2(v[4], v[5]); o.w = pk2(v[6], v[7]);
        *(v4u*)(dst + (size_t)n * K + k0) = o;
    }
}
__device__ __forceinline__ void p0_prologue(Frame& F) {
    const int gtid = F.vcu * (NWAVES * 64) + F.tid, nthr = F.G * NWAVES * 64;
    const int gw = F.vcu * NWAVES + F.wave, NGW = F.G * NWAVES;
    transpose_w<NZ, 1024>(F.WIN, SrcWin{F.in[I_WIN]}, gtid, nthr);
    transpose_w<1024, 512>(F.PA, SrcPlain{F.in[I_PA], 1024}, gtid, nthr);
    transpose_w<1024, 512>(F.PB, SrcPlain{F.in[I_PB], 1024}, gtid, nthr);
    transpose_w<1024, 1024>(F.WOUT, SrcPlain{F.in[I_WOUT], 1024}, gtid, nthr);
    transpose_w<1024, 1024>(F.WQ, SrcWq{F.in[I_WQ], F.in[I_NFW]}, gtid, nthr);
    transpose_w<1536, 384>(F.LW, SrcLora{F.in[I_W2], F.in[I_A2], F.in[I_G2]}, gtid, nthr);
    for (int id = gtid; id < 16 * 128 * 64 / 8; id += nthr) {
        const f32x4 a = *(const f32x4*)(F.in[I_SUBK] + (size_t)id * 8), b = *(const f32x4*)(F.in[I_SUBK] + (size_t)id * 8 + 4);
        v4u o; o.x = pk2(a[0], a[1]); o.y = pk2(a[2], a[3]); o.z = pk2(b[0], b[1]); o.w = pk2(b[2], b[3]);
        *(v4u*)(F.SK + (size_t)id * 8) = o;
    }
    for (int id = gtid; id < NEXP * 32; id += nthr) {
        const int e = id >> 5, c = (id >> 1) & 15, g = id & 1;
        const size_t eb = (size_t)e * 1024 + c * 64 + g * 32;
        const float* wn = F.in[I_NFW] + c * 64 + g * 32;
        v16f ux, uy, vx_, vy_;
#pragma unroll
        for (int j = 0; j < 8; ++j) {
            const f32x4 a0 = *(const f32x4*)(F.in[I_U] + eb + 4 * j) * *(const f32x4*)(wn + 4 * j) * U6_SCALE;
            const f32x4 b0 = *(const f32x4*)(F.in[I_V] + eb + 4 * j) * V6_SCALE;
            ux[2 * j] = a0[0]; uy[2 * j] = a0[1]; ux[2 * j + 1] = a0[2]; uy[2 * j + 1] = a0[3];
            vx_[2 * j] = b0[0]; vy_[2 * j] = b0[1]; vx_[2 * j + 1] = b0[2]; vy_[2 * j + 1] = b0[3];
        }
        const int G = 2 * c + g;
#if U_FP4
        {
            v4u pk;
            { unsigned w = 0; w = __builtin_amdgcn_cvt_scalef32_pk_fp4_f32(w, ux[0], uy[0], 1.0f, 0); w = __builtin_amdgcn_cvt_scalef32_pk_fp4_f32(w, ux[1], uy[1], 1.0f, 1); w = __builtin_amdgcn_cvt_scalef32_pk_fp4_f32(w, ux[2], uy[2], 1.0f, 2); w = __builtin_amdgcn_cvt_scalef32_pk_fp4_f32(w, ux[3], uy[3], 1.0f, 3); pk.x = w; }
            { unsigned w = 0; w = __builtin_amdgcn_cvt_scalef32_pk_fp4_f32(w, ux[4], uy[4], 1.0f, 0); w = __builtin_amdgcn_cvt_scalef32_pk_fp4_f32(w, ux[5], uy[5], 1.0f, 1); w = __builtin_amdgcn_cvt_scalef32_pk_fp4_f32(w, ux[6], uy[6], 1.0f, 2); w = __builtin_amdgcn_cvt_scalef32_pk_fp4_f32(w, ux[7], uy[7], 1.0f, 3); pk.y = w; }
            { unsigned w = 0; w = __builtin_amdgcn_cvt_scalef32_pk_fp4_f32(w, ux[8], uy[8], 1.0f, 0); w = __builtin_amdgcn_cvt_scalef32_pk_fp4_f32(w, ux[9], uy[9], 1.0f, 1); w = __builtin_amdgcn_cvt_scalef32_pk_fp4_f32(w, ux[10], uy[10], 1.0f, 2); w = __builtin_amdgcn_cvt_scalef32_pk_fp4_f32(w, ux[11], uy[11], 1.0f, 3); pk.z = w; }
            { unsigned w = 0; w = __builtin_amdgcn_cvt_scalef32_pk_fp4_f32(w, ux[12], uy[12], 1.0f, 0); w = __builtin_amdgcn_cvt_scalef32_pk_fp4_f32(w, ux[13], uy[13], 1.0f, 1); w = __builtin_amdgcn_cvt_scalef32_pk_fp4_f32(w, ux[14], uy[14], 1.0f, 2); w = __builtin_amdgcn_cvt_scalef32_pk_fp4_f32(w, ux[15], uy[15], 1.0f, 3); pk.w = w; }
            *(v4u*)(F.U8 + (size_t)e * U_ROW + 16 * G) = pk;
        }
#else
        {
            const v6u pu = pack_fp6(ux, uy);
            unsigned char* ur = F.U8 + (size_t)e * U_ROW;
            *(v4u*)(ur + 16 * G) = (v4u){pu[0], pu[1], pu[2], pu[3]}; *(u32x2*)(ur + 512 + 8 * G) = (u32x2){pu[4], pu[5]};
        }
#endif
#if V_FP4
        {
            v4u pk;
            { unsigned w = 0; w = __builtin_amdgcn_cvt_scalef32_pk_fp4_f32(w, vx_[0], vy_[0], 1.0f, 0); w = __builtin_amdgcn_cvt_scalef32_pk_fp4_f32(w, vx_[1], vy_[1], 1.0f, 1); w = __builtin_amdgcn_cvt_scalef32_pk_fp4_f32(w, vx_[2], vy_[2], 1.0f, 2); w = __builtin_amdgcn_cvt_scalef32_pk_fp4_f32(w, vx_[3], vy_[3], 1.0f, 3); pk.x = w; }
            { unsigned w = 0; w = __builtin_amdgcn_cvt_scalef32_pk_fp4_f32(w, vx_[4], vy_[4], 1.0f, 0); w = __builtin_amdgcn_cvt_scalef32_pk_fp4_f32(w, vx_[5], vy_[5], 1.0f, 1); w = __builtin_amdgcn_cvt_scalef32_pk_fp4_f32(w, vx_[6], vy_[6], 1.0f, 2); w = __builtin_amdgcn_cvt_scalef32_pk_fp4_f32(w, vx_[7], vy_[7], 1.0f, 3); pk.y = w; }
            { unsigned w = 0; w = __builtin_amdgcn_cvt_scalef32_pk_fp4_f32(w, vx_[8], vy_[8], 1.0f, 0); w = __builtin_amdgcn_cvt_scalef32_pk_fp4_f32(w, vx_[9], vy_[9], 1.0f, 1); w = __builtin_amdgcn_cvt_scalef32_pk_fp4_f32(w, vx_[10], vy_[10], 1.0f, 2); w = __builtin_amdgcn_cvt_scalef32_pk_fp4_f32(w, vx_[11], vy_[11], 1.0f, 3); pk.z = w; }
            { unsigned w = 0; w = __builtin_amdgcn_cvt_scalef32_pk_fp4_f32(w, vx_[12], vy_[12], 1.0f, 0); w = __builtin_amdgcn_cvt_scalef32_pk_fp4_f32(w, vx_[13], vy_[13], 1.0f, 1); w = __builtin_amdgcn_cvt_scalef32_pk_fp4_f32(w, vx_[14], vy_[14], 1.0f, 2); w = __builtin_amdgcn_cvt_scalef32_pk_fp4_f32(w, vx_[15], vy_[15], 1.0f, 3); pk.w = w; }
            *(v4u*)(F.V8 + (size_t)e * V_ROW + 16 * G) = pk;
        }
#else
        {
            const v6u pv = pack_fp6(vx_, vy_);
            const int hf_ = G >> 4, i_ = G & 15;
            unsigned char* vb = F.V8 + (size_t)e * V_ROW + 384 * hf_;
            *(v4u*)(vb + 16 * i_) = (v4u){pv[0], pv[1], pv[2], pv[3]}; *(u32x2*)(vb + 256 + 8 * i_) = (u32x2){pv[4], pv[5]};
        }
#endif
    }
    for (int id = gtid; id < SEQ * 32; id += nthr) {
        const int t = id >> 5, i = id & 31;
        const double inv = exp2(-(double)i * (13.287712379549449 / 32.0));
        double rev = (double)t * inv * 0.15915494309189535; rev -= floor(rev);
        F.ROPE[2 * id] = __builtin_amdgcn_cosf((float)rev); F.ROPE[2 * id + 1] = __builtin_amdgcn_sinf((float)rev);
    }
    for (int id = gtid; id < M; id += nthr) F.SSQ[id] = 0.f;
    const GAS f32x4* wv = (const GAS f32x4*)F.in[I_NMW] + F.lane;
    f32x4 nw[4];
#pragma unroll
    for (int j = 0; j < 4; ++j) nw[j] = wv[64 * j];
    for (int m = gw; m < M; m += NGW) {
        const GAS f32x4* xr = (const GAS f32x4*)(F.in[I_X] + (size_t)m * D) + F.lane;
        f32x4 v[4]; float s = 0.f;
#pragma unroll
        for (int j = 0; j < 4; ++j) { v[j] = xr[64 * j]; s += (v[j].x * v[j].x + v[j].y * v[j].y) + (v[j].z * v[j].z + v[j].w * v[j].w); }
        const float rstd = 1.0f / sqrtf(wave_sum(s) * (1.f / D) + NORM_EPS);
        GAS unsigned long long* o8 = (GAS unsigned long long*)(F.XN + (size_t)m * D) + F.lane;
#pragma unroll
        for (int j = 0; j < 4; ++j) { const f32x4 y = v[j] * rstd * nw[j]; o8[64 * j] = (unsigned long long)pk2(y.x, y.y) | ((unsigned long long)pk2(y.z, y.w) << 32); }
    }
}

__device__ __forceinline__ void attn_phase(Frame& F) {
    LAS bf16* Ks = (LAS bf16*)F.lds;
    LAS bf16* Vt = (LAS bf16*)(F.lds + 256 * 144);
    const int lane = F.lane, wave = F.wave, r32 = lane & 31, hh = lane >> 5;
    for (int unit = F.vcu; unit < BATCH * 2 * 16; unit += F.G) {
        const int b = unit >> 5, kvh = (unit >> 4) & 1, qb = unit & 15;
        const size_t rowbase = (size_t)b * SEQ + qb * 128;
#pragma unroll
        for (int i = 0; i < 4; ++i) {
            const int c = F.tid + 512 * i, key = c >> 3, piece = c & 7;
            v4u kv = (v4u){0u, 0u, 0u, 0u}, vv = kv;
            if (qb > 0 || key >= 128) { const bf16* src = F.QKV + (rowbase + key - 128) * 768 + kvh * 64 + piece * 8; kv = *(const v4u*)(src + 512); vv = *(const v4u*)(src + 640); }
            *(LAS v4u*)(Ks + key * 72 + piece * 8) = kv;
            LAS bf16* vd = Vt + (piece * 8) * 260 + key;
            vd[0 * 260] = (bf16)(vv.x & 0xffffu); vd[1 * 260] = (bf16)(vv.x >> 16); vd[2 * 260] = (bf16)(vv.y & 0xffffu); vd[3 * 260] = (bf16)(vv.y >> 16);
            vd[4 * 260] = (bf16)(vv.z & 0xffffu); vd[5 * 260] = (bf16)(vv.z >> 16); vd[6 * 260] = (bf16)(vv.w & 0xffffu); vd[7 * 260] = (bf16)(vv.w >> 16);
        }
        __syncthreads();
        const int head = kvh * 4 + (wave >> 1);
        const float sink2 = F.in[I_SINK][head] * LOG2E;
#pragma unroll 1
        for (int qq = 0; qq < 2; ++qq) {
            const int qg = (wave & 1) * 64 + qq * 32, qi = qg + r32;
            const bf16* qp = F.QKV + (rowbase + qi) * 768 + head * 64 + 8 * hh;
            bf16x8 bq[4];
#pragma unroll
            for (int s = 0; s < 4; ++s) bq[s] = *(const bf16x8*)(qp + 16 * s);
            const int kt0 = qg >> 5;
            f32x16 sc[5];
#pragma unroll
            for (int i = 0; i < 5; ++i) {
                f32x16 a_ = {};
#pragma unroll
                for (int s = 0; s < 4; ++s) { const bf16x8 ka = *(const LAS bf16x8*)(Ks + ((kt0 + i) * 32 + r32) * 72 + 16 * s + 8 * hh); a_ = __builtin_amdgcn_mfma_f32_32x32x16_bf16(ka, bq[s], a_, 0, 0, 0); }
                sc[i] = a_;
            }
            float mx = sink2;
#pragma unroll
            for (int i = 0; i < 5; ++i)
#pragma unroll
                for (int r = 0; r < 16; ++r) {
                    const int kj = (kt0 + i) * 32 + (r & 3) + 8 * (r >> 2) + 4 * hh, dk = kj - qi;
                    const bool ok = (dk >= 1) && (dk <= 128) && (qb > 0 || kj >= 128);
                    const float s = ok ? sc[i][r] : -1e30f; sc[i][r] = s; mx = fmaxf(mx, s);
                }
            mx = fmaxf(mx, __shfl_xor(mx, 32));
            float sum = 0.f;
#pragma unroll
            for (int i = 0; i < 5; ++i)
#pragma unroll
                for (int r = 0; r < 16; ++r) { const float p = __builtin_amdgcn_exp2f(sc[i][r] - mx); sc[i][r] = p; sum += p; }
            sum += __shfl_xor(sum, 32); sum += __builtin_amdgcn_exp2f(sink2 - mx);
            const float inv = 1.0f / sum;
            f32x16 o0 = {}, o1 = {};
#pragma unroll
            for (int i = 0; i < 5; ++i)
#pragma unroll
                for (int s2 = 0; s2 < 2; ++s2) {
                    v4u pw;
                    pw.x = pk2(sc[i][8 * s2 + 0] * inv, sc[i][8 * s2 + 1] * inv); pw.y = pk2(sc[i][8 * s2 + 2] * inv, sc[i][8 * s2 + 3] * inv);
                    pw.z = pk2(sc[i][8 * s2 + 4] * inv, sc[i][8 * s2 + 5] * inv); pw.w = pk2(sc[i][8 * s2 + 6] * inv, sc[i][8 * s2 + 7] * inv);
                    const bf16x8 pa = __builtin_bit_cast(bf16x8, pw);
                    const int kb = (kt0 + i) * 32 + 16 * s2 + 4 * hh;
                    const u32x2 l0 = *(const LAS u32x2*)(Vt + r32 * 260 + kb), h0 = *(const LAS u32x2*)(Vt + r32 * 260 + kb + 8);
                    const u32x2 l1 = *(const LAS u32x2*)(Vt + (32 + r32) * 260 + kb), h1 = *(const LAS u32x2*)(Vt + (32 + r32) * 260 + kb + 8);
                    const bf16x8 b0 = __builtin_bit_cast(bf16x8, (v4u){l0.x, l0.y, h0.x, h0.y}), b1 = __builtin_bit_cast(bf16x8, (v4u){l1.x, l1.y, h1.x, h1.y});
                    o0 = __builtin_amdgcn_mfma_f32_32x32x16_bf16(pa, b0, o0, 0, 0, 0);
                    o1 = __builtin_amdgcn_mfma_f32_32x32x16_bf16(pa, b1, o1, 0, 0, 0);
                }
#pragma unroll
            for (int r = 0; r < 16; ++r) {
                const int qrow = (r & 3) + 8 * (r >> 2) + 4 * hh;
                bf16* op = F.YA + (rowbase + qg + qrow) * 512 + head * 64 + r32;
                op[0] = (bf16)f2bf(o0[r]); op[32] = (bf16)f2bf(o1[r]);
            }
        }
        __syncthreads();
    }
}

__device__ __forceinline__ void lora_prep_phase(Frame& F) {
    const int gtid = F.vcu * (NWAVES * 64) + F.tid, nthr = F.G * NWAVES * 64;
    for (int id = gtid; id < M * 48; id += nthr) {
        const int row = id / 48, ch = id % 48, c0 = ch * 8;
        v4u o = (v4u){0u, 0u, 0u, 0u};
        if (c0 < 288) {
            const v4u zc = *(const v4u*)(F.LORA + (size_t)row * 512 + c0);
            v4u zp = (v4u){0u, 0u, 0u, 0u};
            if ((row & (SEQ - 1)) != 0) zp = *(const v4u*)(F.LORA + (size_t)(row - 1) * 512 + c0);
            const float* mu = F.in[I_MU] + 1536 + c0;
            const unsigned zcw[4] = {zc.x, zc.y, zc.z, zc.w}, zpw[4] = {zp.x, zp.y, zp.z, zp.w};
            float v[8];
#pragma unroll
            for (int j = 0; j < 8; ++j) {
                const float zc_ = (j & 1) ? bf_hi(zcw[j >> 1]) : bf_lo(zcw[j >> 1]), zp_ = (j & 1) ? bf_hi(zpw[j >> 1]) : bf_lo(zpw[j >> 1]);
                const float z = zc_ + mu[j] * (zp_ - zc_);
                float f;
                if (c0 < 64) f = 1.0f - 2.0f * __builtin_amdgcn_rcpf(__builtin_amdgcn_exp2f(2.0f * LOG2E * z) + 1.0f);
                else if (c0 < 128) f = z;
                else f = __builtin_amdgcn_rcpf(1.0f + __builtin_amdgcn_exp2f(-LOG2E * z));
                v[j] = f;
            }
            o.x = pk2(v[0], v[1]); o.y = pk2(v[2], v[3]); o.z = pk2(v[4], v[5]); o.w = pk2(v[6], v[7]);
        }
        *(v4u*)(F.LA + (size_t)row * 384 + c0) = o;
    }
}

namespace ck {
constexpr int RS = 136, TS = 40, AS = 40;
constexpr int VB_KT = 0, VB_RT = 16 * RS, VB_KS = 2 * 16 * RS, VB_BS = 3 * 16 * RS, VB_KK = 4 * 16 * RS, VB_BT = VB_KK + 64 * TS, VB_VT = VB_BT + 64 * TS,
              VB_DC = VB_VT + 64 * TS, VB_SIZE = ((VB_DC + 256 + 127) / 128) * 128;
constexpr int VR_V32 = 0, VR_BON = 4096, VR_G = 4096 + 128, VR_SIZE = 4096 + 128 + 2048;
constexpr int RAW_RKV = 0, RAW_DAG = 16 * 384, RAW_SIZE = 2 * 16 * 384;
constexpr int AB_A2 = 0, AB_A3 = 16 * AS, AB_A4 = 2 * 16 * AS, AB_T = 3 * 16 * AS, AB_A1 = 4 * 16 * AS, AB_SIZE = AB_A1 + 1024;
constexpr int OFF_VB = 0, OFF_AB = 3 * VB_SIZE, OFF_Y = OFF_AB + 2 * AB_SIZE, OFF_VR = OFF_Y + 2 * 4096, OFF_RAW = OFF_VR + 4 * VR_SIZE, LDS_TOTAL = OFF_RAW + 3 * RAW_SIZE;
static_assert(LDS_TOTAL <= 131072 && (OFF_RAW % 16) == 0 && (VB_KK % 8) == 0 && (OFF_VR % 16) == 0 && (VB_DC % 16) == 0 && (AB_SIZE % 16) == 0 && (OFF_AB % 16) == 0, "chunked scan LDS map");
}
__device__ __forceinline__ unsigned cvtpk(float lo, float hi) { typedef float f2_ __attribute__((ext_vector_type(2))); typedef __bf16 b2_ __attribute__((ext_vector_type(2))); const f2_ v = {lo, hi}; const b2_ b = __builtin_convertvector(v, b2_); return __builtin_bit_cast(unsigned, b); }
#define SCAN_BAR() do { asm volatile("s_waitcnt lgkmcnt(0)" ::: "memory"); __builtin_amdgcn_s_barrier(); asm volatile("" ::: "memory"); } while (0)
__device__ __forceinline__ void scan_phase(Frame& F) {
    using namespace ck;
    LAS unsigned char* L = F.lds;
    constexpr int NCH = SEQ / 16;
    const int tid = F.tid, lane = F.lane, wave = F.wave;
    const bool helper = wave >= 4;
    const int r16 = lane & 15, g = lane >> 4;
    const int htid = tid & 255, tt = htid >> 4, d4 = (htid & 15) * 4;
    for (int unit = F.vcu; unit < BATCH * 8; unit += F.G) {
        const int b = unit >> 3, h = unit & 7, hc = h * 64 + d4;
        u32x2 rq[6];
#define UP4(W_) ((f32x4){bf_lo((W_).x), bf_hi((W_).x), bf_lo((W_).y), bf_hi((W_).y)})
#define H_ISSUE(c) do { const size_t tk_ = ((size_t)(b * 8 + h) * SEQ + (size_t)(c) * 16 + tt) * 192 + d4; const bf16* rp_ = F.RKV + tk_; const bf16* dp_ = F.DAG + tk_; \
            rq[0] = *(const u32x2*)(rp_); rq[1] = *(const u32x2*)(rp_ + 64); rq[2] = *(const u32x2*)(rp_ + 128); rq[3] = *(const u32x2*)(dp_); rq[4] = *(const u32x2*)(dp_ + 64); rq[5] = *(const u32x2*)(dp_ + 128); } while (0)
#define H_LAND(c) do { LAS unsigned char* rw_ = L + OFF_RAW + (int)((unsigned)(c) % 3u) * RAW_SIZE + tt * 384 + d4 * 2; \
            *(LAS u32x2*)(rw_ + RAW_RKV) = rq[0]; *(LAS u32x2*)(rw_ + RAW_RKV + 128) = rq[1]; *(LAS u32x2*)(rw_ + RAW_RKV + 256) = rq[2]; \
            *(LAS u32x2*)(rw_ + RAW_DAG) = rq[3]; *(LAS u32x2*)(rw_ + RAW_DAG + 128) = rq[4]; *(LAS u32x2*)(rw_ + RAW_DAG + 256) = rq[5]; } while (0)
#define PK4(V_) ((u32x2){cvtpk((V_).x, (V_).y), cvtpk((V_).z, (V_).w)})
#define H_PREP(c) do { int tt_ = tt, d4_ = d4; asm volatile("" : "+v"(tt_), "+v"(d4_));   \
            LAS unsigned char* vb_ = L + OFF_VB + (int)((unsigned)(c) % 3u) * VB_SIZE; LAS unsigned char* vr_ = L + OFF_VR + ((c) & 3) * VR_SIZE; \
            float lt[4] = {0.f, 0.f, 0.f, 0.f};        \
            const LAS unsigned char* raw_ = L + OFF_RAW + (int)((unsigned)(c) % 3u) * RAW_SIZE + d4_ * 2; \
            _Pragma("unroll") for (int s_ = 0; s_ < 16; ++s_) { const u32x2 xw_ = *(const LAS u32x2*)(raw_ + RAW_DAG + s_ * 384); const f32x4 x_ = UP4(xw_); const float m_ = (s_ <= tt_) ? 1.0f : 0.0f; \
                _Pragma("unroll") for (int i_ = 0; i_ < 4; ++i_) lt[i_] += m_ * x_[i_]; } \
            const LAS unsigned char* own_ = raw_ + tt_ * 384; \
            const u32x2 zr = *(const LAS u32x2*)(own_ + RAW_RKV), zk = *(const LAS u32x2*)(own_ + RAW_RKV + 128), zv = *(const LAS u32x2*)(own_ + RAW_RKV + 256); \
            const u32x2 ew = *(const LAS u32x2*)(own_ + RAW_DAG), aa = *(const LAS u32x2*)(own_ + RAW_DAG + 128), gw_ = *(const LAS u32x2*)(own_ + RAW_DAG + 256); \
              \
            const LAS unsigned char* prv_ = (tt_ > 0) ? (own_ - 384) : (L + OFF_RAW + (int)((unsigned)((c) + 2) % 3u) * RAW_SIZE + d4_ * 2 + 15 * 384); \
            u32x2 pr = *(const LAS u32x2*)(prv_ + RAW_RKV), pk = *(const LAS u32x2*)(prv_ + RAW_RKV + 128), pv = *(const LAS u32x2*)(prv_ + RAW_RKV + 256); \
            if ((c) == 0 && tt_ == 0) { pr = (u32x2){0u, 0u}; pk = pr; pv = pr; } \
            const f32x4 r0_ = UP4(zr), k0_ = UP4(zk), v0_ = UP4(zv); \
            const f32x4 r_ = r0_ + c_mur * (UP4(pr) - r0_), k_ = k0_ + c_muk * (UP4(pk) - k0_), v_ = v0_ + c_muv * (UP4(pv) - v0_); \
            const f32x4 a_ = UP4(aa), e_ = UP4(ew); \
            f32x4 kk_ = k_ * c_kk; const float n2_ = allreduce16((kk_.x * kk_.x + kk_.y * kk_.y) + (kk_.z * kk_.z + kk_.w * kk_.w)); \
            kk_ = kk_ * (1.0f / fmaxf(sqrtf(n2_), 1e-12f)); \
            const f32x4 kp_ = k_ * (1.0f + (a_ - 1.0f) * c_ka); \
            const f32x4 rk_ = r_ * kp_ * c_rk; const float bon_ = allreduce16((rk_.x + rk_.y) + (rk_.z + rk_.w)); \
            f32x4 dt_, dtm_, idt_;   \
            _Pragma("unroll") for (int i_ = 0; i_ < 4; ++i_) { dt_[i_] = __builtin_amdgcn_exp2f(-LOG2E * lt[i_]); dtm_[i_] = __builtin_amdgcn_exp2f(-LOG2E * (lt[i_] - e_[i_])); idt_[i_] = __builtin_amdgcn_exp2f(LOG2E * lt[i_]); } \
            const f32x4 kt_ = kk_ * dtm_, rt_ = r_ * dt_, ks_ = kp_ * idt_, bs_ = kk_ * a_ * idt_; \
            *(LAS u32x2*)(vb_ + VB_KT + tt_ * RS + d4_ * 2) = PK4(kt_); *(LAS u32x2*)(vb_ + VB_RT + tt_ * RS + d4_ * 2) = PK4(rt_); \
            *(LAS u32x2*)(vb_ + VB_KS + tt_ * RS + d4_ * 2) = PK4(ks_); *(LAS u32x2*)(vb_ + VB_BS + tt_ * RS + d4_ * 2) = PK4(bs_); \
            { const u32x2 ksp_ = PK4(ks_), vp_ = PK4(v_); const f32x4 nb_ = -bs_; const u32x2 bsp_ = PK4(nb_); \
              LAS unsigned char* t0_ = vb_ + d4_ * TS + tt_ * 2; \
              *(LAS bf16*)(t0_ + VB_KK) = (bf16)(ksp_.x & 0xffffu); *(LAS bf16*)(t0_ + VB_KK + TS) = (bf16)(ksp_.x >> 16); *(LAS bf16*)(t0_ + VB_KK + 2 * TS) = (bf16)(ksp_.y & 0xffffu); *(LAS bf16*)(t0_ + VB_KK + 3 * TS) = (bf16)(ksp_.y >> 16); \
              *(LAS bf16*)(t0_ + VB_BT) = (bf16)(bsp_.x & 0xffffu); *(LAS bf16*)(t0_ + VB_BT + TS) = (bf16)(bsp_.x >> 16); *(LAS bf16*)(t0_ + VB_BT + 2 * TS) = (bf16)(bsp_.y & 0xffffu); *(LAS bf16*)(t0_ + VB_BT + 3 * TS) = (bf16)(bsp_.y >> 16); \
              *(LAS bf16*)(t0_ + VB_VT) = (bf16)(vp_.x & 0xffffu); *(LAS bf16*)(t0_ + VB_VT + TS) = (bf16)(vp_.x >> 16); *(LAS bf16*)(t0_ + VB_VT + 2 * TS) = (bf16)(vp_.y & 0xffffu); *(LAS bf16*)(t0_ + VB_VT + 3 * TS) = (bf16)(vp_.y >> 16); } \
            *(LAS f32x4*)(vr_ + VR_V32 + tt_ * 256 + d4_ * 4) = v_; \
            if ((d4_ == 0)) *(LAS float*)(vr_ + VR_BON + tt_ * 4) = bon_; \
            *(LAS u32x2*)(vr_ + VR_G + tt_ * 128 + d4_ * 2) = gw_; \
            if (tt_ == 15) *(LAS f32x4*)(vb_ + VB_DC + d4_ * 4) = dt_; } while (0)
#define H_PROD(c) do { int r_ = r16, g_ = g; asm volatile("" : "+v"(r_), "+v"(g_)); \
            LAS unsigned char* vb_ = L + OFF_VB + (int)((unsigned)(c) % 3u) * VB_SIZE; LAS unsigned char* ab_ = L + OFF_AB + ((c) & 1) * AB_SIZE; const int hw_ = wave - 4;        \
            const LAS unsigned char* X_ = vb_ + ((hw_ & 1) ? VB_KS : VB_BS) + r_ * RS + g_ * 16; const LAS unsigned char* Y_ = vb_ + ((hw_ & 2) ? VB_RT : VB_KT) + r_ * RS + g_ * 16; \
            f32x4 p_ = (f32x4){0.f, 0.f, 0.f, 0.f}; \
            p_ = __builtin_amdgcn_mfma_f32_16x16x32_bf16(*(const LAS bf16x8*)(X_), *(const LAS bf16x8*)(Y_), p_, 0, 0, 0); \
            p_ = __builtin_amdgcn_mfma_f32_16x16x32_bf16(*(const LAS bf16x8*)(X_ + 64), *(const LAS bf16x8*)(Y_ + 64), p_, 0, 0, 0); \
            _Pragma("unroll") for (int q_ = 0; q_ < 4; ++q_) { const int s_ = 4 * g_ + q_; const bool keep_ = (hw_ & 2) ? (s_ <= r_) : (s_ < r_); p_[q_] = keep_ ? p_[q_] : 0.f; } \
            if (hw_ != 0) { \
                const float sg_ = (hw_ == 2) ? -1.0f : 1.0f; const int off_ = (hw_ == 1) ? AB_A2 : (hw_ == 2) ? AB_A3 : AB_A4; \
                *(LAS u32x2*)(ab_ + off_ + r_ * AS + g_ * 8) = (u32x2){cvtpk(sg_ * p_[0], sg_ * p_[1]), cvtpk(sg_ * p_[2], sg_ * p_[3])}; \
            } } while (0)
#define S_TINV(c) do { int r_ = r16, g_ = g; asm volatile("" : "+v"(r_), "+v"(g_)); \
            LAS unsigned char* vb_ = L + OFF_VB + (int)((unsigned)(c) % 3u) * VB_SIZE; LAS unsigned char* ab_ = L + OFF_AB + ((c) & 1) * AB_SIZE; \
            const LAS unsigned char* X_ = vb_ + VB_BS + r_ * RS + g_ * 16; const LAS unsigned char* Y_ = vb_ + VB_KT + r_ * RS + g_ * 16; \
            f32x4 p_ = (f32x4){0.f, 0.f, 0.f, 0.f}; \
            p_ = __builtin_amdgcn_mfma_f32_16x16x32_bf16(*(const LAS bf16x8*)(X_), *(const LAS bf16x8*)(Y_), p_, 0, 0, 0); \
            p_ = __builtin_amdgcn_mfma_f32_16x16x32_bf16(*(const LAS bf16x8*)(X_ + 64), *(const LAS bf16x8*)(Y_ + 64), p_, 0, 0, 0); \
            _Pragma("unroll") for (int q_ = 0; q_ < 4; ++q_) p_[q_] = (4 * g_ + q_ < r_) ? p_[q_] : 0.f; \
                  \
                  \
                f32x4 p2_ = (f32x4){0.f, 0.f, 0.f, 0.f}; \
                p2_ = __builtin_amdgcn_mfma_f32_16x16x32_bf16(*(const LAS bf16x8*)(Y_), *(const LAS bf16x8*)(X_), p2_, 0, 0, 0); \
                p2_ = __builtin_amdgcn_mfma_f32_16x16x32_bf16(*(const LAS bf16x8*)(Y_ + 64), *(const LAS bf16x8*)(X_ + 64), p2_, 0, 0, 0); \
                f32x4 Pa_, Pb_, Ta_, Tb_; \
                _Pragma("unroll") for (int q_ = 0; q_ < 4; ++q_) { const int o_ = 4 * g_ + q_; Pa_[q_] = -p_[q_]; Pb_[q_] = (r_ < o_) ? -p2_[q_] : 0.f; const float d_ = (r_ == o_) ? 1.0f : 0.0f; Ta_[q_] = d_ + Pa_[q_]; Tb_[q_] = d_ + Pb_[q_]; } \
                _Pragma("unroll") for (int it_ = 0; it_ < 3; ++it_) { \
                    const s16x4 a8_ = K16(((u32x2){cvtpk(Pa_[0], Pa_[1]), cvtpk(Pa_[2], Pa_[3])})), b8_ = K16(((u32x2){cvtpk(Pb_[0], Pb_[1]), cvtpk(Pb_[2], Pb_[3])})); \
                    const f32x4 z_ = (f32x4){0.f, 0.f, 0.f, 0.f}; \
                    Pb_ = __builtin_amdgcn_mfma_f32_16x16x16bf16_1k(a8_, b8_, z_, 0, 0, 0); Pa_ = __builtin_amdgcn_mfma_f32_16x16x16bf16_1k(b8_, a8_, z_, 0, 0, 0); \
                    const s16x4 t8_ = K16(((u32x2){cvtpk(Ta_[0], Ta_[1]), cvtpk(Ta_[2], Ta_[3])})), p8_ = K16(((u32x2){cvtpk(Pb_[0], Pb_[1]), cvtpk(Pb_[2], Pb_[3])})); \
                    const f32x4 nTb_ = __builtin_amdgcn_mfma_f32_16x16x16bf16_1k(t8_, p8_, Tb_, 0, 0, 0), nTa_ = __builtin_amdgcn_mfma_f32_16x16x16bf16_1k(p8_, t8_, Ta_, 0, 0, 0); \
                    Ta_ = nTa_; Tb_ = nTb_; } \
                *(LAS u32x2*)(ab_ + AB_T + r_ * AS + g_ * 8) = (u32x2){cvtpk(Ta_[0], Ta_[1]), cvtpk(Ta_[2], Ta_[3])}; \
            } while (0)
#define H_POST(c) do { int tt_ = tt, d4_ = d4; asm volatile("" : "+v"(tt_), "+v"(d4_)); const size_t row_ = (size_t)b * SEQ + (size_t)(c) * 16 + tt; const LAS unsigned char* vr_ = L + OFF_VR + ((c) & 3) * VR_SIZE; \
            const f32x4 y_ = *(const LAS f32x4*)(L + OFF_Y + ((c) & 1) * 4096 + tt_ * 256 + d4_ * 4); \
            const float mean_ = allreduce16((y_.x + y_.y) + (y_.z + y_.w)) * (1.f / 64.f); const f32x4 dy_ = y_ - mean_; \
            const float var_ = allreduce16((dy_.x * dy_.x + dy_.y * dy_.y) + (dy_.z * dy_.z + dy_.w * dy_.w)) * (1.f / 64.f); const float rs_ = 1.0f / sqrtf(var_ + GN_EPS); \
            const u32x2 gq_ = *(const LAS u32x2*)(vr_ + VR_G + tt_ * 128 + d4_ * 2); const f32x4 vsh_ = *(const LAS f32x4*)(vr_ + VR_V32 + tt_ * 256 + d4_ * 4); const float bo_ = *(const LAS float*)(vr_ + VR_BON + tt_ * 4); \
            const f32x4 o_ = (dy_ * rs_ * c_lnw + c_lnb + bo_ * vsh_) * UP4(gq_); \
            *(u32x2*)(F.YB + row_ * 512 + hc) = PK4(o_); } while (0)
        const f32x4 c_mur = *(const f32x4*)(F.in[I_MU] + hc), c_muk = *(const f32x4*)(F.in[I_MU] + 512 + hc), c_muv = *(const f32x4*)(F.in[I_MU] + 1024 + hc);
        const f32x4 c_kk = *(const f32x4*)(F.in[I_KK] + hc), c_ka = *(const f32x4*)(F.in[I_KA] + hc), c_rk = *(const f32x4*)(F.in[I_RK] + hc), c_lnw = *(const f32x4*)(F.in[I_LNW] + hc), c_lnb = *(const f32x4*)(F.in[I_LNB] + hc);
        f32x4 St[4];
#pragma unroll
        for (int i = 0; i < 4; ++i) St[i] = (f32x4){0.f, 0.f, 0.f, 0.f};
#define FR2(lo_, hi_) __builtin_bit_cast(bf16x8, (v4u){(lo_).x, (lo_).y, (hi_).x, (hi_).y})
typedef short s16x4 __attribute__((ext_vector_type(4)));
#define K16(w_) __builtin_bit_cast(s16x4, (w_))
#define SCAN_CHAIN(c) do { int r_ = r16, g_ = g; asm volatile("" : "+v"(r_), "+v"(g_)); \
                const LAS unsigned char* vb = L + OFF_VB + (int)((unsigned)(c) % 3u) * VB_SIZE; const LAS unsigned char* ab = L + OFF_AB + ((c) & 1) * AB_SIZE; \
                const int v = 16 * wave + r_; \
                const bf16x8 sb01 = __builtin_bit_cast(bf16x8, (v4u){cvtpk(St[0][0], St[0][1]), cvtpk(St[0][2], St[0][3]), cvtpk(St[1][0], St[1][1]), cvtpk(St[1][2], St[1][3])}); \
                const bf16x8 sb23 = __builtin_bit_cast(bf16x8, (v4u){cvtpk(St[2][0], St[2][1]), cvtpk(St[2][2], St[2][3]), cvtpk(St[3][0], St[3][1]), cvtpk(St[3][2], St[3][3])}); \
                const LAS unsigned char* ktp = vb + VB_KT + r_ * RS + g_ * 8; const LAS unsigned char* rtp = vb + VB_RT + r_ * RS + g_ * 8; \
                const bf16x8 kt01 = FR2(*(const LAS u32x2*)(ktp), *(const LAS u32x2*)(ktp + 32)), kt23 = FR2(*(const LAS u32x2*)(ktp + 64), *(const LAS u32x2*)(ktp + 96)); \
                const bf16x8 rt01 = FR2(*(const LAS u32x2*)(rtp), *(const LAS u32x2*)(rtp + 32)), rt23 = FR2(*(const LAS u32x2*)(rtp + 64), *(const LAS u32x2*)(rtp + 96)); \
                const s16x4 a2f = K16(*(const LAS u32x2*)(ab + AB_A2 + r_ * AS + g_ * 8)), a3f = K16(*(const LAS u32x2*)(ab + AB_A3 + r_ * AS + g_ * 8)); \
                const s16x4 a4f = K16(*(const LAS u32x2*)(ab + AB_A4 + r_ * AS + g_ * 8)), tf = K16(*(const LAS u32x2*)(ab + AB_T + r_ * AS + g_ * 8)); \
                const s16x4 vf = K16(*(const LAS u32x2*)(vb + VB_VT + v * TS + g_ * 8)); \
                f32x4 G = (f32x4){0.f, 0.f, 0.f, 0.f}; \
                G = __builtin_amdgcn_mfma_f32_16x16x32_bf16(kt01, sb01, G, 0, 0, 0); \
                G = __builtin_amdgcn_mfma_f32_16x16x32_bf16(kt23, sb23, G, 0, 0, 0); \
                G = __builtin_amdgcn_mfma_f32_16x16x16bf16_1k(a2f, vf, G, 0, 0, 0);        \
                const s16x4 gb = K16(((u32x2){cvtpk(G[0], G[1]), cvtpk(G[2], G[3])})); \
                const f32x4 E = __builtin_amdgcn_mfma_f32_16x16x16bf16_1k(tf, gb, (f32x4){0.f, 0.f, 0.f, 0.f}, 0, 0, 0); \
                const s16x4 eb = K16(((u32x2){cvtpk(E[0], E[1]), cvtpk(E[2], E[3])})); \
                f32x4 Yt = (f32x4){0.f, 0.f, 0.f, 0.f}; \
                Yt = __builtin_amdgcn_mfma_f32_16x16x32_bf16(rt01, sb01, Yt, 0, 0, 0); \
                Yt = __builtin_amdgcn_mfma_f32_16x16x32_bf16(rt23, sb23, Yt, 0, 0, 0); \
                Yt = __builtin_amdgcn_mfma_f32_16x16x16bf16_1k(a4f, vf, Yt, 0, 0, 0); \
                Yt = __builtin_amdgcn_mfma_f32_16x16x16bf16_1k(a3f, eb, Yt, 0, 0, 0); \
                _Pragma("unroll") \
                for (int rt = 0; rt < 4; ++rt) { \
                    const s16x4 kkf = K16(*(const LAS u32x2*)(vb + VB_KK + (16 * rt + r_) * TS + g_ * 8)), btf = K16(*(const LAS u32x2*)(vb + VB_BT + (16 * rt + r_) * TS + g_ * 8)); \
                    St[rt] = __builtin_amdgcn_mfma_f32_16x16x16bf16_1k(kkf, vf, St[rt], 0, 0, 0); \
                    St[rt] = __builtin_amdgcn_mfma_f32_16x16x16bf16_1k(btf, eb, St[rt], 0, 0, 0); \
                    St[rt] = St[rt] * *(const LAS f32x4*)(vb + VB_DC + (16 * rt + 4 * g_) * 4); \
                } \
                LAS float* yo = (LAS float*)(L + OFF_Y + ((c) & 1) * 4096) + (4 * g_) * 64 + v; \
                yo[0] = Yt[0]; yo[64] = Yt[1]; yo[128] = Yt[2]; yo[192] = Yt[3]; \
            } while (0)
        if (helper) { H_ISSUE(0); H_LAND(0); H_ISSUE(1); H_LAND(1); H_ISSUE(2); H_LAND(2); H_ISSUE(3); }
        SCAN_BAR();
        if (helper) { H_PREP(0); H_PREP(1); }
        SCAN_BAR();
        if (helper) H_PROD(0); else if (wave == 0) S_TINV(0);
        SCAN_BAR();
#define ITER(c) do { \
            if (helper) { \
                if ((c) + 3 < NCH) H_LAND((c) + 3); \
                if ((c) + 4 < NCH) H_ISSUE((c) + 4); \
                if ((c) + 1 < NCH) { H_PROD((c) + 1); if (DUP_PHASE == 42) { H_PROD((c) + 1); } } \
                if ((c) + 2 < NCH) { H_PREP((c) + 2); if (DUP_PHASE == 41) { H_PREP((c) + 2); } } \
            } else { \
                if ((c) < NCH) { SCAN_CHAIN(c); } \
                if ((c) >= 1) { H_POST((c) - 1); if (DUP_PHASE == 43) { H_POST((c) - 1); } } \
                if (wave == 0 && (c) + 1 < NCH) { S_TINV((c) + 1); if (DUP_PHASE == 46) { S_TINV((c) + 1); } } \
            } \
            SCAN_BAR(); } while (0)
#pragma unroll 1
        for (int c = 0; c <= NCH; ++c) ITER(c);
#undef ITER
        __syncthreads();
#undef H_ISSUE
#undef H_LAND
#undef UP4
#undef PK4
#undef H_PREP
#undef H_PROD
#undef S_TINV
#undef H_POST
    }
}

#define CE(i, j) do { const unsigned a_ = x[i], b_ = x[j]; x[i] = a_ > b_ ? a_ : b_; x[j] = a_ > b_ ? b_ : a_; } while (0)
__device__ __forceinline__ void sort16(unsigned (&x)[16]) {
    CE(0,1); CE(2,3); CE(0,2); CE(1,3); CE(1,2); CE(4,5); CE(6,7); CE(4,6); CE(5,7); CE(5,6); CE(0,4); CE(2,6); CE(2,4); CE(1,5); CE(3,7); CE(3,5); CE(1,2); CE(3,4); CE(5,6);
    CE(8,9); CE(10,11); CE(8,10); CE(9,11); CE(9,10); CE(12,13); CE(14,15); CE(12,14); CE(13,15); CE(13,14); CE(8,12); CE(10,14); CE(10,12); CE(9,13); CE(11,15); CE(11,13); CE(9,10); CE(11,12); CE(13,14);
    CE(0,8); CE(4,12); CE(4,8); CE(2,10); CE(6,14); CE(6,10); CE(2,4); CE(6,8); CE(10,12); CE(1,9); CE(5,13); CE(5,9); CE(3,11); CE(7,15); CE(7,11); CE(3,5); CE(7,9); CE(11,13);
    CE(1,2); CE(3,4); CE(5,6); CE(7,8); CE(9,10); CE(11,12); CE(13,14);
}
__device__ __forceinline__ void merge16(unsigned (&x)[16], const unsigned (&y)[16]) {
#pragma unroll
    for (int i = 0; i < 16; ++i) x[i] = x[i] > y[15 - i] ? x[i] : y[15 - i];
    CE(0,8); CE(1,9); CE(2,10); CE(3,11); CE(4,12); CE(5,13); CE(6,14); CE(7,15); CE(0,4); CE(1,5); CE(2,6); CE(3,7); CE(8,12); CE(9,13); CE(10,14); CE(11,15);
    CE(0,2); CE(1,3); CE(4,6); CE(5,7); CE(8,10); CE(9,11); CE(12,14); CE(13,15); CE(0,1); CE(2,3); CE(4,5); CE(6,7); CE(8,9); CE(10,11); CE(12,13); CE(14,15);
}
#undef CE
__device__ __forceinline__ unsigned f2key(float f) { const unsigned u = __builtin_bit_cast(unsigned, f); return u ^ ((unsigned)((int)u >> 31) | 0x80000000u); }
__device__ __forceinline__ float key2f(unsigned k) { return __builtin_bit_cast(float, (k & 0x80000000u) ? (k ^ 0x80000000u) : ~k); }
__device__ __forceinline__ unsigned lut16(const unsigned (&p)[4], unsigned i) {
    const unsigned q = i >> 2; const unsigned w = q == 0 ? p[0] : q == 1 ? p[1] : q == 2 ? p[2] : p[3];
    return (w >> ((i & 3u) * 8u)) & 0xffu;
}
__device__ __forceinline__ void peer_half_topk(const bf16* SKhp, const bf16* qrow, int r32, int hh, unsigned (&T)[16]) {
    bf16x8 bq[4];
#pragma unroll
    for (int s = 0; s < 4; ++s) bq[s] = *(const bf16x8*)(qrow + 16 * s + 8 * hh);
    unsigned G_[16];
#pragma unroll
    for (int i = 0; i < 16; ++i) T[i] = 0u;
#pragma unroll 1
    for (int nt = 0; nt < 4; ++nt) {
        f32x16 acc = {};
#pragma unroll
        for (int s = 0; s < 4; ++s) { const bf16x8 a = *(const bf16x8*)(SKhp + (nt * 32 + r32) * 64 + 16 * s + 8 * hh); acc = __builtin_amdgcn_mfma_f32_32x32x16_bf16(a, bq[s], acc, 0, 0, 0); }
#pragma unroll
        for (int r = 0; r < 16; ++r) { const unsigned n = nt * 32 + (r & 3) + 8 * (r >> 2) + 4 * hh; G_[r] = (f2key(acc[r]) & ~0x7fu) | n; }
        sort16(G_);
        merge16(T, G_);
    }
#pragma unroll
    for (int i = 0; i < 16; ++i) G_[i] = (unsigned)__shfl_xor((int)T[i], 32);
    merge16(T, G_);
}
__device__ __forceinline__ void peer_topk_phase(Frame& F) {
    const int lane = F.lane, wave = F.wave, r32 = lane & 31, hh = lane >> 5;
    for (int unit = F.vcu; unit < M / 256; unit += F.G) {
        const int tok = unit * 256 + wave * 32 + r32;
        const float rstd = 1.0f / sqrtf(F.SSQ[tok] * (1.f / D) + NORM_EPS);
#pragma unroll 1
        for (int h = 0; h < 8; ++h) {
            unsigned T1[16], T2[16];
            peer_half_topk(F.SK + (size_t)(h * 2 + 0) * 128 * 64, F.QP + (size_t)tok * 1024 + h * 128, r32, hh, T1);
            peer_half_topk(F.SK + (size_t)(h * 2 + 1) * 128 * 64, F.QP + (size_t)tok * 1024 + h * 128 + 64, r32, hh, T2);
            float v1[16], v2[16]; unsigned p1[4] = {0u, 0u, 0u, 0u}, p2[4] = {0u, 0u, 0u, 0u};
#pragma unroll
            for (int i = 0; i < 16; ++i) { v1[i] = key2f(T1[i] & ~0x7fu); v2[i] = key2f(T2[i] & ~0x7fu); p1[i >> 2] |= (T1[i] & 0x7fu) << ((i & 3) * 8); p2[i >> 2] |= (T2[i] & 0x7fu) << ((i & 3) * 8); }
            unsigned C[16], Gc[16];
#define CK(i, j) ((f2key(v1[i] + v2[j]) & ~0xffu) | (unsigned)((i) * 16 + (j)))
            Gc[0] = CK(0,0); Gc[1] = CK(0,1); Gc[2] = CK(0,2); Gc[3] = CK(0,3); Gc[4] = CK(0,4); Gc[5] = CK(0,5); Gc[6] = CK(0,6); Gc[7] = CK(0,7); Gc[8] = CK(0,8); Gc[9] = CK(0,9); Gc[10] = CK(0,10); Gc[11] = CK(0,11); Gc[12] = CK(0,12); Gc[13] = CK(0,13); Gc[14] = CK(0,14); Gc[15] = CK(0,15);
            sort16(Gc);
            _Pragma("unroll") for (int e = 0; e < 16; ++e) C[e] = Gc[e];
            Gc[0] = CK(1,0); Gc[1] = CK(1,1); Gc[2] = CK(1,2); Gc[3] = CK(1,3); Gc[4] = CK(1,4); Gc[5] = CK(1,5); Gc[6] = CK(1,6); Gc[7] = CK(1,7); Gc[8] = CK(2,0); Gc[9] = CK(2,1); Gc[10] = CK(2,2); Gc[11] = CK(2,3); Gc[12] = CK(2,4); Gc[13] = CK(3,0); Gc[14] = CK(3,1); Gc[15] = CK(3,2);
            sort16(Gc);
            merge16(C, Gc);
            Gc[0] = CK(3,3); Gc[1] = CK(4,0); Gc[2] = CK(4,1); Gc[3] = CK(4,2); Gc[4] = CK(5,0); Gc[5] = CK(5,1); Gc[6] = CK(6,0); Gc[7] = CK(6,1); Gc[8] = CK(7,0); Gc[9] = CK(7,1); Gc[10] = CK(8,0); Gc[11] = CK(9,0); Gc[12] = CK(10,0); Gc[13] = CK(11,0); Gc[14] = CK(12,0); Gc[15] = CK(13,0);
            sort16(Gc);
            merge16(C, Gc);
            Gc[0] = CK(14,0); Gc[1] = CK(15,0); Gc[2] = 0u; Gc[3] = 0u; Gc[4] = 0u; Gc[5] = 0u; Gc[6] = 0u; Gc[7] = 0u; Gc[8] = 0u; Gc[9] = 0u; Gc[10] = 0u; Gc[11] = 0u; Gc[12] = 0u; Gc[13] = 0u; Gc[14] = 0u; Gc[15] = 0u;
            sort16(Gc);
            merge16(C, Gc);
#undef CK
            float gsum = 0.f, gv[16]; int ex[16];
            const float top = key2f(C[0] & ~0xffu) * rstd;
#pragma unroll
            for (int k = 0; k < 16; ++k) {
                const float e = __builtin_amdgcn_exp2f((key2f(C[k] & ~0xffu) * rstd - top) * LOG2E); gv[k] = e; gsum += e;
                ex[k] = (int)(lut16(p1, (C[k] >> 4) & 15u) * 128u + lut16(p2, C[k] & 15u));
            }
            const float ginv = 1.0f / gsum;
            int* ip = F.IDX + (size_t)tok * 128 + h * 16 + hh * 8;
            typedef int i32x4 __attribute__((ext_vector_type(4)));
            i32x4 i0, i1;
#pragma unroll
            for (int k = 0; k < 4; ++k) {
                const int ea = hh ? ex[8 + k] : ex[k], eb = hh ? ex[12 + k] : ex[4 + k];
                const float ga = (hh ? gv[8 + k] : gv[k]) * ginv, gb = (hh ? gv[12 + k] : gv[4 + k]) * ginv;
                i0[k] = (ea << 18) | (int)(ga * 262143.0f + 0.5f); i1[k] = (eb << 18) | (int)(gb * 262143.0f + 0.5f);
            }
            *(i32x4*)ip = i0; *(i32x4*)(ip + 4) = i1;
        }
    }
}

typedef int v8i_t __attribute__((ext_vector_type(8)));
#define H8C(x) __builtin_amdgcn_fmed3f((x), -448.f, 448.f)
__device__ __forceinline__ void peer_gather_phase(Frame& F) {
    const int lane = F.lane, rw = lane >> 4, c = lane & 15;
    const int gw = F.vcu * NWAVES + F.wave, NGW = F.G * NWAVES;
    const float* wfin = F.in[I_NFINAL];
    LAS unsigned* SW = (LAS unsigned*)F.lds + F.wave * 512;
    LAS float* AW = (LAS float*)(F.lds + 16384) + F.wave * 512;
    LAS unsigned char* AT = F.lds + 32768 + F.wave * 4096;
    int round = 0;
#pragma unroll 1
    for (int tbase = gw * 4; tbase < M; tbase += NGW * 4, ++round) {
#ifdef ROUND_SYNC
        if (F.rnd_nloc > 0) {
            __syncthreads();
            if (F.tid == 0) {
                gu32* cw = F.ctl + CW_RND + 64 * F.rnd_x;
                __hip_atomic_fetch_add(cw, 1u, RLX_AGENT);
                const unsigned want = (unsigned)F.rnd_nloc * (unsigned)(round + 1);
                for (int sp = 0; sp < 20000 && __hip_atomic_load(cw, RLX_AGENT) < want; ++sp) __builtin_amdgcn_s_sleep(2);
            }
            __syncthreads();
        }
#endif
#pragma unroll 1
        for (int j = 0; j < 4; ++j) {
            int lo_ = lane; asm volatile("" : "+v"(lo_));
            unsigned id0 = (unsigned)F.IDX[(size_t)(tbase + j) * 128 + lo_], id1 = (unsigned)F.IDX[(size_t)(tbase + j) * 128 + 64 + lo_];
#define BSTEP(k_, j_, OTH0, OTH1) do { const unsigned o0_ = (OTH0), o1_ = (OTH1); const bool low_ = (lane & (j_)) == 0; \
            const bool up0_ = ((lane & (k_)) == 0), up1_ = (((64 + lane) & (k_)) == 0); \
            const unsigned mn0_ = id0 < o0_ ? id0 : o0_, mx0_ = id0 < o0_ ? o0_ : id0, mn1_ = id1 < o1_ ? id1 : o1_, mx1_ = id1 < o1_ ? o1_ : id1; \
            id0 = (up0_ == low_) ? mn0_ : mx0_; id1 = (up1_ == low_) ? mn1_ : mx1_; } while (0)
#define BSWZ(k_, j_) BSTEP(k_, j_, (unsigned)__builtin_amdgcn_ds_swizzle((int)id0, ((j_) << 10) | 0x1f), (unsigned)__builtin_amdgcn_ds_swizzle((int)id1, ((j_) << 10) | 0x1f))
#define B32(k_) do { const auto p0_ = __builtin_amdgcn_permlane32_swap(id0, id0, false, false); const unsigned p00_ = p0_[0], p01_ = p0_[1]; \
            const auto p1_ = __builtin_amdgcn_permlane32_swap(id1, id1, false, false); const unsigned p10_ = p1_[0], p11_ = p1_[1]; \
            BSTEP(k_, 32, (lane < 32 ? p01_ : p00_), (lane < 32 ? p11_ : p10_)); } while (0)
            BSWZ(2, 1);
            BSWZ(4, 2); BSWZ(4, 1);
            BSWZ(8, 4); BSWZ(8, 2); BSWZ(8, 1);
            BSWZ(16, 8); BSWZ(16, 4); BSWZ(16, 2); BSWZ(16, 1);
            BSWZ(32, 16); BSWZ(32, 8); BSWZ(32, 4); BSWZ(32, 2); BSWZ(32, 1);
            B32(64); BSWZ(64, 16); BSWZ(64, 8); BSWZ(64, 4); BSWZ(64, 2); BSWZ(64, 1);
            { const unsigned mn_ = id0 < id1 ? id0 : id1, mx_ = id0 < id1 ? id1 : id0; id0 = mn_; id1 = mx_; }
            B32(128); BSWZ(128, 16); BSWZ(128, 8); BSWZ(128, 4); BSWZ(128, 2); BSWZ(128, 1);
#undef BSTEP
#undef BSWZ
#undef B32
            SW[j * 128 + lane] = id0; SW[j * 128 + 64 + lane] = id1;
        }
        const int tok = tbase + rw;
        int c1 = c; asm volatile("" : "+v"(c1));
        const bf16* hb = F.HB + (size_t)tok * 1024 + c1 * 64;
        const float rstd = 1.0f / sqrtf(F.SSQ[tok] * (1.f / D) + NORM_EPS);
        const float hscale = rstd * (1.0f / U6_SCALE);
        const LAS unsigned* sw = SW + rw * 128;
        LAS float* aw = AW + rw * 128;
        const unsigned char* vlane = F.V8 + c * 16;
        constexpr int VFMT = V_FP4 ? 4 : 2;
        struct VSet { v4u l4; u32x2 l2; v4u h4; u32x2 h2; };
        VSet sa[4], sb[4];
#define PV_LOAD(q_, T_, S_) do { const int p_ = 4 * (q_) + rw; const unsigned e_ = SW[(T_) * 128 + (p_ < 128 ? p_ : 127)] >> 18; const unsigned char* vb_ = vlane + (size_t)e_ * V_ROW; \
            if (V_FP4) { S_.l4 = *(const v4u*)(vb_); S_.h4 = *(const v4u*)(vb_ + 256); } \
            else { S_.l4 = *(const v4u*)(vb_); S_.l2 = *(const u32x2*)(vb_ + 256 - 8 * c); S_.h4 = *(const v4u*)(vb_ + 384); S_.h2 = *(const u32x2*)(vb_ + 640 - 8 * c); } } while (0)
        PV_LOAD(0, 0, sa[0]); PV_LOAD(0, 1, sa[1]); PV_LOAD(0, 2, sa[2]); PV_LOAD(0, 3, sa[3]);
        PV_LOAD(1, 0, sb[0]); PV_LOAD(1, 1, sb[1]); PV_LOAD(1, 2, sb[2]); PV_LOAD(1, 3, sb[3]);
        {
            v8i_t hbT[4];
#pragma unroll
            for (int t_ = 0; t_ < 4; ++t_) {
                const float bs = H8_SCALE / sqrtf(F.SSQ[tbase + t_] * (1.f / D) + NORM_EPS);
                const bf16* hq = F.HB + (size_t)(tbase + t_) * 1024 + (c & 7) * 128 + rw * 16;
#pragma unroll
                for (int q = 0; q < 4; ++q) {
                    const v4u w = *(const v4u*)(hq + (q >> 1) * 64 + (q & 1) * 8);
                    int d0 = __builtin_amdgcn_cvt_pk_fp8_f32(H8C(bf_lo(w.x) * bs), H8C(bf_hi(w.x) * bs), 0, false); d0 = __builtin_amdgcn_cvt_pk_fp8_f32(H8C(bf_lo(w.y) * bs), H8C(bf_hi(w.y) * bs), d0, true);
                    int d1 = __builtin_amdgcn_cvt_pk_fp8_f32(H8C(bf_lo(w.z) * bs), H8C(bf_hi(w.z) * bs), 0, false); d1 = __builtin_amdgcn_cvt_pk_fp8_f32(H8C(bf_lo(w.w) * bs), H8C(bf_hi(w.w) * bs), d1, true);
                    hbT[t_][2 * q] = d0; hbT[t_][2 * q + 1] = d1;
                }
            }
            const unsigned char* ulane = F.U8 + 16 * (4 * (c & 7) + rw);
            const int uoff2 = 512 - 8 * (4 * (c & 7) + rw);
            constexpr int UFMT = U_FP4 ? 4 : 2;
            const bool dkeep = (c < 8) && ((rw & 1) == (c >> 2));
            struct USet { v4u a; u32x2 b; };
            USet ua[8], ub[8];
#define UA_LOAD(b_, X_, S_) do { const int p_ = 4 * (b_) + 2 * ((X_) & 1) + (c >> 3); const unsigned e_ = SW[((X_) >> 1) * 128 + (p_ < 128 ? p_ : 127)] >> 18; \
                const unsigned char* up_ = ulane + (size_t)e_ * U_ROW; S_.a = *(const v4u*)(up_); if (!U_FP4) S_.b = *(const u32x2*)(up_ + uoff2); } while (0)
#define UA_COMP(X_, S_) do { const v8i_t a8 = {(int)S_.a.x, (int)S_.a.y, (int)S_.a.z, (int)S_.a.w, U_FP4 ? 0 : (int)S_.b.x, U_FP4 ? 0 : (int)S_.b.y, 0, 0}; \
                const f32x4 d_ = __builtin_amdgcn_mfma_scale_f32_16x16x128_f8f6f4(a8, hbT[(X_) >> 1], (f32x4){0.f, 0.f, 0.f, 0.f}, UFMT, 0, 0, 0x7f7f7f7f, 0, 0x7f7f7f7f); \
                const int tq_ = c & 3; const float ds_ = tq_ == 0 ? d_[0] : tq_ == 1 ? d_[1] : tq_ == 2 ? d_[2] : d_[3]; \
                float r_ = allreduce16(dkeep ? ds_ : 0.f); \
                { const auto sw_ = __builtin_amdgcn_permlane16_swap(f2u(r_), f2u(r_), false, false); const unsigned s0_ = sw_[0], s1_ = sw_[1]; r_ = u2f(s0_) + u2f(s1_); } \
                dsel = (c == (X_)) ? r_ : dsel; } while (0)
#define UA_ITER(b_, SETS_) do { float dsel = 0.f; \
                UA_COMP(0, SETS_[0]); UA_LOAD((b_) + 2, 0, SETS_[0]); UA_COMP(1, SETS_[1]); UA_LOAD((b_) + 2, 1, SETS_[1]); \
                UA_COMP(2, SETS_[2]); UA_LOAD((b_) + 2, 2, SETS_[2]); UA_COMP(3, SETS_[3]); UA_LOAD((b_) + 2, 3, SETS_[3]); \
                UA_COMP(4, SETS_[4]); UA_LOAD((b_) + 2, 4, SETS_[4]); UA_COMP(5, SETS_[5]); UA_LOAD((b_) + 2, 5, SETS_[5]); \
                UA_COMP(6, SETS_[6]); UA_LOAD((b_) + 2, 6, SETS_[6]); UA_COMP(7, SETS_[7]); UA_LOAD((b_) + 2, 7, SETS_[7]); \
                  \
                const int wi_ = ((c >> 1) & 3) * 128 + 4 * (b_) + 2 * (c & 1) + (rw >> 1); \
                const unsigned wg_ = SW[wi_]; \
                const float act_ = gelu_erf(dsel * (1.0f / (U6_SCALE * H8_SCALE))) * ((float)(wg_ & 0x3ffffu) * (1.0f / (262143.0f * V6_SCALE))); \
                if (c < 8 && (rw & 1) == 0) AW[wi_] = act_; } while (0)
#pragma unroll
            for (int x_ = 0; x_ < 8; ++x_) UA_LOAD(0, x_, ua[x_]);
#pragma unroll
            for (int x_ = 0; x_ < 8; ++x_) UA_LOAD(1, x_, ub[x_]);
#pragma unroll 1
            for (int b = 0; b < 32; b += 2) {
                if ((b & 3) == 0) __builtin_amdgcn_s_barrier();
                UA_ITER(b, ua);
                UA_ITER(b + 1, ub);
            }
#undef UA_LOAD
#undef UA_COMP
#undef UA_ITER
        }
        f32x4 dd[4][4];
#pragma unroll
        for (int t_ = 0; t_ < 4; ++t_)
#pragma unroll
            for (int x_ = 0; x_ < 4; ++x_) dd[t_][x_] = (f32x4){0.f, 0.f, 0.f, 0.f};
        {
            const unsigned selA = 0x0c0c0c0cu ^ (0x0cu << (8 * (c & 3))), selB = selA | (1u << (8 * (c & 3)));
            unsigned mk[2][4];
#pragma unroll
            for (int s_ = 0; s_ < 2; ++s_)
#pragma unroll
                for (int d_ = 0; d_ < 4; ++d_) mk[s_][d_] = ((c >> 2) == d_ && (rw & 1) == s_) ? 0xffffffffu : 0u;
#define PV_COMP(q_, T_, S_) do { const LAS float* ap_ = AW + (T_) * 128 + 4 * (q_) + (rw >> 1); \
                const float a0_ = __builtin_amdgcn_fmed3f(ap_[0] * A8_SCALE, -448.f, 448.f), a1_ = __builtin_amdgcn_fmed3f(ap_[2] * A8_SCALE, -448.f, 448.f); \
                const unsigned w_ = (unsigned)__builtin_amdgcn_cvt_pk_fp8_f32(a0_, a1_, 0, false); \
                const unsigned x0_ = __builtin_amdgcn_perm(w_, w_, selA), x1_ = __builtin_amdgcn_perm(w_, w_, selB); \
                const v8i_t b0_ = {(int)(x0_ & mk[0][0]), (int)(x0_ & mk[0][1]), (int)(x0_ & mk[0][2]), (int)(x0_ & mk[0][3]), (int)(x1_ & mk[0][0]), (int)(x1_ & mk[0][1]), (int)(x1_ & mk[0][2]), (int)(x1_ & mk[0][3])}; \
                const v8i_t b1_ = {(int)(x0_ & mk[1][0]), (int)(x0_ & mk[1][1]), (int)(x0_ & mk[1][2]), (int)(x0_ & mk[1][3]), (int)(x1_ & mk[1][0]), (int)(x1_ & mk[1][1]), (int)(x1_ & mk[1][2]), (int)(x1_ & mk[1][3])}; \
                const v8i_t al_ = {(int)S_.l4.x, (int)S_.l4.y, (int)S_.l4.z, (int)S_.l4.w, V_FP4 ? 0 : (int)S_.l2.x, V_FP4 ? 0 : (int)S_.l2.y, 0, 0}; \
                const v8i_t ah_ = {(int)S_.h4.x, (int)S_.h4.y, (int)S_.h4.z, (int)S_.h4.w, V_FP4 ? 0 : (int)S_.h2.x, V_FP4 ? 0 : (int)S_.h2.y, 0, 0}; \
                dd[T_][0] = __builtin_amdgcn_mfma_scale_f32_16x16x128_f8f6f4(al_, b0_, dd[T_][0], VFMT, 0, 0, 0x7f7f7f7f, 0, 0x7f7f7f7f); \
                dd[T_][1] = __builtin_amdgcn_mfma_scale_f32_16x16x128_f8f6f4(al_, b1_, dd[T_][1], VFMT, 0, 0, 0x7f7f7f7f, 0, 0x7f7f7f7f); \
                dd[T_][2] = __builtin_amdgcn_mfma_scale_f32_16x16x128_f8f6f4(ah_, b0_, dd[T_][2], VFMT, 0, 0, 0x7f7f7f7f, 0, 0x7f7f7f7f); \
                dd[T_][3] = __builtin_amdgcn_mfma_scale_f32_16x16x128_f8f6f4(ah_, b1_, dd[T_][3], VFMT, 0, 0, 0x7f7f7f7f, 0, 0x7f7f7f7f); } while (0)
#pragma unroll 1
            for (int q = 0; q < 32; q += 2) {
                if ((q & 3) == 0) __builtin_amdgcn_s_barrier();
                PV_COMP(q, 0, sa[0]); PV_LOAD(q + 2, 0, sa[0]); PV_COMP(q, 1, sa[1]); PV_LOAD(q + 2, 1, sa[1]);
                PV_COMP(q, 2, sa[2]); PV_LOAD(q + 2, 2, sa[2]); PV_COMP(q, 3, sa[3]); PV_LOAD(q + 2, 3, sa[3]);
                PV_COMP(q + 1, 0, sb[0]); PV_LOAD(q + 3, 0, sb[0]); PV_COMP(q + 1, 1, sb[1]); PV_LOAD(q + 3, 1, sb[1]);
                PV_COMP(q + 1, 2, sb[2]); PV_LOAD(q + 3, 2, sb[2]); PV_COMP(q + 1, 3, sb[3]); PV_LOAD(q + 3, 3, sb[3]);
            }
#undef PV_LOAD
#undef PV_COMP
        }
        {
            LAS float* OT = (LAS float*)AT;
            int l2 = lane; asm volatile("" : "+v"(l2));
            u32x2 hw[4][4]; f32x4 wf[4];
#pragma unroll
            for (int t_ = 0; t_ < 4; ++t_)
#pragma unroll
                for (int k = 0; k < 4; ++k) hw[t_][k] = *(const u32x2*)(F.HB + (size_t)(tbase + t_) * 1024 + 256 * k + 4 * l2);
#pragma unroll
            for (int k = 0; k < 4; ++k) wf[k] = *(const f32x4*)(wfin + 256 * k + 4 * l2);
#pragma unroll
            for (int t_ = 0; t_ < 4; ++t_) {
                const int tok = tbase + t_;
#pragma unroll
                for (int x_ = 0; x_ < 4; ++x_)
#pragma unroll
                    for (int r_ = 0; r_ < 4; ++r_) OT[512 * (x_ >> 1) + 32 * (4 * rw + r_) + 16 * (x_ & 1) + c] = dd[t_][x_][r_];
                f32x4 o[4]; float ss = 0.f;
#pragma unroll
                for (int k = 0; k < 4; ++k) {
                    const f32x4 ov = *(const LAS f32x4*)(OT + 256 * k + 4 * l2);
                    const u32x2 hwk = hw[t_][k];
                    o[k] = (f32x4){ov[0] * (1.0f / A8_SCALE) + bf_lo(hwk.x), ov[1] * (1.0f / A8_SCALE) + bf_hi(hwk.x), ov[2] * (1.0f / A8_SCALE) + bf_lo(hwk.y), ov[3] * (1.0f / A8_SCALE) + bf_hi(hwk.y)};
                    ss += (o[k][0] * o[k][0] + o[k][1] * o[k][1]) + (o[k][2] * o[k][2] + o[k][3] * o[k][3]);
                }
                const float rf = 1.0f / sqrtf(wave_allreduce(ss) * (1.f / D) + NORM_EPS);
#pragma unroll
                for (int k = 0; k < 4; ++k)
                    *(f32x4*)(F.out + (size_t)tok * 1024 + 256 * k + 4 * l2) = (f32x4){o[k][0] * rf * wf[k][0], o[k][1] * rf * wf[k][1], o[k][2] * rf * wf[k][2], o[k][3] * rf * wf[k][3]};
            }
        }
    }
}

#ifndef MK_N_LAUNCHES
#define MK_N_LAUNCHES 1
#endif
constexpr int N_PHASES = 10;
struct Args { const float* in[24]; float* out; unsigned char* ws; int ph_lo, ph_hi; };
__global__ void __launch_bounds__(NWAVES * 64, 2) mega_fwd(Args args) {
    extern __shared__ __attribute__((aligned(16))) unsigned char lds[];
    Frame F;
    F.lds = (LAS unsigned char*)lds;
    F.MISC = (volatile LAS unsigned*)(F.lds + MISC_OFF);
    F.tid = threadIdx.x; F.lane = F.tid & 63; F.wave = __builtin_amdgcn_readfirstlane(F.tid >> 6);
    F.G = gridDim.x; { const int bx = blockIdx.x; F.vcu = (F.G % 8 == 0) ? (bx % 8) * (F.G / 8) + bx / 8 : bx; }
    unsigned char* ws = args.ws;
    F.ctl = (gu32*)(ws + WS_CTL);
#pragma unroll
    for (int i = 0; i < 24; ++i) F.in[i] = args.in[i];
    F.out = args.out;
    F.ROPE = (float*)(ws + WS_ROPE); F.SSQ = (float*)(ws + WS_SSQ);
    F.WIN = (bf16*)(ws + WS_WIN); F.PA = (bf16*)(ws + WS_PA); F.PB = (bf16*)(ws + WS_PB); F.WOUT = (bf16*)(ws + WS_WOUT); F.WQ = (bf16*)(ws + WS_WQ); F.LW = (bf16*)(ws + WS_LW);
    F.SK = (bf16*)(ws + WS_SK); F.U8 = ws + WS_U8; F.V8 = ws + WS_V8; F.XN = (bf16*)(ws + WS_XN); F.LA = (bf16*)(ws + WS_LA); F.YA = (bf16*)(ws + WS_YA);
    F.QKV = (bf16*)(ws + WS_QKV); F.YB = (bf16*)(ws + WS_YB); F.RKV = (bf16*)(ws + WS_RKV); F.HB = (bf16*)(ws + WS_HB); F.LORA = (bf16*)(ws + WS_LORA);
    F.GA = (bf16*)(ws + WS_GA); F.GB = (bf16*)(ws + WS_GB); F.DAG = (bf16*)(ws + WS_DAG); F.QP = (bf16*)(ws + WS_QP);
    F.IDX = (int*)(ws + WS_IDX); F.GATE = (float*)(ws + WS_GATE);
    for (int u = F.tid; u < (LDS_BYTES - LDSCTL_OFF) / 4; u += NWAVES * 64) ((LAS unsigned*)(F.lds + LDSCTL_OFF))[u] = 0u;
    __syncthreads();
    XcdBarrier bar; bar.bar = (unsigned*)(F.ctl + CW_BAR); bar.x = 0; bar.st = nullptr;
    const bool multi = (args.ph_hi - args.ph_lo) > 1;
    if (multi) bar = xcd_barrier_post((unsigned*)(F.ctl + CW_BAR), F.MISC + 8);
    const int lo = args.ph_lo, hi = args.ph_hi;
#ifndef PH_MASK
#define PH_MASK 0x3ff
#endif
#define IN(k) ((((PH_MASK) >> (k)) & 1) && lo <= (k) && (k) < hi)
#define SEAM(k) do { if (IN(k) && IN((k) + 1)) xcd_barrier(bar); } while (0)
    if (IN(0)) { p0_prologue(F); if (DUP_PHASE == 0) p0_prologue(F); }
    SEAM(0);
    if (IN(1)) {
        pg8::Gemm g{F.XN, F.WIN, M, NZ, D}; pg8::StaticOrder S; S.init(M, NZ, F.G, (int)blockIdx.x);
        pg8::EpiZ E{F.QKV, F.RKV, F.LORA, F.GA, F.GB, F.ROPE, QSCALE};
        pg8::gemm_phase<pg8::EpiZ, pg8::StaticOrder, true, true>(F.lds, g, S, E);
        if (DUP_PHASE == 1) pg8::gemm_phase<pg8::EpiZ, pg8::StaticOrder, true, true>(F.lds, g, S, E);
    }
    SEAM(1);
    if (IN(2)) { attn_phase(F); lora_prep_phase(F); if (DUP_PHASE == 2) attn_phase(F); if (DUP_PHASE == 22) lora_prep_phase(F); }
    SEAM(2);
    if (IN(3)) {
#ifndef P3_NO_A
        { pg8::Gemm g{F.LA, F.LW, M, 1536, 384}; pg8::StaticOrder S; S.init(M, 1536, F.G, (int)blockIdx.x);
          pg8::EpiDAG E{F.DAG, F.in[I_W0], F.in[I_A0]};
          pg8::gemm_phase<pg8::EpiDAG, pg8::StaticOrder, true, true>(F.lds, g, S, E);
          if (DUP_PHASE == 3) pg8::gemm_phase<pg8::EpiDAG, pg8::StaticOrder, true, true>(F.lds, g, S, E); }
#endif
#ifndef P3_NO_B
        { pg8::Gemm g{F.YA, F.PA, M, 1024, 512}; pg8::StaticOrder S; S.init(M, 1024, F.G, (int)blockIdx.x);
          pg8::EpiGate<0> E{F.GA, nullptr};
          pg8::gemm_phase<pg8::EpiGate<0>, pg8::StaticOrder, true, true>(F.lds, g, S, E); }
#endif
    }
    SEAM(3);
    if (IN(4)) { scan_phase(F); if (DUP_PHASE == 4) scan_phase(F); }
    SEAM(4);
    if (IN(5)) {
        pg8::Gemm g{F.YB, F.PB, M, 1024, 512}; pg8::StaticOrder S; S.init(M, 1024, F.G, (int)blockIdx.x);
        pg8::EpiGate<1> E{F.GA, F.GB};
        pg8::gemm_phase<pg8::EpiGate<1>, pg8::StaticOrder, true, true>(F.lds, g, S, E);
    }
    SEAM(5);
    if (IN(6)) {
        pg8::Gemm g{F.GA, F.WOUT, M, 1024, 1024}; pg8::StaticOrder S; S.init(M, 1024, F.G, (int)blockIdx.x);
        pg8::EpiH E{F.in[I_X], F.out, F.HB, F.SSQ};
        pg8::gemm_phase<pg8::EpiH, pg8::StaticOrder, true, true>(F.lds, g, S, E);
    }
    SEAM(6);
    if (IN(7)) {
        pg8::Gemm g{F.HB, F.WQ, M, 1024, 1024}; pg8::StaticOrder S; S.init(M, 1024, F.G, (int)blockIdx.x);
        pg8::EpiPlain E{F.QP, 1024};
        pg8::gemm_phase<pg8::EpiPlain, pg8::StaticOrder, true, true>(F.lds, g, S, E);
        if (DUP_PHASE == 7) pg8::gemm_phase<pg8::EpiPlain, pg8::StaticOrder, true, true>(F.lds, g, S, E);
    }
    SEAM(7);
    if (IN(8)) { peer_topk_phase(F); if (DUP_PHASE == 8) peer_topk_phase(F); }
    SEAM(8);
    if (IN(9)) { F.rnd_nloc = multi ? __builtin_amdgcn_readfirstlane((int)F.MISC[8]) : 0; F.rnd_x = __builtin_amdgcn_readfirstlane((int)bar.x); peer_gather_phase(F); if (DUP_PHASE == 9) { F.rnd_nloc = 0; peer_gather_phase(F); } }
#undef IN
#undef SEAM
}

extern "C" void kernel_launch(void* const* d_in, const int* in_sizes, int n_in, void* d_out, int out_size, void* d_ws, size_t ws_size, hipStream_t stream) {
    static int grid = 0;
    if (grid == 0) {
        if (n_in != 24 || in_sizes[0] != M * D || out_size != M * D || ws_size < WS_END) { fprintf(stderr, "kernel_launch: unexpected problem (n_in %d, in0 %d, out %d, ws %zu < %zu); nothing launched\n", n_in, n_in > 0 ? in_sizes[0] : -1, out_size, ws_size, (size_t)WS_END); grid = -1; return; }
        int dev = 0, cus = 0, per_cu = 0;
        if (hipGetDevice(&dev) != hipSuccess || hipDeviceGetAttribute(&cus, hipDeviceAttributeMultiprocessorCount, dev) != hipSuccess) { fprintf(stderr, "kernel_launch: device query failed\n"); grid = -1; return; }
        if (hipFuncSetAttribute((const void*)mega_fwd, hipFuncAttributeMaxDynamicSharedMemorySize, LDS_BYTES) != hipSuccess) { fprintf(stderr, "kernel_launch: hipFuncSetAttribute failed\n"); grid = -1; return; }
        if (hipOccupancyMaxActiveBlocksPerMultiprocessor(&per_cu, (const void*)mega_fwd, NWAVES * 64, LDS_BYTES) != hipSuccess || per_cu < 1)
            fprintf(stderr, "kernel_launch: note: occupancy query reports %d workgroups per CU\n", per_cu);
        (void)hipGetLastError();
        grid = cus;
    }
    if (grid < 0) return;
    if (hipMemsetAsync((char*)d_ws + WS_CTL, 0, CTL_ZERO_BYTES, stream) != hipSuccess) { fprintf(stderr, "kernel_launch: memset failed\n"); return; }
    Args a{};
    for (int i = 0; i < 24; ++i) a.in[i] = (const float*)d_in[i];
    a.out = (float*)d_out; a.ws = (unsigned char*)d_ws;
#if MK_N_LAUNCHES == 1
    a.ph_lo = 0; a.ph_hi = N_PHASES;
    hipLaunchKernelGGL(mega_fwd, dim3(grid), dim3(NWAVES * 64), LDS_BYTES, stream, a);
#else
    for (int p = 0; p < N_PHASES; ++p) { a.ph_lo = p; a.ph_hi = p + 1; hipLaunchKernelGGL(mega_fwd, dim3(grid), dim3(NWAVES * 64), LDS_BYTES, stream, a); }
#endif
    const hipError_t le = hipPeekAtLastError();
    if (le != hipSuccess) fprintf(stderr, "kernel_launch: launch failed: %s\n", hipGetErrorName(le));
}
```

```cpp
#include <hip/hip_runtime.h>
#include <cstdio>
#include <cstdint>
namespace pg8 {
#define PG8_LAS __attribute__((address_space(3)))
typedef unsigned short bf16_t;
typedef short bf16x8 __attribute__((ext_vector_type(8)));
typedef float f32x4 __attribute__((ext_vector_type(4)));
typedef unsigned u32x4 __attribute__((ext_vector_type(4)));
constexpr int BM = 256, BK = 64, HALF = 128, HTB = HALF * BK * 2  , STAGE_BYTES = 8 * HTB, NXCD = 8, WGM = 8;

__host__ __device__ __forceinline__ int lds_byte(int r, int c) { const int st = (r >> 4) * 2 + (c >> 5), rr = r & 15, cc = c & 31, ob = rr * 64 + cc * 2; return st * 1024 + (ob ^ (((ob >> 9) & 1) << 5)); }
__host__ __device__ __forceinline__ void stage_rc(int b, int& R, int& C) { const int st = b / 1024, sb = b % 1024, swz = sb ^ (((sb >> 9) & 1) << 5); R = (st >> 1) * 16 + swz / 64; C = (st & 1) * 32 + (swz % 64) / 2; }
__host__ __device__ __forceinline__ int perm32(int rho) { const int n = rho >> 4, i = rho & 15; return 8 * (i >> 2) + 4 * n + (i & 3); }

struct Unit { int pm, pn; };
struct Gemm { const bf16_t* A; const bf16_t* Bt; int M, N, K; };

struct StaticOrder {
    int nM, nN, nwg, G, c;
    __host__ __device__ void init(int M, int N, int G_, int c_) { nM = M / BM; nN = N / BM; nwg = nM * nN; G = G_; c = c_; }
    __host__ __device__ bool next(int i, Unit& u) const {
        const long L = (long)i * G + c; if (L >= nwg) return false;
        int wgid = (int)L; { const int q = nwg / NXCD, r = nwg % NXCD, xcd = wgid % NXCD, off = wgid / NXCD; wgid = (xcd < r ? xcd * (q + 1) : r * (q + 1) + (xcd - r) * q) + off; }
        const int nig = WGM * nN, gid = wgid / nig, fm = gid * WGM, gsz = (nM - fm) < WGM ? (nM - fm) : WGM;
        u.pm = fm + ((wgid % nig) % gsz); u.pn = (wgid % nig) / gsz; return true;
    }
    __device__ __forceinline__ void a_ready(const Unit&) const {}
    __device__ __forceinline__ void done(const Unit&) const {}
};

__device__ __forceinline__ unsigned cvt_pk_bf16(float lo, float hi) { unsigned r; asm volatile("v_cvt_pk_bf16_f32 %0, %1, %2" : "=v"(r) : "v"(lo), "v"(hi)); return r; }
typedef float f32x2 __attribute__((ext_vector_type(2)));
__device__ __forceinline__ f32x2 gelu_pk(f32x2 v) {
    const f32x2 av = __builtin_elementwise_abs(v), d = av * 0.2316418882f + 1.0f;
    f32x2 t; t.x = __builtin_amdgcn_rcpf(d.x); t.y = __builtin_amdgcn_rcpf(d.y);
    f32x2 q = t * 0.5307027145f + (-0.7265760135f); q = q * t + 0.7107068705f; q = q * t + (-0.142248368f); q = q * t + 0.127414796f; q = q * t;
    const f32x2 s = (v * v) * (-0.72134752044f);
    f32x2 e; e.x = __builtin_amdgcn_exp2f(s.x); e.y = __builtin_amdgcn_exp2f(s.y);
    const f32x2 m = v * (q * e), r = v - m;
    f32x2 o; o.x = v.x < 0.f ? m.x : r.x; o.y = v.y < 0.f ? m.y : r.y; return o;
}

__device__ __forceinline__ float sigm(float x) { return __builtin_amdgcn_rcpf(1.0f + __builtin_amdgcn_exp2f(-1.4426950408889634f * x)); }
__device__ __forceinline__ u32x4 pack8(const f32x4 v0, const f32x4 v1) { u32x4 w; w.x = cvt_pk_bf16(v0[0], v0[1]); w.y = cvt_pk_bf16(v0[2], v0[3]); w.z = cvt_pk_bf16(v1[0], v1[1]); w.w = cvt_pk_bf16(v1[2], v1[3]); return w; }
__device__ __forceinline__ float bflo(unsigned w) { return __builtin_bit_cast(float, w << 16); }
__device__ __forceinline__ float bfhi(unsigned w) { return __builtin_bit_cast(float, w & 0xffff0000u); }

struct EpiZ {
    static constexpr bool PERM = true, AFTER_DRAIN = false;
    bf16_t *QKV, *RKV, *LORA, *GA, *GB; const float* cs; float qscale;
    __device__ __forceinline__ void operator()(const f32x4 (&acc)[2][2][4][2], const Unit& u, int wr, int wc, int fr, int fq) const {
        const int pn = u.pn;
        bf16_t* base; int ld, colt, mode;
        if (pn < 3)       { base = QKV;  ld = 768;  colt = pn * 256;        mode = (pn < 2) ? 1 : 2; }
        else if (pn < 9)  { base = RKV;  ld = 1536; colt = (pn - 3) * 256;  mode = 0; }
        else if (pn < 11) { base = LORA; ld = 512;  colt = (pn - 9) * 256;  mode = 0; }
        else if (pn < 15) { base = GA;   ld = 1024; colt = (pn - 11) * 256; mode = 3; }
        else              { base = GB;   ld = 1024; colt = (pn - 15) * 256; mode = 3; }
        const int row0 = u.pm * BM + wr * 64 + fr, col0 = colt + wc * 32 + 8 * fq;
        const int i0 = 16 * (wc & 1) + 4 * fq;
#pragma unroll
        for (int ai = 0; ai < 2; ++ai)
#pragma unroll
            for (int m = 0; m < 4; ++m) {
                const int row = row0 + ai * HALF + m * 16;
                bf16_t* rowp = base + (size_t)row * ld + col0;
                f32x4 c0 = (f32x4){1.f, 0.f, 1.f, 0.f}, c1 = c0;
                if (mode == 1 || mode == 2) { const f32x4* cp = (const f32x4*)(cs + ((size_t)(row & 2047) * 32 + i0) * 2); c0 = cp[0]; c1 = cp[1]; }
#pragma unroll
                for (int bj = 0; bj < 2; ++bj) {
                    f32x4 v0 = acc[ai][bj][m][0], v1 = acc[ai][bj][m][1];
                    if (mode == 1 || (mode == 2 && bj == 0)) {
                        f32x4 r0, r1;
                        r0[0] = v0[0] * c0[0] - v0[1] * c0[1]; r0[1] = v0[1] * c0[0] + v0[0] * c0[1];
                        r0[2] = v0[2] * c0[2] - v0[3] * c0[3]; r0[3] = v0[3] * c0[2] + v0[2] * c0[3];
                        r1[0] = v1[0] * c1[0] - v1[1] * c1[1]; r1[1] = v1[1] * c1[0] + v1[0] * c1[1];
                        r1[2] = v1[2] * c1[2] - v1[3] * c1[3]; r1[3] = v1[3] * c1[2] + v1[2] * c1[3];
                        if (mode == 1) { r0 = r0 * qscale; r1 = r1 * qscale; }
                        v0 = r0; v1 = r1;
                    } else if (mode == 3) {
#pragma unroll
                        for (int e = 0; e < 4; ++e) { v0[e] = sigm(v0[e]); v1[e] = sigm(v1[e]); }
                    }
                    if (base == RKV) {
                        const int j = col0 + bj * HALF, which = j >> 9, hh = (j >> 6) & 7, d = j & 63;
                        *(u32x4*)(RKV + ((size_t)(((row >> 11) * 8 + hh) * 2048 + (row & 2047))) * 192 + which * 64 + d) = pack8(v0, v1);
                    } else
                    *(u32x4*)(rowp + bj * HALF) = pack8(v0, v1);
                }
            }
    }
};
struct EpiDAG {
    static constexpr bool PERM = true, AFTER_DRAIN = false;
    bf16_t* DAG; const float* w0; const float* a0;
    __device__ __forceinline__ void operator()(const f32x4 (&acc)[2][2][4][2], const Unit& u, int wr, int wc, int fr, int fq) const {
        const int pn = u.pn, mode = pn >> 1;
        const int row0 = u.pm * BM + wr * 64 + fr, col0 = pn * BM + wc * 32 + 8 * fq;
#pragma unroll
        for (int bj = 0; bj < 2; ++bj) {
            f32x4 b0 = (f32x4){0.f, 0.f, 0.f, 0.f}, b1 = b0;
            if (mode == 0) { b0 = *(const f32x4*)(w0 + col0 + bj * HALF); b1 = *(const f32x4*)(w0 + col0 + bj * HALF + 4); }
            else if (mode == 1) { b0 = *(const f32x4*)(a0 + (col0 - 512) + bj * HALF); b1 = *(const f32x4*)(a0 + (col0 - 512) + bj * HALF + 4); }
            const float sc = (mode == 0) ? 0.6065306597126334f : 1.0f;
#pragma unroll
            for (int ai = 0; ai < 2; ++ai)
#pragma unroll
                for (int m = 0; m < 4; ++m) {
                    const int row = row0 + ai * HALF + m * 16, j = col0 + bj * HALF;
                    bf16_t* rowp = DAG + ((size_t)(((row >> 11) * 8 + ((j >> 6) & 7)) * 2048 + (row & 2047))) * 192 + (j >> 9) * 64 + (j & 63);
                    f32x4 v0 = acc[ai][bj][m][0] + b0, v1 = acc[ai][bj][m][1] + b1;
                    if (mode < 2) {
#pragma unroll
                        for (int e = 0; e < 4; ++e) { v0[e] = sigm(v0[e]) * sc; v1[e] = sigm(v1[e]) * sc; }
                    }
                    *(u32x4*)rowp = pack8(v0, v1);
                    asm volatile("" ::: "memory");
                }
        }
    }
};
template <int SECOND> struct EpiGate {
    static constexpr bool PERM = true, AFTER_DRAIN = false;
    bf16_t* G; const bf16_t* G2;
    __device__ __forceinline__ void operator()(const f32x4 (&acc)[2][2][4][2], const Unit& u, int wr, int wc, int fr, int fq) const {
        const int row0 = u.pm * BM + wr * 64 + fr, col0 = u.pn * BM + wc * 32 + 8 * fq;
#pragma unroll
        for (int ai = 0; ai < 2; ++ai)
#pragma unroll
            for (int m = 0; m < 4; ++m) {
                const size_t off = (size_t)(row0 + ai * HALF + m * 16) * 1024 + col0;
#pragma unroll
                for (int bj = 0; bj < 2; ++bj) {
                    const u32x4 g = *(const u32x4*)(G + off + bj * HALF);
                    f32x4 v0 = acc[ai][bj][m][0], v1 = acc[ai][bj][m][1];
                    if (SECOND) {
                        const u32x4 h = *(const u32x4*)(G2 + off + bj * HALF);
                        v0[0] = bflo(g.x) + bflo(h.x) * v0[0]; v0[1] = bfhi(g.x) + bfhi(h.x) * v0[1]; v0[2] = bflo(g.y) + bflo(h.y) * v0[2]; v0[3] = bfhi(g.y) + bfhi(h.y) * v0[3];
                        v1[0] = bflo(g.z) + bflo(h.z) * v1[0]; v1[1] = bfhi(g.z) + bfhi(h.z) * v1[1]; v1[2] = bflo(g.w) + bflo(h.w) * v1[2]; v1[3] = bfhi(g.w) + bfhi(h.w) * v1[3];
                    } else {
                        v0[0] *= bflo(g.x); v0[1] *= bfhi(g.x); v0[2] *= bflo(g.y); v0[3] *= bfhi(g.y);
                        v1[0] *= bflo(g.z); v1[1] *= bfhi(g.z); v1[2] *= bflo(g.w); v1[3] *= bfhi(g.w);
                    }
                    *(u32x4*)(G + off + bj * HALF) = pack8(v0, v1);
                }
            }
    }
};
struct EpiH {
    static constexpr bool PERM = true, AFTER_DRAIN = false;
    const float* X; float* Hf; bf16_t* HB; float* ssq;
    __device__ __forceinline__ void operator()(const f32x4 (&acc)[2][2][4][2], const Unit& u, int wr, int wc, int fr, int fq) const {
        const int row0 = u.pm * BM + wr * 64 + fr, col0 = u.pn * BM + wc * 32 + 8 * fq;
#pragma unroll
        for (int ai = 0; ai < 2; ++ai)
#pragma unroll
            for (int m = 0; m < 4; ++m) {
                const int row = row0 + ai * HALF + m * 16;
                const size_t off = (size_t)row * 1024 + col0;
                float s = 0.f;
#pragma unroll
                for (int bj = 0; bj < 2; ++bj) {
                    const f32x4 x0 = *(const f32x4*)(X + off + bj * HALF), x1 = *(const f32x4*)(X + off + bj * HALF + 4);
#ifdef DBG_NO_MIX
                    const f32x4 v0 = x0, v1 = x1;
#else
                    const f32x4 v0 = acc[ai][bj][m][0] + x0, v1 = acc[ai][bj][m][1] + x1;
#endif
                    *(u32x4*)(HB + off + bj * HALF) = pack8(v0, v1);
                    s += (v0[0] * v0[0] + v0[1] * v0[1]) + (v0[2] * v0[2] + v0[3] * v0[3]) + (v1[0] * v1[0] + v1[1] * v1[1]) + (v1[2] * v1[2] + v1[3] * v1[3]);
                }
                s += __shfl_xor(s, 16); s += __shfl_xor(s, 32);
                if (fq == 0) unsafeAtomicAdd(ssq + row, s);
            }
    }
};
struct EpiPlain {
    static constexpr bool PERM = true, AFTER_DRAIN = false;
    bf16_t* O; int ldc;
    __device__ __forceinline__ void operator()(const f32x4 (&acc)[2][2][4][2], const Unit& u, int wr, int wc, int fr, int fq) const {
        const int row0 = u.pm * BM + wr * 64 + fr, col0 = u.pn * BM + wc * 32 + 8 * fq;
#pragma unroll
        for (int ai = 0; ai < 2; ++ai)
#pragma unroll
            for (int m = 0; m < 4; ++m) { bf16_t* rowp = O + (size_t)(row0 + ai * HALF + m * 16) * ldc + col0;
#pragma unroll
                for (int bj = 0; bj < 2; ++bj) *(u32x4*)(rowp + bj * HALF) = pack8(acc[ai][bj][m][0], acc[ai][bj][m][1]); }
    }
};

template <class Epi, class Sched, bool ALIGN_EPI = false, bool SP2 = false>
__device__ __forceinline__ void gemm_phase(PG8_LAS unsigned char* lds, const Gemm g, const Sched& S, const Epi& E) {
    const int tid = threadIdx.x, wid = __builtin_amdgcn_readfirstlane(tid >> 6), lane = tid & 63, wr = wid >> 2, wc = wid & 3, fr = lane & 15, fq = lane >> 4;
    const int K = g.K, nt = K / BK;
    unsigned voffA[2], voffB[2];
#pragma unroll
    for (int i = 0; i < 2; ++i) { int R, C; stage_rc(tid * 16 + i * 8192, R, C); const int Rb = Epi::PERM ? ((R & ~31) + perm32(R & 31)) : R;
        voffA[i] = (unsigned)(R * K + C) * 2u; voffB[i] = (unsigned)(Rb * K + C) * 2u; }
    const size_t kstep = (size_t)(BK * 2);
    const size_t hstep = (size_t)HALF * K * 2;
    const size_t tstep = 2 * hstep;
    const unsigned ldsw = (unsigned)wid * 1024u;
    const int aoff = lds_byte(wr * 64 + fr, fq * 8), boff = lds_byte(wc * 32 + fr, fq * 8);
#define PG8_SA(b, h) (((b) * 2 + (h)) * HTB)
#define PG8_SB(b, h) ((4 + (b) * 2 + (h)) * HTB)
#define PG8_STAGE(bufoff, gbase, voff) do { _Pragma("unroll") for (int _i = 0; _i < 2; ++_i) \
        __builtin_amdgcn_global_load_lds((const unsigned*)((const char*)(gbase) + (voff)[_i]), (PG8_LAS unsigned*)(lds + (bufoff) + ldsw + _i * 8192), 16, 0, 0); } while (0)
#define PG8_LDA(dst, b, h) do { _Pragma("unroll") for (int m = 0; m < 4; ++m) _Pragma("unroll") for (int k = 0; k < 2; ++k) dst[m][k] = *(const PG8_LAS bf16x8*)(lds + PG8_SA(b, h) + aoff + m * 2048 + k * 1024); } while (0)
#define PG8_LDB(dst, b, h) do { _Pragma("unroll") for (int n = 0; n < 2; ++n) _Pragma("unroll") for (int k = 0; k < 2; ++k) dst[n][k] = *(const PG8_LAS bf16x8*)(lds + PG8_SB(b, h) + boff + n * 2048 + k * 1024); } while (0)
#define PG8_MMA(ai, bj, At, Bt) do { __builtin_amdgcn_s_setprio(1); _Pragma("unroll") for (int m = 0; m < 4; ++m) _Pragma("unroll") for (int n = 0; n < 2; ++n) _Pragma("unroll") for (int k = 0; k < 2; ++k) \
        acc[ai][bj][m][n] = __builtin_amdgcn_mfma_f32_16x16x32_bf16(Bt[n][k], At[m][k], acc[ai][bj][m][n], 0, 0, 0); __builtin_amdgcn_s_setprio(0); } while (0)
#define PG8_WAIT_V(n) asm volatile("s_waitcnt vmcnt(" #n ")" ::: "memory")
#define PG8_WAIT_L(n) asm volatile("s_waitcnt lgkmcnt(" #n ")" ::: "memory")
#define PG8_BAR __builtin_amdgcn_s_barrier()
#define PG8_SCHED __builtin_amdgcn_sched_barrier(0)
    Unit cur, nxt; int ui = 0;
    if (!S.next(0, cur)) return;
    f32x4 acc[2][2][4][2];
#pragma unroll
    for (int a = 0; a < 2; ++a)
#pragma unroll
        for (int b = 0; b < 2; ++b)
#pragma unroll
            for (int m = 0; m < 4; ++m)
#pragma unroll
                for (int n = 0; n < 2; ++n) acc[a][b][m][n] = (f32x4){0.f, 0.f, 0.f, 0.f};
    bf16x8 At[4][2], B0[2][2], B1[2][2];
    const char* cA = (const char*)g.A + (size_t)cur.pm * tstep; const char* cB = (const char*)g.Bt + (size_t)cur.pn * tstep;
    S.a_ready(cur);
    if constexpr (SP2) {
        PG8_STAGE(PG8_SB(0, 0), cB, voffB); PG8_STAGE(PG8_SB(0, 1), cB + hstep, voffB); PG8_STAGE(PG8_SA(0, 0), cA, voffA); PG8_STAGE(PG8_SA(0, 1), cA + hstep, voffA);
        if (wr == 1) PG8_BAR;
        PG8_WAIT_V(2); PG8_BAR;
        PG8_STAGE(PG8_SB(1, 0), cB + kstep, voffB); PG8_STAGE(PG8_SA(1, 0), cA + kstep, voffA); PG8_STAGE(PG8_SB(1, 1), cB + hstep + kstep, voffB);
        PG8_WAIT_V(6); PG8_BAR;
    } else {
        PG8_STAGE(PG8_SB(0, 0), cB, voffB); PG8_STAGE(PG8_SA(0, 0), cA, voffA); PG8_STAGE(PG8_SB(0, 1), cB + hstep, voffB); PG8_STAGE(PG8_SA(0, 1), cA + hstep, voffA);
        if (wr == 1) PG8_BAR;
        PG8_WAIT_V(4); PG8_BAR;
        PG8_STAGE(PG8_SB(1, 0), cB + kstep, voffB); PG8_STAGE(PG8_SA(1, 0), cA + kstep, voffA); PG8_STAGE(PG8_SB(1, 1), cB + hstep + kstep, voffB);
        PG8_WAIT_V(6); PG8_BAR;
    }
    for (;;) {
        const bool has_next = S.next(ui + 1, nxt);
        const char* nA = has_next ? (const char*)g.A + (size_t)nxt.pm * tstep : cA; const char* nB = has_next ? (const char*)g.Bt + (size_t)nxt.pn * tstep : cB;
#pragma unroll 1
        for (int t = 0; t < nt; t += 2) {
            const bool last = (t == nt - 2);
            const char* a1 = cA + (size_t)(t + 1) * kstep;
            const char* a2 = last ? nA : cA + (size_t)(t + 2) * kstep; const char* b2 = last ? nB : cB + (size_t)(t + 2) * kstep;
            const char* a3 = a2 + kstep; const char* b3 = b2 + kstep;
            if (last && has_next) S.a_ready(nxt);
            if constexpr (SP2) {
            PG8_LDB(B0, 0, 0); PG8_LDB(B1, 0, 1); PG8_SCHED; PG8_LDA(At, 0, 0); PG8_STAGE(PG8_SA(1, 1), a1 + hstep, voffA);
            PG8_WAIT_V(8); PG8_WAIT_L(0); PG8_BAR; PG8_MMA(0, 0, At, B0); PG8_MMA(0, 1, At, B1); PG8_BAR; PG8_SCHED;
            PG8_LDA(At, 0, 1); PG8_STAGE(PG8_SB(0, 0), b2, voffB); PG8_STAGE(PG8_SB(0, 1), b2 + hstep, voffB); PG8_STAGE(PG8_SA(0, 0), a2, voffA);
            PG8_WAIT_V(8); PG8_WAIT_L(0); PG8_BAR; PG8_MMA(1, 0, At, B0); PG8_MMA(1, 1, At, B1); PG8_BAR; PG8_SCHED;
            PG8_LDB(B0, 1, 0); PG8_LDB(B1, 1, 1); PG8_SCHED; PG8_LDA(At, 1, 0); PG8_STAGE(PG8_SA(0, 1), a2 + hstep, voffA);
            PG8_WAIT_V(8); PG8_WAIT_L(0); PG8_BAR; PG8_MMA(0, 0, At, B0); PG8_MMA(0, 1, At, B1); PG8_BAR; PG8_SCHED;
            PG8_LDA(At, 1, 1); PG8_STAGE(PG8_SB(1, 0), b3, voffB); PG8_STAGE(PG8_SB(1, 1), b3 + hstep, voffB); PG8_STAGE(PG8_SA(1, 0), a3, voffA);
            PG8_WAIT_V(8); PG8_WAIT_L(0); PG8_BAR; PG8_MMA(1, 0, At, B0); PG8_MMA(1, 1, At, B1); PG8_BAR; PG8_SCHED;
            } else {
            PG8_LDB(B0, 0, 0); PG8_SCHED; PG8_LDA(At, 0, 0); PG8_STAGE(PG8_SA(1, 1), a1 + hstep, voffA);
            PG8_WAIT_L(8); PG8_BAR; PG8_WAIT_L(0); PG8_MMA(0, 0, At, B0); PG8_BAR; PG8_SCHED;
            PG8_LDB(B1, 0, 1); PG8_STAGE(PG8_SB(0, 0), b2, voffB);
            PG8_BAR; PG8_WAIT_L(0); PG8_MMA(0, 1, At, B1); PG8_BAR;
            PG8_LDA(At, 0, 1); PG8_STAGE(PG8_SA(0, 0), a2, voffA);
            PG8_BAR; PG8_WAIT_L(0); PG8_MMA(1, 0, At, B0); PG8_BAR; PG8_SCHED;
            PG8_STAGE(PG8_SB(0, 1), b2 + hstep, voffB);
            PG8_WAIT_V(6); PG8_BAR; PG8_MMA(1, 1, At, B1); PG8_BAR;
            PG8_LDB(B0, 1, 0); PG8_SCHED; PG8_LDA(At, 1, 0); PG8_STAGE(PG8_SA(0, 1), a2 + hstep, voffA);
            PG8_WAIT_L(8); PG8_BAR; PG8_WAIT_L(0); PG8_MMA(0, 0, At, B0); PG8_BAR; PG8_SCHED;
            PG8_LDB(B1, 1, 1); PG8_STAGE(PG8_SB(1, 0), b3, voffB);
            PG8_BAR; PG8_WAIT_L(0); PG8_MMA(0, 1, At, B1); PG8_BAR;
            PG8_LDA(At, 1, 1); PG8_STAGE(PG8_SA(1, 0), a3, voffA);
            PG8_BAR; PG8_WAIT_L(0); PG8_MMA(1, 0, At, B0); PG8_BAR; PG8_SCHED;
            PG8_STAGE(PG8_SB(1, 1), b3 + hstep, voffB);
            PG8_WAIT_V(6); PG8_BAR; PG8_MMA(1, 1, At, B1); PG8_BAR;
            }
        }
        if constexpr (ALIGN_EPI) { if (wr == 0) PG8_BAR; }
        if constexpr (!Epi::AFTER_DRAIN) { E(acc, cur, wr, wc, fr, fq); S.done(cur); }
        if (!has_next) break;
#pragma unroll
        for (int a = 0; a < 2; ++a)
#pragma unroll
            for (int b = 0; b < 2; ++b)
#pragma unroll
                for (int m = 0; m < 4; ++m)
#pragma unroll
                    for (int n = 0; n < 2; ++n) acc[a][b][m][n] = (f32x4){0.f, 0.f, 0.f, 0.f};
        cur = nxt; cA = nA; cB = nB; ++ui;
        if constexpr (ALIGN_EPI) { if (wr == 1) PG8_BAR; }
    }
    PG8_WAIT_V(0);
    if constexpr (!ALIGN_EPI) { if (wr == 0) PG8_BAR; }
    PG8_BAR;
    if constexpr (Epi::AFTER_DRAIN) { E.fused(acc, cur, wr, wc, fr, fq, lds, wid, lane); S.done(cur); }
#undef PG8_SA
#undef PG8_SB
#undef PG8_STAGE
#undef PG8_LDA
#undef PG8_LDB
#undef PG8_MMA
#undef PG8_WAIT_V
#undef PG8_WAIT_L
#undef PG8_BAR
#undef PG8_SCHED
}
}
#define GAS __attribute__((address_space(1)))
#define LAS __attribute__((address_space(3)))
typedef unsigned short bf16;
typedef unsigned v4u __attribute__((ext_vector_type(4)));
typedef float f32x4 __attribute__((ext_vector_type(4)));
typedef short bf16x8 __attribute__((ext_vector_type(8)));
typedef GAS unsigned gu32;
typedef GAS unsigned long long gu64;
#define RLX_AGENT __ATOMIC_RELAXED, __HIP_MEMORY_SCOPE_AGENT
#define LDS_WAIT() asm volatile("s_waitcnt lgkmcnt(0)" ::: "memory")
#define VM_WAIT() asm volatile("s_waitcnt vmcnt(0)" ::: "memory")
__device__ __forceinline__ unsigned long long rt() { return __builtin_amdgcn_s_memrealtime(); }
__device__ __forceinline__ unsigned f2bf(float f) { unsigned u = __builtin_bit_cast(unsigned, f); return (u + 0x7fffu + ((u >> 16) & 1u)) >> 16; }
__device__ __forceinline__ unsigned pk2(float lo, float hi) { return f2bf(lo) | (f2bf(hi) << 16); }

#define XB_TMO      128
#define XB_XCNT(j)  (256  + 64 * (j))
#define XB_XSUB(j)  (1280 + 64 * (j))
#define XB_XGEN(j)  (2304 + 64 * (j))
#define XB_TOP      3328
#define XB_TOPGEN   3392
#define XCD_BAR_WORDS 3456
#define XB_SPIN_CAP (1u << 22)

__device__ __forceinline__ unsigned xb_ld(unsigned* p)              { return __hip_atomic_load(p, __ATOMIC_RELAXED, __HIP_MEMORY_SCOPE_AGENT); }
__device__ __forceinline__ unsigned xb_add(unsigned* p, unsigned v) { return __hip_atomic_fetch_add(p, v, __ATOMIC_RELAXED, __HIP_MEMORY_SCOPE_AGENT); }
__device__ __forceinline__ unsigned xb_xcc_id() { return (unsigned)__builtin_amdgcn_s_getreg((3 << 11) | 20) & 0xFu; }
#define XB_SPIN(cond, bar) do { unsigned _sp = 0; while (cond) { __builtin_amdgcn_s_sleep(1); \
    if ((++_sp & 255u) == 0u) { if (xb_ld(&(bar)[XB_TMO])) break; if (_sp > XB_SPIN_CAP) { atomicAdd(&(bar)[XB_TMO], 1u); break; } } } } while (0)

struct XcdBarrier {
    unsigned* bar; unsigned x;
    volatile LAS unsigned* st;
};

__device__ __forceinline__ XcdBarrier xcd_barrier_post(unsigned* bar, volatile LAS unsigned* st) {
    XcdBarrier b; b.bar = bar; b.x = xb_xcc_id(); b.st = st;
    if (threadIdx.x == 0) (void)xb_add(&bar[XB_XCNT(b.x)], 1u);
    return b;
}
__device__ __forceinline__ void xcd_barrier_complete(unsigned* bar, unsigned x, unsigned& nloc, unsigned& nx) {
    const unsigned G = gridDim.x * gridDim.y * gridDim.z;
    unsigned sum, cnt, mine, sp = 0u;
    for (;;) {
        sum = 0u; cnt = 0u; mine = 0u;
#pragma unroll
        for (unsigned j = 0; j < 16; ++j) { const unsigned c = xb_ld(&bar[XB_XCNT(j)]); sum += c; cnt += (c > 0u) ? 1u : 0u; mine = (j == x) ? c : mine; }
        if (sum == G) break;
        __builtin_amdgcn_s_sleep(1);
        if ((++sp & 255u) == 0u) { if (xb_ld(&bar[XB_TMO])) break; if (sp > XB_SPIN_CAP) { atomicAdd(&bar[XB_TMO], 1u); break; } }
    }
    nloc = mine > 0u ? mine : 1u; nx = cnt > 0u ? cnt : 1u;
}

__device__ __forceinline__ void xcd_barrier(const XcdBarrier& b) {
    asm volatile("s_waitcnt vmcnt(0)" ::: "memory");
    __syncthreads();
    if (threadIdx.x == 0) {
        unsigned* bar = b.bar;
        __builtin_amdgcn_s_waitcnt(0);
        unsigned nloc = b.st[0], nx = b.st[1];
        if (nloc == 0u) { xcd_barrier_complete(bar, b.x, nloc, nx); b.st[0] = nloc; b.st[1] = nx; }
        const unsigned old = xb_add(&bar[XB_XSUB(b.x)], 1u);
        const unsigned gen = old / nloc;
        if (old + 1u == (gen + 1u) * nloc) {
            __builtin_amdgcn_fence(__ATOMIC_RELEASE, "agent");
            asm volatile("s_waitcnt vmcnt(0)" ::: "memory");
            const unsigned og = xb_add(&bar[XB_TOP], 1u);
            const unsigned tg = og / nx;
            if (og + 1u == (tg + 1u) * nx) xb_add(&bar[XB_TOPGEN], 1u);
            else XB_SPIN(xb_ld(&bar[XB_TOPGEN]) == tg, bar);
            __builtin_amdgcn_fence(__ATOMIC_ACQUIRE, "agent");
            xb_add(&bar[XB_XGEN(b.x)], 1u);
            asm volatile("s_waitcnt vmcnt(0)" ::: "memory");
        } else {
            XB_SPIN(xb_ld(&bar[XB_XGEN(b.x)]) == gen, bar);
            __builtin_amdgcn_fence(__ATOMIC_ACQUIRE, "agent");
            asm volatile("s_waitcnt vmcnt(0)" ::: "memory");
        }
    }
    __syncthreads();
}

#ifndef DUP_PHASE
#define DUP_PHASE -1
#endif
constexpr int NWAVES = 8;
constexpr int BATCH = 32, SEQ = 2048, D = 1024, M = BATCH * SEQ;
constexpr int IN_COLS = 4640, NZ = 4864;
constexpr int NEXP = 16384;
constexpr float NORM_EPS = 1e-5f, GN_EPS = 64e-5f, LOG2E = 1.4426950408889634f;
constexpr float QSCALE = 0.125f * LOG2E;
constexpr float U6_SCALE = 64.0f, V6_SCALE = 5.656854249f, H8_SCALE = 16.0f, A8_SCALE = 64.0f;
#ifndef U_FP4
#define U_FP4 1
#endif
#ifndef V_FP4
#define V_FP4 1
#endif
constexpr int U_ROW = U_FP4 ? 512 : 768, V_ROW = V_FP4 ? 512 : 768;

constexpr size_t MiB = 1u << 20;
constexpr size_t WS_CTL = 0, CTL_ZERO_BYTES = 64 * 1024;
constexpr size_t WS_ROPE = 1 * MiB;
constexpr size_t WS_SSQ = 1 * MiB + 512 * 1024;
constexpr size_t WS_WIN = 2 * MiB;
constexpr size_t WS_PA = 12 * MiB, WS_PB = 13 * MiB, WS_WOUT = 14 * MiB, WS_WQ = 16 * MiB, WS_LW = 18 * MiB;
constexpr size_t WS_SK = 19 * MiB + 512 * 1024;
constexpr size_t WS_U8 = 20 * MiB, WS_V8 = 36 * MiB;
constexpr size_t WS_XN = 84 * MiB;
constexpr size_t WS_LA = 84 * MiB;
constexpr size_t WS_YA = 132 * MiB;
constexpr size_t WS_IDX = 84 * MiB, WS_GATE = 116 * MiB;
constexpr size_t WS_QKV = 212 * MiB;
constexpr size_t WS_YB = 212 * MiB;
constexpr size_t WS_RKV = 308 * MiB;
constexpr size_t WS_HB = 308 * MiB;
constexpr size_t WS_LORA = 500 * MiB;
constexpr size_t WS_GA = 564 * MiB, WS_GB = 692 * MiB;
constexpr size_t WS_DAG = 820 * MiB;
constexpr size_t WS_QP = 820 * MiB;
constexpr size_t WS_END = 1012 * MiB;
constexpr int CW_BAR = 4096, CW_RND = 8192;

constexpr int RING_BYTES = 131072;
constexpr int LDSCTL_OFF = RING_BYTES, MISC_OFF = LDSCTL_OFF + 320;
constexpr int LDS_BYTES = 147456;

typedef float f32x2 __attribute__((ext_vector_type(2)));
typedef float f32x16 __attribute__((ext_vector_type(16)));
typedef unsigned u32x2 __attribute__((ext_vector_type(2)));
typedef __bf16 bf16x2_t __attribute__((ext_vector_type(2)));
typedef float v16f __attribute__((ext_vector_type(16)));
typedef float v32f __attribute__((ext_vector_type(32)));
typedef unsigned v6u __attribute__((ext_vector_type(6)));

__device__ __forceinline__ float bf2f(unsigned b) { return __builtin_bit_cast(float, b << 16); }
__device__ __forceinline__ float bf_lo(unsigned w) { return __builtin_bit_cast(float, w << 16); }
__device__ __forceinline__ float bf_hi(unsigned w) { return __builtin_bit_cast(float, w & 0xffff0000u); }
template <int CTRL> __device__ __forceinline__ float dppf(float x) { return __builtin_bit_cast(float, __builtin_amdgcn_update_dpp(0, __builtin_bit_cast(int, x), CTRL, 0xF, 0xF, true)); }
__device__ __forceinline__ float allreduce16(float x) { x += dppf<0xB1>(x); x += dppf<0x4E>(x); x += dppf<0x141>(x); x += dppf<0x140>(x); return x; }
__device__ __forceinline__ float wave_sum(float v) {
#pragma unroll
    for (int o = 1; o < 64; o <<= 1) v += __shfl_xor(v, o);
    return v;
}
__device__ __forceinline__ bf16x2_t as_bf2(unsigned w) { return __builtin_bit_cast(bf16x2_t, w); }
__device__ __forceinline__ float u2f(unsigned w) { return __builtin_bit_cast(float, w); }
__device__ __forceinline__ unsigned f2u(float f) { return __builtin_bit_cast(unsigned, f); }
__device__ __forceinline__ float wave_allreduce(float x) {
    x = allreduce16(x);
    { const auto r = __builtin_amdgcn_permlane16_swap(f2u(x), f2u(x), false, false); const unsigned a = r[0], b = r[1]; x = u2f(a) + u2f(b); }
    { const auto r = __builtin_amdgcn_permlane32_swap(f2u(x), f2u(x), false, false); const unsigned a = r[0], b = r[1]; x = u2f(a) + u2f(b); }
    return x;
}
__device__ __forceinline__ float gelu_erf(float v) {
    const float av = __builtin_fabsf(v), t = __builtin_amdgcn_rcpf(av * 0.2316418882f + 1.0f);
    float q = t * 0.5307027145f + (-0.7265760135f); q = q * t + 0.7107068705f; q = q * t + (-0.142248368f); q = q * t + 0.127414796f; q = q * t;
    const float e = __builtin_amdgcn_exp2f((v * v) * (-0.72134752044f));
    const float m = v * (q * e);
    return v < 0.f ? m : v - m;
}

__device__ __forceinline__ float sfma(float a, float b, float c) { float d; asm("v_fma_f32 %0, %1, %2, %3" : "=v"(d) : "v"(a), "v"(b), "v"(c)); return d; }
__device__ __forceinline__ float smul(float a, float b) { float d; asm("v_mul_f32 %0, %1, %2" : "=v"(d) : "v"(a), "v"(b)); return d; }
__device__ __forceinline__ v6u pack_fp6(const v16f x, const v16f y) { v6u p = __builtin_amdgcn_cvt_scalef32_2xpk16_fp6_f32(x, y, 1.0f); asm volatile("" : "+v"(p) : "v"(x), "v"(y)); return p; }
__device__ __forceinline__ v32f unpack_fp6(const v6u p) { const v32f f = __builtin_amdgcn_cvt_scalef32_pk32_f32_fp6(p, 1.0f); asm volatile("" :: "v"(p)); return f; }
struct Frame {
    LAS unsigned char* lds;
    volatile LAS unsigned* MISC;
    gu32* ctl;
    int tid, lane, wave, vcu, G, rnd_nloc, rnd_x;
    const float* in[24]; float* out;
    float *ROPE, *SSQ;
    bf16 *WIN, *PA, *PB, *WOUT, *WQ, *LW, *SK, *XN, *LA, *YA, *QKV, *YB, *RKV, *HB, *LORA, *GA, *GB, *DAG, *QP;
    int* IDX; float* GATE; unsigned char *U8, *V8;
};
enum { I_X = 0, I_NMW, I_WIN, I_MU, I_SINK, I_W0, I_W2, I_A0, I_A2, I_G2, I_KK, I_KA, I_RK, I_LNW, I_LNB, I_PA, I_PB, I_WOUT, I_NFW, I_WQ, I_SUBK, I_U, I_V, I_NFINAL };

struct SrcWin { const float* w; __device__ __forceinline__ float operator()(int k, int n) const {
    int src;
    if (n < 640) { const int hd = n >> 6, j = n & 63; src = hd * 64 + ((j & 1) ? 32 + (j >> 1) : (j >> 1)); }
    else if (n < 2592) src = n;
    else if (n < 2816) return 0.f;
    else src = n - 224;
    return w[(size_t)k * IN_COLS + src]; } };
struct SrcPlain { const float* w; int N; __device__ __forceinline__ float operator()(int k, int n) const { return w[(size_t)k * N + n]; } };
struct SrcWq { const float* w; const float* s; __device__ __forceinline__ float operator()(int k, int n) const { return w[(size_t)k * 1024 + n] * s[k]; } };
struct SrcLora { const float *w2, *a2, *g2; __device__ __forceinline__ float operator()(int k, int n) const {
    if (n < 512) return k < 64 ? w2[k * 512 + n] : 0.f;
    if (n < 1024) return (k >= 64 && k < 128) ? a2[(k - 64) * 512 + (n - 512)] : 0.f;
    return (k >= 128 && k < 288) ? g2[(k - 128) * 512 + (n - 1024)] : 0.f; } };
template <int N, int K, class F_> __device__ __forceinline__ void transpose_w(bf16* dst, const F_& f, int gtid, int nthr) {
    for (int id = gtid; id < N * (K / 8); id += nthr) {
        const int n = id % N, k0 = (id / N) * 8;
        float v[8];
#pragma unroll
        for (int j = 0; j < 8; ++j) v[j] = f(k0 + j, n);
        v4u o; o.x = pk2(v[0], v[1]); o.y = pk2(v[2], v[3]); o.z = pk2(v[4], v[5]); o.w = pk2(v[6], v[7]);
        *(v4u*)(dst + (size_t)n * K + k0) = o;
    }
}
__device__ __forceinline__ void p0_prologue(Frame& F) {
    const int gtid = F.vcu * (NWAVES * 64) + F.tid, nthr = F.G * NWAVES * 64;
    const int gw = F.vcu * NWAVES + F.wave, NGW = F.G * NWAVES;
    transpose_w<NZ, 1024>(F.WIN, SrcWin{F.in[I_WIN]}, gtid, nthr);
    transpose_w<1024, 512>(F.PA, SrcPlain{F.in[I_PA], 1024}, gtid, nthr);
    transpose_w<1024, 512>(F.PB, SrcPlain{F.in[I_PB], 1024}, gtid, nthr);
    transpose_w<1024, 1024>(F.WOUT, SrcPlain{F.in[I_WOUT], 1024}, gtid, nthr);
    transpose_w<1024, 1024>(F.WQ, SrcWq{F.in[I_WQ], F.in[I_NFW]}, gtid, nthr);
    transpose_w<1536, 384>(F.LW, SrcLora{F.in[I_W2], F.in[I_A2], F.in[I_G2]}, gtid, nthr);
    for (int id = gtid; id < 16 * 128 * 64 / 8; id += nthr) {
        const f32x4 a = *(const f32x4*)(F.in[I_SUBK] + (size_t)id * 8), b = *(const f32x4*)(F.in[I_SUBK] + (size_t)id * 8 + 4);
        v4u o; o.x = pk2(a[0], a[1]); o.y = pk2(a[2], a[3]); o.z = pk2(b[0], b[1]); o.w = pk2(b[2], b[3]);
        *(v4u*)(F.SK + (size_t)id * 8) = o;
    }
    for (int id = gtid; id < NEXP * 32; id += nthr) {
        const int e = id >> 5, c = (id >> 1) & 15, g = id & 1;
        const size_t eb = (size_t)e * 1024 + c * 64 + g * 32;
        const float* wn = F.in[I_NFW] + c * 64 + g * 32;
        v16f ux, uy, vx_, vy_;
#pragma unroll
        for (int j = 0; j < 8; ++j) {
            const f32x4 a0 = *(const f32x4*)(F.in[I_U] + eb + 4 * j) * *(const f32x4*)(wn + 4 * j) * U6_SCALE;
            const f32x4 b0 = *(const f32x4*)(F.in[I_V] + eb + 4 * j) * V6_SCALE;
            ux[2 * j] = a0[0]; uy[2 * j] = a0[1]; ux[2 * j + 1] = a0[2]; uy[2 * j + 1] = a0[3];
            vx_[2 * j] = b0[0]; vy_[2 * j] = b0[1]; vx_[2 * j + 1] = b0[2]; vy_[2 * j + 1] = b0[3];
        }
        const int G = 2 * c + g;
#if U_FP4
        {
            v4u pk;
            { unsigned w = 0; w = __builtin_amdgcn_cvt_scalef32_pk_fp4_f32(w, ux[0], uy[0], 1.0f, 0); w = __builtin_amdgcn_cvt_scalef32_pk_fp4_f32(w, ux[1], uy[1], 1.0f, 1); w = __builtin_amdgcn_cvt_scalef32_pk_fp4_f32(w, ux[2], uy[2], 1.0f, 2); w = __builtin_amdgcn_cvt_scalef32_pk_fp4_f32(w, ux[3], uy[3], 1.0f, 3); pk.x = w; }
            { unsigned w = 0; w = __builtin_amdgcn_cvt_scalef32_pk_fp4_f32(w, ux[4], uy[4], 1.0f, 0); w = __builtin_amdgcn_cvt_scalef32_pk_fp4_f32(w, ux[5], uy[5], 1.0f, 1); w = __builtin_amdgcn_cvt_scalef32_pk_fp4_f32(w, ux[6], uy[6], 1.0f, 2); w = __builtin_amdgcn_cvt_scalef32_pk_fp4_f32(w, ux[7], uy[7], 1.0f, 3); pk.y = w; }
            { unsigned w = 0; w = __builtin_amdgcn_cvt_scalef32_pk_fp4_f32(w, ux[8], uy[8], 1.0f, 0); w = __builtin_amdgcn_cvt_scalef32_pk_fp4_f32(w, ux[9], uy[9], 1.0f, 1); w = __builtin_amdgcn_cvt_scalef32_pk_fp4_f32(w, ux[10], uy[10], 1.0f, 2); w = __builtin_amdgcn_cvt_scalef32_pk_fp4_f32(w, ux[11], uy[11], 1.0f, 3); pk.z = w; }
            { unsigned w = 0; w = __builtin_amdgcn_cvt_scalef32_pk_fp4_f32(w, ux[12], uy[12], 1.0f, 0); w = __builtin_amdgcn_cvt_scalef32_pk_fp4_f32(w, ux[13], uy[13], 1.0f, 1); w = __builtin_amdgcn_cvt_scalef32_pk_fp4_f32(w, ux[14], uy[14], 1.0f, 2); w = __builtin_amdgcn_cvt_scalef32_pk_fp4_f32(w, ux[15], uy[15], 1.0f, 3); pk.w = w; }
            *(v4u*)(F.U8 + (size_t)e * U_ROW + 16 * G) = pk;
        }
#else
        {
            const v6u pu = pack_fp6(ux, uy);
            unsigned char* ur = F.U8 + (size_t)e * U_ROW;
            *(v4u*)(ur + 16 * G) = (v4u){pu[0], pu[1], pu[2], pu[3]}; *(u32x2*)(ur + 512 + 8 * G) = (u32x2){pu[4], pu[5]};
        }
#endif
#if V_FP4
        {
            v4u pk;
            { unsigned w = 0; w = __builtin_amdgcn_cvt_scalef32_pk_fp4_f32(w, vx_[0], vy_[0], 1.0f, 0); w = __builtin_amdgcn_cvt_scalef32_pk_fp4_f32(w, vx_[1], vy_[1], 1.0f, 1); w = __builtin_amdgcn_cvt_scalef32_pk_fp4_f32(w, vx_[2], vy_[2], 1.0f, 2); w = __builtin_amdgcn_cvt_scalef32_pk_fp4_f32(w, vx_[3], vy_[3], 1.0f, 3); pk.x = w; }
            { unsigned w = 0; w = __builtin_amdgcn_cvt_scalef32_pk_fp4_f32(w, vx_[4], vy_[4], 1.0f, 0); w = __builtin_amdgcn_cvt_scalef32_pk_fp4_f32(w, vx_[5], vy_[5], 1.0f, 1); w = __builtin_amdgcn_cvt_scalef32_pk_fp4_f32(w, vx_[6], vy_[6], 1.0f, 2); w = __builtin_amdgcn_cvt_scalef32_pk_fp4_f32(w, vx_[7], vy_[7], 1.0f, 3); pk.y = w; }
            { unsigned w = 0; w = __builtin_amdgcn_cvt_scalef32_pk_fp4_f32(w, vx_[8], vy_[8], 1.0f, 0); w = __builtin_amdgcn_cvt_scalef32_pk_fp4_f32(w, vx_[9], vy_[9], 1.0f, 1); w = __builtin_amdgcn_cvt_scalef32_pk_fp4_f32(w, vx_[10], vy_[10], 1.0f, 2); w = __builtin_amdgcn_cvt_scalef32_pk_fp4_f32(w, vx_[11], vy_[11], 1.0f, 3); pk.z = w; }
            { unsigned w = 0; w = __builtin_amdgcn_cvt_scalef32_pk_fp4_f32(w, vx_[12], vy_[12], 1.0f, 0); w = __builtin_amdgcn_cvt_scalef32_pk_fp4_f32(w, vx_[13], vy_[13], 1.0f, 1); w = __builtin_amdgcn_cvt_scalef32_pk_fp4_f32(w, vx_[14], vy_[14], 1.0f, 2); w = __builtin_amdgcn_cvt_scalef32_pk_fp4_f32(w, vx_[15], vy_[15], 1.0f, 3); pk.w = w; }
            *(v4u*)(F.V8 + (size_t)e * V_ROW + 16 * G) = pk;
        }
#else
        {
            const v6u pv = pack_fp6(vx_, vy_);
            const int hf_ = G >> 4, i_ = G & 15;
            unsigned char* vb = F.V8 + (size_t)e * V_ROW + 384 * hf_;
            *(v4u*)(vb + 16 * i_) = (v4u){pv[0], pv[1], pv[2], pv[3]}; *(u32x2*)(vb + 256 + 8 * i_) = (u32x2){pv[4], pv[5]};
        }
#endif
    }
    for (int id = gtid; id < SEQ * 32; id += nthr) {
        const int t = id >> 5, i = id & 31;
        const double inv = exp2(-(double)i * (13.287712379549449 / 32.0));
        double rev = (double)t * inv * 0.15915494309189535; rev -= floor(rev);
        F.ROPE[2 * id] = __builtin_amdgcn_cosf((float)rev); F.ROPE[2 * id + 1] = __builtin_amdgcn_sinf((float)rev);
    }
    for (int id = gtid; id < M; id += nthr) F.SSQ[id] = 0.f;
    const GAS f32x4* wv = (const GAS f32x4*)F.in[I_NMW] + F.lane;
    f32x4 nw[4];
#pragma unroll
    for (int j = 0; j < 4; ++j) nw[j] = wv[64 * j];
    for (int m = gw; m < M; m += NGW) {
        const GAS f32x4* xr = (const GAS f32x4*)(F.in[I_X] + (size_t)m * D) + F.lane;
        f32x4 v[4]; float s = 0.f;
#pragma unroll
        for (int j = 0; j < 4; ++j) { v[j] = xr[64 * j]; s += (v[j].x * v[j].x + v[j].y * v[j].y) + (v[j].z * v[j].z + v[j].w * v[j].w); }
        const float rstd = 1.0f / sqrtf(wave_sum(s) * (1.f / D) + NORM_EPS);
        GAS unsigned long long* o8 = (GAS unsigned long long*)(F.XN + (size_t)m * D) + F.lane;
#pragma unroll
        for (int j = 0; j < 4; ++j) { const f32x4 y = v[j] * rstd * nw[j]; o8[64 * j] = (unsigned long long)pk2(y.x, y.y) | ((unsigned long long)pk2(y.z, y.w) << 32); }
    }
}

__device__ __forceinline__ void attn_phase(Frame& F) {
    LAS bf16* Ks = (LAS bf16*)F.lds;
    LAS bf16* Vt = (LAS bf16*)(F.lds + 256 * 144);
    const int lane = F.lane, wave = F.wave, r32 = lane & 31, hh = lane >> 5;
    for (int unit = F.vcu; unit < BATCH * 2 * 16; unit += F.G) {
        const int b = unit >> 5, kvh = (unit >> 4) & 1, qb = unit & 15;
        const size_t rowbase = (size_t)b * SEQ + qb * 128;
#pragma unroll
        for (int i = 0; i < 4; ++i) {
            const int c = F.tid + 512 * i, key = c >> 3, piece = c & 7;
            v4u kv = (v4u){0u, 0u, 0u, 0u}, vv = kv;
            if (qb > 0 || key >= 128) { const bf16* src = F.QKV + (rowbase + key - 128) * 768 + kvh * 64 + piece * 8; kv = *(const v4u*)(src + 512); vv = *(const v4u*)(src + 640); }
            *(LAS v4u*)(Ks + key * 72 + piece * 8) = kv;
            LAS bf16* vd = Vt + (piece * 8) * 260 + key;
            vd[0 * 260] = (bf16)(vv.x & 0xffffu); vd[1 * 260] = (bf16)(vv.x >> 16); vd[2 * 260] = (bf16)(vv.y & 0xffffu); vd[3 * 260] = (bf16)(vv.y >> 16);
            vd[4 * 260] = (bf16)(vv.z & 0xffffu); vd[5 * 260] = (bf16)(vv.z >> 16); vd[6 * 260] = (bf16)(vv.w & 0xffffu); vd[7 * 260] = (bf16)(vv.w >> 16);
        }
        __syncthreads();
        const int head = kvh * 4 + (wave >> 1);
        const float sink2 = F.in[I_SINK][head] * LOG2E;
#pragma unroll 1
        for (int qq = 0; qq < 2; ++qq) {
            const int qg = (wave & 1) * 64 + qq * 32, qi = qg + r32;
            const bf16* qp = F.QKV + (rowbase + qi) * 768 + head * 64 + 8 * hh;
            bf16x8 bq[4];
#pragma unroll
            for (int s = 0; s < 4; ++s) bq[s] = *(const bf16x8*)(qp + 16 * s);
            const int kt0 = qg >> 5;
            f32x16 sc[5];
#pragma unroll
            for (int i = 0; i < 5; ++i) {
                f32x16 a_ = {};
#pragma unroll
                for (int s = 0; s < 4; ++s) { const bf16x8 ka = *(const LAS bf16x8*)(Ks + ((kt0 + i) * 32 + r32) * 72 + 16 * s + 8 * hh); a_ = __builtin_amdgcn_mfma_f32_32x32x16_bf16(ka, bq[s], a_, 0, 0, 0); }
                sc[i] = a_;
            }
            float mx = sink2;
#pragma unroll
            for (int i = 0; i < 5; ++i)
#pragma unroll
                for (int r = 0; r < 16; ++r) {
                    const int kj = (kt0 + i) * 32 + (r & 3) + 8 * (r >> 2) + 4 * hh, dk = kj - qi;
                    const bool ok = (dk >= 1) && (dk <= 128) && (qb > 0 || kj >= 128);
                    const float s = ok ? sc[i][r] : -1e30f; sc[i][r] = s; mx = fmaxf(mx, s);
                }
            mx = fmaxf(mx, __shfl_xor(mx, 32));
            float sum = 0.f;
#pragma unroll
            for (int i = 0; i < 5; ++i)
#pragma unroll
                for (int r = 0; r < 16; ++r) { const float p = __builtin_amdgcn_exp2f(sc[i][r] - mx); sc[i][r] = p; sum += p; }
            sum += __shfl_xor(sum, 32); sum += __builtin_amdgcn_exp2f(sink2 - mx);
            const float inv = 1.0f / sum;
            f32x16 o0 = {}, o1 = {};
#pragma unroll
            for (int i = 0; i < 5; ++i)
#pragma unroll
                for (int s2 = 0; s2 < 2; ++s2) {
                    v4u pw;
                    pw.x = pk2(sc[i][8 * s2 + 0] * inv, sc[i][8 * s2 + 1] * inv); pw.y = pk2(sc[i][8 * s2 + 2] * inv, sc[i][8 * s2 + 3] * inv);
                    pw.z = pk2(sc[i][8 * s2 + 4] * inv, sc[i][8 * s2 + 5] * inv); pw.w = pk2(sc[i][8 * s2 + 6] * inv, sc[i][8 * s2 + 7] * inv);
                    const bf16x8 pa = __builtin_bit_cast(bf16x8, pw);
                    const int kb = (kt0 + i) * 32 + 16 * s2 + 4 * hh;
                    const u32x2 l0 = *(const LAS u32x2*)(Vt + r32 * 260 + kb), h0 = *(const LAS u32x2*)(Vt + r32 * 260 + kb + 8);
                    const u32x2 l1 = *(const LAS u32x2*)(Vt + (32 + r32) * 260 + kb), h1 = *(const LAS u32x2*)(Vt + (32 + r32) * 260 + kb + 8);
                    const bf16x8 b0 = __builtin_bit_cast(bf16x8, (v4u){l0.x, l0.y, h0.x, h0.y}), b1 = __builtin_bit_cast(bf16x8, (v4u){l1.x, l1.y, h1.x, h1.y});
                    o0 = __builtin_amdgcn_mfma_f32_32x32x16_bf16(pa, b0, o0, 0, 0, 0);
                    o1 = __builtin_amdgcn_mfma_f32_32x32x16_bf16(pa, b1, o1, 0, 0, 0);
                }
#pragma unroll
            for (int r = 0; r < 16; ++r) {
                const int qrow = (r & 3) + 8 * (r >> 2) + 4 * hh;
                bf16* op = F.YA + (rowbase + qg + qrow) * 512 + head * 64 + r32;
                op[0] = (bf16)f2bf(o0[r]); op[32] = (bf16)f2bf(o1[r]);
            }
        }
        __syncthreads();
    }
}

__device__ __forceinline__ void lora_prep_phase(Frame& F) {
    const int gtid = F.vcu * (NWAVES * 64) + F.tid, nthr = F.G * NWAVES * 64;
    for (int id = gtid; id < M * 48; id += nthr) {
        const int row = id / 48, ch = id % 48, c0 = ch * 8;
        v4u o = (v4u){0u, 0u, 0u, 0u};
        if (c0 < 288) {
            const v4u zc = *(const v4u*)(F.LORA + (size_t)row * 512 + c0);
            v4u zp = (v4u){0u, 0u, 0u, 0u};
            if ((row & (SEQ - 1)) != 0) zp = *(const v4u*)(F.LORA + (size_t)(row - 1) * 512 + c0);
            const float* mu = F.in[I_MU] + 1536 + c0;
            const unsigned zcw[4] = {zc.x, zc.y, zc.z, zc.w}, zpw[4] = {zp.x, zp.y, zp.z, zp.w};
            float v[8];
#pragma unroll
            for (int j = 0; j < 8; ++j) {
                const float zc_ = (j & 1) ? bf_hi(zcw[j >> 1]) : bf_lo(zcw[j >> 1]), zp_ = (j & 1) ? bf_hi(zpw[j >> 1]) : bf_lo(zpw[j >> 1]);
                const float z = zc_ + mu[j] * (zp_ - zc_);
                float f;
                if (c0 < 64) f = 1.0f - 2.0f * __builtin_amdgcn_rcpf(__builtin_amdgcn_exp2f(2.0f * LOG2E * z) + 1.0f);
                else if (c0 < 128) f = z;
                else f = __builtin_amdgcn_rcpf(1.0f + __builtin_amdgcn_exp2f(-LOG2E * z));
                v[j] = f;
            }
            o.x = pk2(v[0], v[1]); o.y = pk2(v[2], v[3]); o.z = pk2(v[4], v[5]); o.w = pk2(v[6], v[7]);
        }
        *(v4u*)(F.LA + (size_t)row * 384 + c0) = o;
    }
}

namespace ck {
constexpr int RS = 136, TS = 40, AS = 40;
constexpr int VB_KT = 0, VB_RT = 16 * RS, VB_KS = 2 * 16 * RS, VB_BS = 3 * 16 * RS, VB_KK = 4 * 16 * RS, VB_BT = VB_KK + 64 * TS, VB_VT = VB_BT + 64 * TS,
              VB_DC = VB_VT + 64 * TS, VB_SIZE = ((VB_DC + 256 + 127) / 128) * 128;
constexpr int VR_V32 = 0, VR_BON = 4096, VR_G = 4096 + 128, VR_SIZE = 4096 + 128 + 2048;
constexpr int RAW_RKV = 0, RAW_DAG = 16 * 384, RAW_SIZE = 2 * 16 * 384;
constexpr int AB_A2 = 0, AB_A3 = 16 * AS, AB_A4 = 2 * 16 * AS, AB_T = 3 * 16 * AS, AB_A1 = 4 * 16 * AS, AB_SIZE = AB_A1 + 1024;
constexpr int OFF_VB = 0, OFF_AB = 3 * VB_SIZE, OFF_Y = OFF_AB + 2 * AB_SIZE, OFF_VR = OFF_Y + 2 * 4096, OFF_RAW = OFF_VR + 4 * VR_SIZE, LDS_TOTAL = OFF_RAW + 3 * RAW_SIZE;
static_assert(LDS_TOTAL <= 131072 && (OFF_RAW % 16) == 0 && (VB_KK % 8) == 0 && (OFF_VR % 16) == 0 && (VB_DC % 16) == 0 && (AB_SIZE % 16) == 0 && (OFF_AB % 16) == 0, "chunked scan LDS map");
}
__device__ __forceinline__ unsigned cvtpk(float lo, float hi) { typedef float f2_ __attribute__((ext_vector_type(2))); typedef __bf16 b2_ __attribute__((ext_vector_type(2))); const f2_ v = {lo, hi}; const b2_ b = __builtin_convertvector(v, b2_); return __builtin_bit_cast(unsigned, b); }
#define SCAN_BAR() do { asm volatile("s_waitcnt lgkmcnt(0)" ::: "memory"); __builtin_amdgcn_s_barrier(); asm volatile("" ::: "memory"); } while (0)
__device__ __forceinline__ void scan_phase(Frame& F) {
    using namespace ck;
    LAS unsigned char* L = F.lds;
    constexpr int NCH = SEQ / 16;
    const int tid = F.tid, lane = F.lane, wave = F.wave;
    const bool helper = wave >= 4;
    const int r16 = lane & 15, g = lane >> 4;
    const int htid = tid & 255, tt = htid >> 4, d4 = (htid & 15) * 4;
    for (int unit = F.vcu; unit < BATCH * 8; unit += F.G) {
        const int b = unit >> 3, h = unit & 7, hc = h * 64 + d4;
        u32x2 rq[6];
#define UP4(W_) ((f32x4){bf_lo((W_).x), bf_hi((W_).x), bf_lo((W_).y), bf_hi((W_).y)})
#define H_ISSUE(c) do { const size_t tk_ = ((size_t)(b * 8 + h) * SEQ + (size_t)(c) * 16 + tt) * 192 + d4; const bf16* rp_ = F.RKV + tk_; const bf16* dp_ = F.DAG + tk_; \
            rq[0] = *(const u32x2*)(rp_); rq[1] = *(const u32x2*)(rp_ + 64); rq[2] = *(const u32x2*)(rp_ + 128); rq[3] = *(const u32x2*)(dp_); rq[4] = *(const u32x2*)(dp_ + 64); rq[5] = *(const u32x2*)(dp_ + 128); } while (0)
#define H_LAND(c) do { LAS unsigned char* rw_ = L + OFF_RAW + (int)((unsigned)(c) % 3u) * RAW_SIZE + tt * 384 + d4 * 2; \
            *(LAS u32x2*)(rw_ + RAW_RKV) = rq[0]; *(LAS u32x2*)(rw_ + RAW_RKV + 128) = rq[1]; *(LAS u32x2*)(rw_ + RAW_RKV + 256) = rq[2]; \
            *(LAS u32x2*)(rw_ + RAW_DAG) = rq[3]; *(LAS u32x2*)(rw_ + RAW_DAG + 128) = rq[4]; *(LAS u32x2*)(rw_ + RAW_DAG + 256) = rq[5]; } while (0)
#define PK4(V_) ((u32x2){cvtpk((V_).x, (V_).y), cvtpk((V_).z, (V_).w)})
#define H_PREP(c) do { int tt_ = tt, d4_ = d4; asm volatile("" : "+v"(tt_), "+v"(d4_));   \
            LAS unsigned char* vb_ = L + OFF_VB + (int)((unsigned)(c) % 3u) * VB_SIZE; LAS unsigned char* vr_ = L + OFF_VR + ((c) & 3) * VR_SIZE; \
            float lt[4] = {0.f, 0.f, 0.f, 0.f};        \
            const LAS unsigned char* raw_ = L + OFF_RAW + (int)((unsigned)(c) % 3u) * RAW_SIZE + d4_ * 2; \
            _Pragma("unroll") for (int s_ = 0; s_ < 16; ++s_) { const u32x2 xw_ = *(const LAS u32x2*)(raw_ + RAW_DAG + s_ * 384); const f32x4 x_ = UP4(xw_); const float m_ = (s_ <= tt_) ? 1.0f : 0.0f; \
                _Pragma("unroll") for (int i_ = 0; i_ < 4; ++i_) lt[i_] += m_ * x_[i_]; } \
            const LAS unsigned char* own_ = raw_ + tt_ * 384; \
            const u32x2 zr = *(const LAS u32x2*)(own_ + RAW_RKV), zk = *(const LAS u32x2*)(own_ + RAW_RKV + 128), zv = *(const LAS u32x2*)(own_ + RAW_RKV + 256); \
            const u32x2 ew = *(const LAS u32x2*)(own_ + RAW_DAG), aa = *(const LAS u32x2*)(own_ + RAW_DAG + 128), gw_ = *(const LAS u32x2*)(own_ + RAW_DAG + 256); \
              \
            const LAS unsigned char* prv_ = (tt_ > 0) ? (own_ - 384) : (L + OFF_RAW + (int)((unsigned)((c) + 2) % 3u) * RAW_SIZE + d4_ * 2 + 15 * 384); \
            u32x2 pr = *(const LAS u32x2*)(prv_ + RAW_RKV), pk = *(const LAS u32x2*)(prv_ + RAW_RKV + 128), pv = *(const LAS u32x2*)(prv_ + RAW_RKV + 256); \
            if ((c) == 0 && tt_ == 0) { pr = (u32x2){0u, 0u}; pk = pr; pv = pr; } \
            const f32x4 r0_ = UP4(zr), k0_ = UP4(zk), v0_ = UP4(zv); \
            const f32x4 r_ = r0_ + c_mur * (UP4(pr) - r0_), k_ = k0_ + c_muk * (UP4(pk) - k0_), v_ = v0_ + c_muv * (UP4(pv) - v0_); \
            const f32x4 a_ = UP4(aa), e_ = UP4(ew); \
            f32x4 kk_ = k_ * c_kk; const float n2_ = allreduce16((kk_.x * kk_.x + kk_.y * kk_.y) + (kk_.z * kk_.z + kk_.w * kk_.w)); \
            kk_ = kk_ * (1.0f / fmaxf(sqrtf(n2_), 1e-12f)); \
            const f32x4 kp_ = k_ * (1.0f + (a_ - 1.0f) * c_ka); \
            const f32x4 rk_ = r_ * kp_ * c_rk; const float bon_ = allreduce16((rk_.x + rk_.y) + (rk_.z + rk_.w)); \
            f32x4 dt_, dtm_, idt_;   \
            _Pragma("unroll") for (int i_ = 0; i_ < 4; ++i_) { dt_[i_] = __builtin_amdgcn_exp2f(-LOG2E * lt[i_]); dtm_[i_] = __builtin_amdgcn_exp2f(-LOG2E * (lt[i_] - e_[i_])); idt_[i_] = __builtin_amdgcn_exp2f(LOG2E * lt[i_]); } \
            const f32x4 kt_ = kk_ * dtm_, rt_ = r_ * dt_, ks_ = kp_ * idt_, bs_ = kk_ * a_ * idt_; \
            *(LAS u32x2*)(vb_ + VB_KT + tt_ * RS + d4_ * 2) = PK4(kt_); *(LAS u32x2*)(vb_ + VB_RT + tt_ * RS + d4_ * 2) = PK4(rt_); \
            *(LAS u32x2*)(vb_ + VB_KS + tt_ * RS + d4_ * 2) = PK4(ks_); *(LAS u32x2*)(vb_ + VB_BS + tt_ * RS + d4_ * 2) = PK4(bs_); \
            { const u32x2 ksp_ = PK4(ks_), vp_ = PK4(v_); const f32x4 nb_ = -bs_; const u32x2 bsp_ = PK4(nb_); \
              LAS unsigned char* t0_ = vb_ + d4_ * TS + tt_ * 2; \
              *(LAS bf16*)(t0_ + VB_KK) = (bf16)(ksp_.x & 0xffffu); *(LAS bf16*)(t0_ + VB_KK + TS) = (bf16)(ksp_.x >> 16); *(LAS bf16*)(t0_ + VB_KK + 2 * TS) = (bf16)(ksp_.y & 0xffffu); *(LAS bf16*)(t0_ + VB_KK + 3 * TS) = (bf16)(ksp_.y >> 16); \
              *(LAS bf16*)(t0_ + VB_BT) = (bf16)(bsp_.x & 0xffffu); *(LAS bf16*)(t0_ + VB_BT + TS) = (bf16)(bsp_.x >> 16); *(LAS bf16*)(t0_ + VB_BT + 2 * TS) = (bf16)(bsp_.y & 0xffffu); *(LAS bf16*)(t0_ + VB_BT + 3 * TS) = (bf16)(bsp_.y >> 16); \
              *(LAS bf16*)(t0_ + VB_VT) = (bf16)(vp_.x & 0xffffu); *(LAS bf16*)(t0_ + VB_VT + TS) = (bf16)(vp_.x >> 16); *(LAS bf16*)(t0_ + VB_VT + 2 * TS) = (bf16)(vp_.y & 0xffffu); *(LAS bf16*)(t0_ + VB_VT + 3 * TS) = (bf16)(vp_.y >> 16); } \
            *(LAS f32x4*)(vr_ + VR_V32 + tt_ * 256 + d4_ * 4) = v_; \
            if ((d4_ == 0)) *(LAS float*)(vr_ + VR_BON + tt_ * 4) = bon_; \
            *(LAS u32x2*)(vr_ + VR_G + tt_ * 128 + d4_ * 2) = gw_; \
            if (tt_ == 15) *(LAS f32x4*)(vb_ + VB_DC + d4_ * 4) = dt_; } while (0)
#define H_PROD(c) do { int r_ = r16, g_ = g; asm volatile("" : "+v"(r_), "+v"(g_)); \
            LAS unsigned char* vb_ = L + OFF_VB + (int)((unsigned)(c) % 3u) * VB_SIZE; LAS unsigned char* ab_ = L + OFF_AB + ((c) & 1) * AB_SIZE; const int hw_ = wave - 4;        \
            const LAS unsigned char* X_ = vb_ + ((hw_ & 1) ? VB_KS : VB_BS) + r_ * RS + g_ * 16; const LAS unsigned char* Y_ = vb_ + ((hw_ & 2) ? VB_RT : VB_KT) + r_ * RS + g_ * 16; \
            f32x4 p_ = (f32x4){0.f, 0.f, 0.f, 0.f}; \
            p_ = __builtin_amdgcn_mfma_f32_16x16x32_bf16(*(const LAS bf16x8*)(X_), *(const LAS bf16x8*)(Y_), p_, 0, 0, 0); \
            p_ = __builtin_amdgcn_mfma_f32_16x16x32_bf16(*(const LAS bf16x8*)(X_ + 64), *(const LAS bf16x8*)(Y_ + 64), p_, 0, 0, 0); \
            _Pragma("unroll") for (int q_ = 0; q_ < 4; ++q_) { const int s_ = 4 * g_ + q_; const bool keep_ = (hw_ & 2) ? (s_ <= r_) : (s_ < r_); p_[q_] = keep_ ? p_[q_] : 0.f; } \
            if (hw_ != 0) { \
                const float sg_ = (hw_ == 2) ? -1.0f : 1.0f; const int off_ = (hw_ == 1) ? AB_A2 : (hw_ == 2) ? AB_A3 : AB_A4; \
                *(LAS u32x2*)(ab_ + off_ + r_ * AS + g_ * 8) = (u32x2){cvtpk(sg_ * p_[0], sg_ * p_[1]), cvtpk(sg_ * p_[2], sg_ * p_[3])}; \
            } } while (0)
#define S_TINV(c) do { int r_ = r16, g_ = g; asm volatile("" : "+v"(r_), "+v"(g_)); \
            LAS unsigned char* vb_ = L + OFF_VB + (int)((unsigned)(c) % 3u) * VB_SIZE; LAS unsigned char* ab_ = L + OFF_AB + ((c) & 1) * AB_SIZE; \
            const LAS unsigned char* X_ = vb_ + VB_BS + r_ * RS + g_ * 16; const LAS unsigned char* Y_ = vb_ + VB_KT + r_ * RS + g_ * 16; \
            f32x4 p_ = (f32x4){0.f, 0.f, 0.f, 0.f}; \
            p_ = __builtin_amdgcn_mfma_f32_16x16x32_bf16(*(const LAS bf16x8*)(X_), *(const LAS bf16x8*)(Y_), p_, 0, 0, 0); \
            p_ = __builtin_amdgcn_mfma_f32_16x16x32_bf16(*(const LAS bf16x8*)(X_ + 64), *(const LAS bf16x8*)(Y_ + 64), p_, 0, 0, 0); \
            _Pragma("unroll") for (int q_ = 0; q_ < 4; ++q_) p_[q_] = (4 * g_ + q_ < r_) ? p_[q_] : 0.f; \
                  \
                  \
                f32x4 p2_ = (f32x4){0.f, 0.f, 0.f, 0.f}; \
                p2_ = __builtin_amdgcn_mfma_f32_16x16x32_bf16(*(const LAS bf16x8*)(Y_), *(const LAS bf16x8*)(X_), p2_, 0, 0, 0); \
                p2_ = __builtin_amdgcn_mfma_f32_16x16x32_bf16(*(const LAS bf16x8*)(Y_ + 64), *(const LAS bf16x8*)(X_ + 64), p2_, 0, 0, 0); \
                f32x4 Pa_, Pb_, Ta_, Tb_; \
                _Pragma("unroll") for (int q_ = 0; q_ < 4; ++q_) { const int o_ = 4 * g_ + q_; Pa_[q_] = -p_[q_]; Pb_[q_] = (r_ < o_) ? -p2_[q_] : 0.f; const float d_ = (r_ == o_) ? 1.0f : 0.0f; Ta_[q_] = d_ + Pa_[q_]; Tb_[q_] = d_ + Pb_[q_]; } \
                _Pragma("unroll") for (int it_ = 0; it_ < 3; ++it_) { \
                    const s16x4 a8_ = K16(((u32x2){cvtpk(Pa_[0], Pa_[1]), cvtpk(Pa_[2], Pa_[3])})), b8_ = K16(((u32x2){cvtpk(Pb_[0], Pb_[1]), cvtpk(Pb_[2], Pb_[3])})); \
                    const f32x4 z_ = (f32x4){0.f, 0.f, 0.f, 0.f}; \
                    Pb_ = __builtin_amdgcn_mfma_f32_16x16x16bf16_1k(a8_, b8_, z_, 0, 0, 0); Pa_ = __builtin_amdgcn_mfma_f32_16x16x16bf16_1k(b8_, a8_, z_, 0, 0, 0); \
                    const s16x4 t8_ = K16(((u32x2){cvtpk(Ta_[0], Ta_[1]), cvtpk(Ta_[2], Ta_[3])})), p8_ = K16(((u32x2){cvtpk(Pb_[0], Pb_[1]), cvtpk(Pb_[2], Pb_[3])})); \
                    const f32x4 nTb_ = __builtin_amdgcn_mfma_f32_16x16x16bf16_1k(t8_, p8_, Tb_, 0, 0, 0), nTa_ = __builtin_amdgcn_mfma_f32_16x16x16bf16_1k(p8_, t8_, Ta_, 0, 0, 0); \
                    Ta_ = nTa_; Tb_ = nTb_; } \
                *(LAS u32x2*)(ab_ + AB_T + r_ * AS + g_ * 8) = (u32x2){cvtpk(Ta_[0], Ta_[1]), cvtpk(Ta_[2], Ta_[3])}; \
            } while (0)
#define H_POST(c) do { int tt_ = tt, d4_ = d4; asm volatile("" : "+v"(tt_), "+v"(d4_)); const size_t row_ = (size_t)b * SEQ + (size_t)(c) * 16 + tt; const LAS unsigned char* vr_ = L + OFF_VR + ((c) & 3) * VR_SIZE; \
            const f32x4 y_ = *(const LAS f32x4*)(L + OFF_Y + ((c) & 1) * 4096 + tt_ * 256 + d4_ * 4); \
            const float mean_ = allreduce16((y_.x + y_.y) + (y_.z + y_.w)) * (1.f / 64.f); const f32x4 dy_ = y_ - mean_; \
            const float var_ = allreduce16((dy_.x * dy_.x + dy_.y * dy_.y) + (dy_.z * dy_.z + dy_.w * dy_.w)) * (1.f / 64.f); const float rs_ = 1.0f / sqrtf(var_ + GN_EPS); \
            const u32x2 gq_ = *(const LAS u32x2*)(vr_ + VR_G + tt_ * 128 + d4_ * 2); const f32x4 vsh_ = *(const LAS f32x4*)(vr_ + VR_V32 + tt_ * 256 + d4_ * 4); const float bo_ = *(const LAS float*)(vr_ + VR_BON + tt_ * 4); \
            const f32x4 o_ = (dy_ * rs_ * c_lnw + c_lnb + bo_ * vsh_) * UP4(gq_); \
            *(u32x2*)(F.YB + row_ * 512 + hc) = PK4(o_); } while (0)
        const f32x4 c_mur = *(const f32x4*)(F.in[I_MU] + hc), c_muk = *(const f32x4*)(F.in[I_MU] + 512 + hc), c_muv = *(const f32x4*)(F.in[I_MU] + 1024 + hc);
        const f32x4 c_kk = *(const f32x4*)(F.in[I_KK] + hc), c_ka = *(const f32x4*)(F.in[I_KA] + hc), c_rk = *(const f32x4*)(F.in[I_RK] + hc), c_lnw = *(const f32x4*)(F.in[I_LNW] + hc), c_lnb = *(const f32x4*)(F.in[I_LNB] + hc);
        f32x4 St[4];
#pragma unroll
        for (int i = 0; i < 4; ++i) St[i] = (f32x4){0.f, 0.f, 0.f, 0.f};
#define FR2(lo_, hi_) __builtin_bit_cast(bf16x8, (v4u){(lo_).x, (lo_).y, (hi_).x, (hi_).y})
typedef short s16x4 __attribute__((ext_vector_type(4)));
#define K16(w_) __builtin_bit_cast(s16x4, (w_))
#define SCAN_CHAIN(c) do { int r_ = r16, g_ = g; asm volatile("" : "+v"(r_), "+v"(g_)); \
                const LAS unsigned char* vb = L + OFF_VB + (int)((unsigned)(c) % 3u) * VB_SIZE; const LAS unsigned char* ab = L + OFF_AB + ((c) & 1) * AB_SIZE; \
                const int v = 16 * wave + r_; \
                const bf16x8 sb01 = __builtin_bit_cast(bf16x8, (v4u){cvtpk(St[0][0], St[0][1]), cvtpk(St[0][2], St[0][3]), cvtpk(St[1][0], St[1][1]), cvtpk(St[1][2], St[1][3])}); \
                const bf16x8 sb23 = __builtin_bit_cast(bf16x8, (v4u){cvtpk(St[2][0], St[2][1]), cvtpk(St[2][2], St[2][3]), cvtpk(St[3][0], St[3][1]), cvtpk(St[3][2], St[3][3])}); \
                const LAS unsigned char* ktp = vb + VB_KT + r_ * RS + g_ * 8; const LAS unsigned char* rtp = vb + VB_RT + r_ * RS + g_ * 8; \
                const bf16x8 kt01 = FR2(*(const LAS u32x2*)(ktp), *(const LAS u32x2*)(ktp + 32)), kt23 = FR2(*(const LAS u32x2*)(ktp + 64), *(const LAS u32x2*)(ktp + 96)); \
                const bf16x8 rt01 = FR2(*(const LAS u32x2*)(rtp), *(const LAS u32x2*)(rtp + 32)), rt23 = FR2(*(const LAS u32x2*)(rtp + 64), *(const LAS u32x2*)(rtp + 96)); \
                const s16x4 a2f = K16(*(const LAS u32x2*)(ab + AB_A2 + r_ * AS + g_ * 8)), a3f = K16(*(const LAS u32x2*)(ab + AB_A3 + r_ * AS + g_ * 8)); \
                const s16x4 a4f = K16(*(const LAS u32x2*)(ab + AB_A4 + r_ * AS + g_ * 8)), tf = K16(*(const LAS u32x2*)(ab + AB_T + r_ * AS + g_ * 8)); \
                const s16x4 vf = K16(*(const LAS u32x2*)(vb + VB_VT + v * TS + g_ * 8)); \
                f32x4 G = (f32x4){0.f, 0.f, 0.f, 0.f}; \
                G = __builtin_amdgcn_mfma_f32_16x16x32_bf16(kt01, sb01, G, 0, 0, 0); \
                G = __builtin_amdgcn_mfma_f32_16x16x32_bf16(kt23, sb23, G, 0, 0, 0); \
                G = __builtin_amdgcn_mfma_f32_16x16x16bf16_1k(a2f, vf, G, 0, 0, 0);        \
                const s16x4 gb = K16(((u32x2){cvtpk(G[0], G[1]), cvtpk(G[2], G[3])})); \
                const f32x4 E = __builtin_amdgcn_mfma_f32_16x16x16bf16_1k(tf, gb, (f32x4){0.f, 0.f, 0.f, 0.f}, 0, 0, 0); \
                const s16x4 eb = K16(((u32x2){cvtpk(E[0], E[1]), cvtpk(E[2], E[3])})); \
                f32x4 Yt = (f32x4){0.f, 0.f, 0.f, 0.f}; \
                Yt = __builtin_amdgcn_mfma_f32_16x16x32_bf16(rt01, sb01, Yt, 0, 0, 0); \
                Yt = __builtin_amdgcn_mfma_f32_16x16x32_bf16(rt23, sb23, Yt, 0, 0, 0); \
                Yt = __builtin_amdgcn_mfma_f32_16x16x16bf16_1k(a4f, vf, Yt, 0, 0, 0); \
                Yt = __builtin_amdgcn_mfma_f32_16x16x16bf16_1k(a3f, eb, Yt, 0, 0, 0); \
                _Pragma("unroll") \
                for (int rt = 0; rt < 4; ++rt) { \
                    const s16x4 kkf = K16(*(const LAS u32x2*)(vb + VB_KK + (16 * rt + r_) * TS + g_ * 8)), btf = K16(*(const LAS u32x2*)(vb + VB_BT + (16 * rt + r_) * TS + g_ * 8)); \
                    St[rt] = __builtin_amdgcn_mfma_f32_16x16x16bf16_1k(kkf, vf, St[rt], 0, 0, 0); \
                    St[rt] = __builtin_amdgcn_mfma_f32_16x16x16bf16_1k(btf, eb, St[rt], 0, 0, 0); \
                    St[rt] = St[rt] * *(const LAS f32x4*)(vb + VB_DC + (16 * rt + 4 * g_) * 4); \
                } \
                LAS float* yo = (LAS float*)(L + OFF_Y + ((c) & 1) * 4096) + (4 * g_) * 64 + v; \
                yo[0] = Yt[0]; yo[64] = Yt[1]; yo[128] = Yt[2]; yo[192] = Yt[3]; \
            } while (0)
        if (helper) { H_ISSUE(0); H_LAND(0); H_ISSUE(1); H_LAND(1); H_ISSUE(2); H_LAND(2); H_ISSUE(3); }
        SCAN_BAR();
        if (helper) { H_PREP(0); H_PREP(1); }
        SCAN_BAR();
        if (helper) H_PROD(0); else if (wave == 0) S_TINV(0);
        SCAN_BAR();
#define ITER(c) do { \
            if (helper) { \
                if ((c) + 3 < NCH) H_LAND((c) + 3); \
                if ((c) + 4 < NCH) H_ISSUE((c) + 4); \
                if ((c) + 1 < NCH) { H_PROD((c) + 1); if (DUP_PHASE == 42) { H_PROD((c) + 1); } } \
                if ((c) + 2 < NCH) { H_PREP((c) + 2); if (DUP_PHASE == 41) { H_PREP((c) + 2); } } \
            } else { \
                if ((c) < NCH) { SCAN_CHAIN(c); } \
                if ((c) >= 1) { H_POST((c) - 1); if (DUP_PHASE == 43) { H_POST((c) - 1); } } \
                if (wave == 0 && (c) + 1 < NCH) { S_TINV((c) + 1); if (DUP_PHASE == 46) { S_TINV((c) + 1); } } \
            } \
            SCAN_BAR(); } while (0)
#pragma unroll 1
        for (int c = 0; c <= NCH; ++c) ITER(c);
#undef ITER
        __syncthreads();
#undef H_ISSUE
#undef H_LAND
#undef UP4
#undef PK4
#undef H_PREP
#undef H_PROD
#undef S_TINV
#undef H_POST
    }
}

#define CE(i, j) do { const unsigned a_ = x[i], b_ = x[j]; x[i] = a_ > b_ ? a_ : b_; x[j] = a_ > b_ ? b_ : a_; } while (0)
__device__ __forceinline__ void sort16(unsigned (&x)[16]) {
    CE(0,1); CE(2,3); CE(0,2); CE(1,3); CE(1,2); CE(4,5); CE(6,7); CE(4,6); CE(5,7); CE(5,6); CE(0,4); CE(2,6); CE(2,4); CE(1,5); CE(3,7); CE(3,5); CE(1,2); CE(3,4); CE(5,6);
    CE(8,9); CE(10,11); CE(8,10); CE(9,11); CE(9,10); CE(12,13); CE(14,15); CE(12,14); CE(13,15); CE(13,14); CE(8,12); CE(10,14); CE(10,12); CE(9,13); CE(11,15); CE(11,13); CE(9,10); CE(11,12); CE(13,14);
    CE(0,8); CE(4,12); CE(4,8); CE(2,10); CE(6,14); CE(6,10); CE(2,4); CE(6,8); CE(10,12); CE(1,9); CE(5,13); CE(5,9); CE(3,11); CE(7,15); CE(7,11); CE(3,5); CE(7,9); CE(11,13);
    CE(1,2); CE(3,4); CE(5,6); CE(7,8); CE(9,10); CE(11,12); CE(13,14);
}
__device__ __forceinline__ void merge16(unsigned (&x)[16], const unsigned (&y)[16]) {
#pragma unroll
    for (int i = 0; i < 16; ++i) x[i] = x[i] > y[15 - i] ? x[i] : y[15 - i];
    CE(0,8); CE(1,9); CE(2,10); CE(3,11); CE(4,12); CE(5,13); CE(6,14); CE(7,15); CE(0,4); CE(1,5); CE(2,6); CE(3,7); CE(8,12); CE(9,13); CE(10,14); CE(11,15);
    CE(0,2); CE(1,3); CE(4,6); CE(5,7); CE(8,10); CE(9,11); CE(12,14); CE(13,15); CE(0,1); CE(2,3); CE(4,5); CE(6,7); CE(8,9); CE(10,11); CE(12,13); CE(14,15);
}
#undef CE
__device__ __forceinline__ unsigned f2key(float f) { const unsigned u = __builtin_bit_cast(unsigned, f); return u ^ ((unsigned)((int)u >> 31) | 0x80000000u); }
__device__ __forceinline__ float key2f(unsigned k) { return __builtin_bit_cast(float, (k & 0x80000000u) ? (k ^ 0x80000000u) : ~k); }
__device__ __forceinline__ unsigned lut16(const unsigned (&p)[4], unsigned i) {
    const unsigned q = i >> 2; const unsigned w = q == 0 ? p[0] : q == 1 ? p[1] : q == 2 ? p[2] : p[3];
    return (w >> ((i & 3u) * 8u)) & 0xffu;
}
__device__ __forceinline__ void peer_half_topk(const bf16* SKhp, const bf16* qrow, int r32, int hh, unsigned (&T)[16]) {
    bf16x8 bq[4];
#pragma unroll
    for (int s = 0; s < 4; ++s) bq[s] = *(const bf16x8*)(qrow + 16 * s + 8 * hh);
    unsigned G_[16];
#pragma unroll
    for (int i = 0; i < 16; ++i) T[i] = 0u;
#pragma unroll 1
    for (int nt = 0; nt < 4; ++nt) {
        f32x16 acc = {};
#pragma unroll
        for (int s = 0; s < 4; ++s) { const bf16x8 a = *(const bf16x8*)(SKhp + (nt * 32 + r32) * 64 + 16 * s + 8 * hh); acc = __builtin_amdgcn_mfma_f32_32x32x16_bf16(a, bq[s], acc, 0, 0, 0); }
#pragma unroll
        for (int r = 0; r < 16; ++r) { const unsigned n = nt * 32 + (r & 3) + 8 * (r >> 2) + 4 * hh; G_[r] = (f2key(acc[r]) & ~0x7fu) | n; }
        sort16(G_);
        merge16(T, G_);
    }
#pragma unroll
    for (int i = 0; i < 16; ++i) G_[i] = (unsigned)__shfl_xor((int)T[i], 32);
    merge16(T, G_);
}
__device__ __forceinline__ void peer_topk_phase(Frame& F) {
    const int lane = F.lane, wave = F.wave, r32 = lane & 31, hh = lane >> 5;
    for (int unit = F.vcu; unit < M / 256; unit += F.G) {
        const int tok = unit * 256 + wave * 32 + r32;
        const float rstd = 1.0f / sqrtf(F.SSQ[tok] * (1.f / D) + NORM_EPS);
#pragma unroll 1
        for (int h = 0; h < 8; ++h) {
            unsigned T1[16], T2[16];
            peer_half_topk(F.SK + (size_t)(h * 2 + 0) * 128 * 64, F.QP + (size_t)tok * 1024 + h * 128, r32, hh, T1);
            peer_half_topk(F.SK + (size_t)(h * 2 + 1) * 128 * 64, F.QP + (size_t)tok * 1024 + h * 128 + 64, r32, hh, T2);
            float v1[16], v2[16]; unsigned p1[4] = {0u, 0u, 0u, 0u}, p2[4] = {0u, 0u, 0u, 0u};
#pragma unroll
            for (int i = 0; i < 16; ++i) { v1[i] = key2f(T1[i] & ~0x7fu); v2[i] = key2f(T2[i] & ~0x7fu); p1[i >> 2] |= (T1[i] & 0x7fu) << ((i & 3) * 8); p2[i >> 2] |= (T2[i] & 0x7fu) << ((i & 3) * 8); }
            unsigned C[16], Gc[16];
#define CK(i, j) ((f2key(v1[i] + v2[j]) & ~0xffu) | (unsigned)((i) * 16 + (j)))
            Gc[0] = CK(0,0); Gc[1] = CK(0,1); Gc[2] = CK(0,2); Gc[3] = CK(0,3); Gc[4] = CK(0,4); Gc[5] = CK(0,5); Gc[6] = CK(0,6); Gc[7] = CK(0,7); Gc[8] = CK(0,8); Gc[9] = CK(0,9); Gc[10] = CK(0,10); Gc[11] = CK(0,11); Gc[12] = CK(0,12); Gc[13] = CK(0,13); Gc[14] = CK(0,14); Gc[15] = CK(0,15);
            sort16(Gc);
            _Pragma("unroll") for (int e = 0; e < 16; ++e) C[e] = Gc[e];
            Gc[0] = CK(1,0); Gc[1] = CK(1,1); Gc[2] = CK(1,2); Gc[3] = CK(1,3); Gc[4] = CK(1,4); Gc[5] = CK(1,5); Gc[6] = CK(1,6); Gc[7] = CK(1,7); Gc[8] = CK(2,0); Gc[9] = CK(2,1); Gc[10] = CK(2,2); Gc[11] = CK(2,3); Gc[12] = CK(2,4); Gc[13] = CK(3,0); Gc[14] = CK(3,1); Gc[15] = CK(3,2);
            sort16(Gc);
            merge16(C, Gc);
            Gc[0] = CK(3,3); Gc[1] = CK(4,0); Gc[2] = CK(4,1); Gc[3] = CK(4,2); Gc[4] = CK(5,0); Gc[5] = CK(5,1); Gc[6] = CK(6,0); Gc[7] = CK(6,1); Gc[8] = CK(7,0); Gc[9] = CK(7,1); Gc[10] = CK(8,0); Gc[11] = CK(9,0); Gc[12] = CK(10,0); Gc[13] = CK(11,0); Gc[14] = CK(12,0); Gc[15] = CK(13,0);
            sort16(Gc);
            merge16(C, Gc);
            Gc[0] = CK(14,0); Gc[1] = CK(15,0); Gc[2] = 0u; Gc[3] = 0u; Gc[4] = 0u; Gc[5] = 0u; Gc[6] = 0u; Gc[7] = 0u; Gc[8] = 0u; Gc[9] = 0u; Gc[10] = 0u; Gc[11] = 0u; Gc[12] = 0u; Gc[13] = 0u; Gc[14] = 0u; Gc[15] = 0u;
            sort16(Gc);
            merge16(C, Gc);
#undef CK
            float gsum = 0.f, gv[16]; int ex[16];
            const float top = key2f(C[0] & ~0xffu) * rstd;
#pragma unroll
            for (int k = 0; k < 16; ++k) {
                const float e = __builtin_amdgcn_exp2f((key2f(C[k] & ~0xffu) * rstd - top) * LOG2E); gv[k] = e; gsum += e;
                ex[k] = (int)(lut16(p1, (C[k] >> 4) & 15u) * 128u + lut16(p2, C[k] & 15u));
            }
            const float ginv = 1.0f / gsum;
            int* ip = F.IDX + (size_t)tok * 128 + h * 16 + hh * 8;
            typedef int i32x4 __attribute__((ext_vector_type(4)));
            i32x4 i0, i1;
#pragma unroll
            for (int k = 0; k < 4; ++k) {
                const int ea = hh ? ex[8 + k] : ex[k], eb = hh ? ex[12 + k] : ex[4 + k];
                const float ga = (hh ? gv[8 + k] : gv[k]) * ginv, gb = (hh ? gv[12 + k] : gv[4 + k]) * ginv;
                i0[k] = (ea << 18) | (int)(ga * 262143.0f + 0.5f); i1[k] = (eb << 18) | (int)(gb * 262143.0f + 0.5f);
            }
            *(i32x4*)ip = i0; *(i32x4*)(ip + 4) = i1;
        }
    }
}

typedef int v8i_t __attribute__((ext_vector_type(8)));
#define H8C(x) __builtin_amdgcn_fmed3f((x), -448.f, 448.f)
__device__ __forceinline__ void peer_gather_phase(Frame& F) {
    const int lane = F.lane, rw = lane >> 4, c = lane & 15;
    const int gw = F.vcu * NWAVES + F.wave, NGW = F.G * NWAVES;
    const float* wfin = F.in[I_NFINAL];
    LAS unsigned* SW = (LAS unsigned*)F.lds + F.wave * 512;
    LAS float* AW = (LAS float*)(F.lds + 16384) + F.wave * 512;
    LAS unsigned char* AT = F.lds + 32768 + F.wave * 4096;
    int round = 0;
#pragma unroll 1
    for (int tbase = gw * 4; tbase < M; tbase += NGW * 4, ++round) {
#ifdef ROUND_SYNC
        if (F.rnd_nloc > 0) {
            __syncthreads();
            if (F.tid == 0) {
                gu32* cw = F.ctl + CW_RND + 64 * F.rnd_x;
                __hip_atomic_fetch_add(cw, 1u, RLX_AGENT);
                const unsigned want = (unsigned)F.rnd_nloc * (unsigned)(round + 1);
                for (int sp = 0; sp < 20000 && __hip_atomic_load(cw, RLX_AGENT) < want; ++sp) __builtin_amdgcn_s_sleep(2);
            }
            __syncthreads();
        }
#endif
#pragma unroll 1
        for (int j = 0; j < 4; ++j) {
            int lo_ = lane; asm volatile("" : "+v"(lo_));
            unsigned id0 = (unsigned)F.IDX[(size_t)(tbase + j) * 128 + lo_], id1 = (unsigned)F.IDX[(size_t)(tbase + j) * 128 + 64 + lo_];
#define BSTEP(k_, j_, OTH0, OTH1) do { const unsigned o0_ = (OTH0), o1_ = (OTH1); const bool low_ = (lane & (j_)) == 0; \
            const bool up0_ = ((lane & (k_)) == 0), up1_ = (((64 + lane) & (k_)) == 0); \
            const unsigned mn0_ = id0 < o0_ ? id0 : o0_, mx0_ = id0 < o0_ ? o0_ : id0, mn1_ = id1 < o1_ ? id1 : o1_, mx1_ = id1 < o1_ ? o1_ : id1; \
            id0 = (up0_ == low_) ? mn0_ : mx0_; id1 = (up1_ == low_) ? mn1_ : mx1_; } while (0)
#define BSWZ(k_, j_) BSTEP(k_, j_, (unsigned)__builtin_amdgcn_ds_swizzle((int)id0, ((j_) << 10) | 0x1f), (unsigned)__builtin_amdgcn_ds_swizzle((int)id1, ((j_) << 10) | 0x1f))
#define B32(k_) do { const auto p0_ = __builtin_amdgcn_permlane32_swap(id0, id0, false, false); const unsigned p00_ = p0_[0], p01_ = p0_[1]; \
            const auto p1_ = __builtin_amdgcn_permlane32_swap(id1, id1, false, false); const unsigned p10_ = p1_[0], p11_ = p1_[1]; \
            BSTEP(k_, 32, (lane < 32 ? p01_ : p00_), (lane < 32 ? p11_ : p10_)); } while (0)
            BSWZ(2, 1);
            BSWZ(4, 2); BSWZ(4, 1);
            BSWZ(8, 4); BSWZ(8, 2); BSWZ(8, 1);
            BSWZ(16, 8); BSWZ(16, 4); BSWZ(16, 2); BSWZ(16, 1);
            BSWZ(32, 16); BSWZ(32, 8); BSWZ(32, 4); BSWZ(32, 2); BSWZ(32, 1);
            B32(64); BSWZ(64, 16); BSWZ(64, 8); BSWZ(64, 4); BSWZ(64, 2); BSWZ(64, 1);
            { const unsigned mn_ = id0 < id1 ? id0 : id1, mx_ = id0 < id1 ? id1 : id0; id0 = mn_; id1 = mx_; }
            B32(128); BSWZ(128, 16); BSWZ(128, 8); BSWZ(128, 4); BSWZ(128, 2); BSWZ(128, 1);
#undef BSTEP
#undef BSWZ
#undef B32
            SW[j * 128 + lane] = id0; SW[j * 128 + 64 + lane] = id1;
        }
        const int tok = tbase + rw;
        int c1 = c; asm volatile("" : "+v"(c1));
        const bf16* hb = F.HB + (size_t)tok * 1024 + c1 * 64;
        const float rstd = 1.0f / sqrtf(F.SSQ[tok] * (1.f / D) + NORM_EPS);
        const float hscale = rstd * (1.0f / U6_SCALE);
        const LAS unsigned* sw = SW + rw * 128;
        LAS float* aw = AW + rw * 128;
        const unsigned vlo = c * 16; const LAS unsigned* swr = SW + rw;
        constexpr int VFMT = V_FP4 ? 4 : 2;
        struct VSet { v4u l4; u32x2 l2; v4u h4; u32x2 h2; };
        VSet sa[4], sb[4];
#define PV_LOAD(q_, T_, S_) do { const unsigned e_ = swr[(T_) * 128 + 4 * (q_)] >> 18; const unsigned char* vb_ = F.V8 + (size_t)(e_ * (unsigned)V_ROW + vlo);        \
            if (V_FP4) { S_.l4 = *(const v4u*)(vb_); S_.h4 = *(const v4u*)(vb_ + 256); } \
            else { S_.l4 = *(const v4u*)(vb_); S_.l2 = *(const u32x2*)(vb_ + 256 - 8 * c); S_.h4 = *(const v4u*)(vb_ + 384); S_.h2 = *(const u32x2*)(vb_ + 640 - 8 * c); } } while (0)
        PV_LOAD(0, 0, sa[0]); PV_LOAD(0, 1, sa[1]); PV_LOAD(0, 2, sa[2]); PV_LOAD(0, 3, sa[3]);
        PV_LOAD(1, 0, sb[0]); PV_LOAD(1, 1, sb[1]); PV_LOAD(1, 2, sb[2]); PV_LOAD(1, 3, sb[3]);
        {
            v8i_t hbT[4];
#pragma unroll
            for (int t_ = 0; t_ < 4; ++t_) {
                const float bs = H8_SCALE / sqrtf(F.SSQ[tbase + t_] * (1.f / D) + NORM_EPS);
                const bf16* hq = F.HB + (size_t)(tbase + t_) * 1024 + (c & 7) * 128 + rw * 16;
#pragma unroll
                for (int q = 0; q < 4; ++q) {
                    const v4u w = *(const v4u*)(hq + (q >> 1) * 64 + (q & 1) * 8);
                    int d0 = __builtin_amdgcn_cvt_pk_fp8_f32(H8C(bf_lo(w.x) * bs), H8C(bf_hi(w.x) * bs), 0, false); d0 = __builtin_amdgcn_cvt_pk_fp8_f32(H8C(bf_lo(w.y) * bs), H8C(bf_hi(w.y) * bs), d0, true);
                    int d1 = __builtin_amdgcn_cvt_pk_fp8_f32(H8C(bf_lo(w.z) * bs), H8C(bf_hi(w.z) * bs), 0, false); d1 = __builtin_amdgcn_cvt_pk_fp8_f32(H8C(bf_lo(w.w) * bs), H8C(bf_hi(w.w) * bs), d1, true);
                    hbT[t_][2 * q] = d0; hbT[t_][2 * q + 1] = d1;
                }
            }
            const unsigned ulo = 16 * (4 * (c & 7) + rw); const LAS unsigned* swl8 = SW + (c >> 3);
            const int uoff2 = 512 - 8 * (4 * (c & 7) + rw);
            constexpr int UFMT = U_FP4 ? 4 : 2;
            const bool dkeep = (c < 8) && ((rw & 1) == (c >> 2));
            struct USet { v4u a; u32x2 b; };
            USet ua[8], ub[8];
#define UA_LOAD(b_, X_, S_) do { const unsigned e_ = swl8[((X_) >> 1) * 128 + 4 * (b_) + 2 * ((X_) & 1)] >> 18; \
                const unsigned char* up_ = F.U8 + (size_t)(e_ * (unsigned)U_ROW + ulo); S_.a = *(const v4u*)(up_); if (!U_FP4) S_.b = *(const u32x2*)(up_ + uoff2); } while (0)
#define UA_COMP(X_, S_) do { const v8i_t a8 = {(int)S_.a.x, (int)S_.a.y, (int)S_.a.z, (int)S_.a.w, U_FP4 ? 0 : (int)S_.b.x, U_FP4 ? 0 : (int)S_.b.y, 0, 0}; \
                const f32x4 d_ = __builtin_amdgcn_mfma_scale_f32_16x16x128_f8f6f4(a8, hbT[(X_) >> 1], (f32x4){0.f, 0.f, 0.f, 0.f}, UFMT, 0, 0, 0x7f7f7f7f, 0, 0x7f7f7f7f); \
                sx[X_] = d_[(X_) & 3] + dppf<0x39>(d_[((X_) + 1) & 3]) + dppf<0x4E>(d_[((X_) + 2) & 3]) + dppf<0x93>(d_[((X_) + 3) & 3]); } while (0)
#define UA_ITER(b_, SETS_) do { float sx[8]; \
                UA_COMP(0, SETS_[0]); UA_LOAD((b_) + 2, 0, SETS_[0]); UA_COMP(1, SETS_[1]); UA_LOAD((b_) + 2, 1, SETS_[1]); \
                UA_COMP(2, SETS_[2]); UA_LOAD((b_) + 2, 2, SETS_[2]); UA_COMP(3, SETS_[3]); UA_LOAD((b_) + 2, 3, SETS_[3]); \
                UA_COMP(4, SETS_[4]); UA_LOAD((b_) + 2, 4, SETS_[4]); UA_COMP(5, SETS_[5]); UA_LOAD((b_) + 2, 5, SETS_[5]); \
                UA_COMP(6, SETS_[6]); UA_LOAD((b_) + 2, 6, SETS_[6]); UA_COMP(7, SETS_[7]); UA_LOAD((b_) + 2, 7, SETS_[7]); \
                const int l3_ = c & 3; \
                float w0_ = l3_ == 0 ? sx[0] : l3_ == 1 ? sx[1] : l3_ == 2 ? sx[2] : sx[3], w1_ = l3_ == 0 ? sx[4] : l3_ == 1 ? sx[5] : l3_ == 2 ? sx[6] : sx[7]; \
                w0_ = dkeep ? w0_ : 0.f; w1_ = dkeep ? w1_ : 0.f;                    \
                w0_ += dppf<0x124>(w0_); w1_ += dppf<0x124>(w1_); w0_ += dppf<0x128>(w0_); w1_ += dppf<0x128>(w1_);        \
                { const auto sw_ = __builtin_amdgcn_permlane16_swap(f2u(w0_), f2u(w0_), false, false); const unsigned s0_ = sw_[0], s1_ = sw_[1]; w0_ = u2f(s0_) + u2f(s1_); } \
                { const auto sw_ = __builtin_amdgcn_permlane16_swap(f2u(w1_), f2u(w1_), false, false); const unsigned s0_ = sw_[0], s1_ = sw_[1]; w1_ = u2f(s0_) + u2f(s1_); } \
                const float dsel = (c & 4) ? w1_ : w0_;                              \
                  \
                const int wi_ = ((c >> 1) & 3) * 128 + 4 * (b_) + 2 * (c & 1) + (rw >> 1); \
                const unsigned wg_ = SW[wi_]; \
                const float act_ = gelu_erf(dsel * (1.0f / (U6_SCALE * H8_SCALE))) * ((float)(wg_ & 0x3ffffu) * (1.0f / (262143.0f * V6_SCALE))); \
                if (c < 8 && (rw & 1) == 0) AW[wi_] = act_; } while (0)
#pragma unroll
            for (int x_ = 0; x_ < 8; ++x_) UA_LOAD(0, x_, ua[x_]);
#pragma unroll
            for (int x_ = 0; x_ < 8; ++x_) UA_LOAD(1, x_, ub[x_]);
#pragma unroll 1
            for (int b = 0; b < 32; b += 2) {
                if ((b & 3) == 0) __builtin_amdgcn_s_barrier();
                UA_ITER(b, ua);
                UA_ITER(b + 1, ub);
            }
#undef UA_LOAD
#undef UA_COMP
#undef UA_ITER
        }
        f32x4 dd[4][4];
#pragma unroll
        for (int t_ = 0; t_ < 4; ++t_)
#pragma unroll
            for (int x_ = 0; x_ < 4; ++x_) dd[t_][x_] = (f32x4){0.f, 0.f, 0.f, 0.f};
        {
            const unsigned selA = 0x0c0c0c0cu ^ (0x0cu << (8 * (c & 3))), selB = selA | (1u << (8 * (c & 3)));
            unsigned mk[2][4];
#pragma unroll
            for (int s_ = 0; s_ < 2; ++s_)
#pragma unroll
                for (int d_ = 0; d_ < 4; ++d_) mk[s_][d_] = ((c >> 2) == d_ && (rw & 1) == s_) ? 0xffffffffu : 0u;
#define PV_COMP(q_, T_, S_) do { const LAS float* ap_ = AW + (T_) * 128 + 4 * (q_) + (rw >> 1); \
                const float a0_ = __builtin_amdgcn_fmed3f(ap_[0] * A8_SCALE, -448.f, 448.f), a1_ = __builtin_amdgcn_fmed3f(ap_[2] * A8_SCALE, -448.f, 448.f); \
                const unsigned w_ = (unsigned)__builtin_amdgcn_cvt_pk_fp8_f32(a0_, a1_, 0, false); \
                const unsigned x0_ = __builtin_amdgcn_perm(w_, w_, selA), x1_ = __builtin_amdgcn_perm(w_, w_, selB); \
                const v8i_t b0_ = {(int)(x0_ & mk[0][0]), (int)(x0_ & mk[0][1]), (int)(x0_ & mk[0][2]), (int)(x0_ & mk[0][3]), (int)(x1_ & mk[0][0]), (int)(x1_ & mk[0][1]), (int)(x1_ & mk[0][2]), (int)(x1_ & mk[0][3])}; \
                const v8i_t b1_ = {(int)(x0_ & mk[1][0]), (int)(x0_ & mk[1][1]), (int)(x0_ & mk[1][2]), (int)(x0_ & mk[1][3]), (int)(x1_ & mk[1][0]), (int)(x1_ & mk[1][1]), (int)(x1_ & mk[1][2]), (int)(x1_ & mk[1][3])}; \
                const v8i_t al_ = {(int)S_.l4.x, (int)S_.l4.y, (int)S_.l4.z, (int)S_.l4.w, V_FP4 ? 0 : (int)S_.l2.x, V_FP4 ? 0 : (int)S_.l2.y, 0, 0}; \
                const v8i_t ah_ = {(int)S_.h4.x, (int)S_.h4.y, (int)S_.h4.z, (int)S_.h4.w, V_FP4 ? 0 : (int)S_.h2.x, V_FP4 ? 0 : (int)S_.h2.y, 0, 0}; \
                dd[T_][0] = __builtin_amdgcn_mfma_scale_f32_16x16x128_f8f6f4(al_, b0_, dd[T_][0], VFMT, 0, 0, 0x7f7f7f7f, 0, 0x7f7f7f7f); \
                dd[T_][1] = __builtin_amdgcn_mfma_scale_f32_16x16x128_f8f6f4(al_, b1_, dd[T_][1], VFMT, 0, 0, 0x7f7f7f7f, 0, 0x7f7f7f7f); \
                dd[T_][2] = __builtin_amdgcn_mfma_scale_f32_16x16x128_f8f6f4(ah_, b0_, dd[T_][2], VFMT, 0, 0, 0x7f7f7f7f, 0, 0x7f7f7f7f); \
                dd[T_][3] = __builtin_amdgcn_mfma_scale_f32_16x16x128_f8f6f4(ah_, b1_, dd[T_][3], VFMT, 0, 0, 0x7f7f7f7f, 0, 0x7f7f7f7f); } while (0)
#pragma unroll 1
            for (int q = 0; q < 32; q += 2) {
                if ((q & 3) == 0) __builtin_amdgcn_s_barrier();
                PV_COMP(q, 0, sa[0]); PV_LOAD(q + 2, 0, sa[0]); PV_COMP(q, 1, sa[1]); PV_LOAD(q + 2, 1, sa[1]);
                PV_COMP(q, 2, sa[2]); PV_LOAD(q + 2, 2, sa[2]); PV_COMP(q, 3, sa[3]); PV_LOAD(q + 2, 3, sa[3]);
                PV_COMP(q + 1, 0, sb[0]); PV_LOAD(q + 3, 0, sb[0]); PV_COMP(q + 1, 1, sb[1]); PV_LOAD(q + 3, 1, sb[1]);
                PV_COMP(q + 1, 2, sb[2]); PV_LOAD(q + 3, 2, sb[2]); PV_COMP(q + 1, 3, sb[3]); PV_LOAD(q + 3, 3, sb[3]);
            }
#undef PV_LOAD
#undef PV_COMP
        }
        {
            LAS float* OT = (LAS float*)AT;
            int l2 = lane; asm volatile("" : "+v"(l2));
            u32x2 hw[4][4]; f32x4 wf[4];
#pragma unroll
            for (int t_ = 0; t_ < 4; ++t_)
#pragma unroll
                for (int k = 0; k < 4; ++k) hw[t_][k] = *(const u32x2*)(F.HB + (size_t)(tbase + t_) * 1024 + 256 * k + 4 * l2);
#pragma unroll
            for (int k = 0; k < 4; ++k) wf[k] = *(const f32x4*)(wfin + 256 * k + 4 * l2);
#pragma unroll
            for (int t_ = 0; t_ < 4; ++t_) {
                const int tok = tbase + t_;
#pragma unroll
                for (int x_ = 0; x_ < 4; ++x_)
#pragma unroll
                    for (int r_ = 0; r_ < 4; ++r_) OT[512 * (x_ >> 1) + 32 * (4 * rw + r_) + 16 * (x_ & 1) + c] = dd[t_][x_][r_];
                f32x4 o[4]; float ss = 0.f;
#pragma unroll
                for (int k = 0; k < 4; ++k) {
                    const f32x4 ov = *(const LAS f32x4*)(OT + 256 * k + 4 * l2);
                    const u32x2 hwk = hw[t_][k];
                    o[k] = (f32x4){ov[0] * (1.0f / A8_SCALE) + bf_lo(hwk.x), ov[1] * (1.0f / A8_SCALE) + bf_hi(hwk.x), ov[2] * (1.0f / A8_SCALE) + bf_lo(hwk.y), ov[3] * (1.0f / A8_SCALE) + bf_hi(hwk.y)};
                    ss += (o[k][0] * o[k][0] + o[k][1] * o[k][1]) + (o[k][2] * o[k][2] + o[k][3] * o[k][3]);
                }
                const float rf = 1.0f / sqrtf(wave_allreduce(ss) * (1.f / D) + NORM_EPS);
#pragma unroll
                for (int k = 0; k < 4; ++k)
                    *(f32x4*)(F.out + (size_t)tok * 1024 + 256 * k + 4 * l2) = (f32x4){o[k][0] * rf * wf[k][0], o[k][1] * rf * wf[k][1], o[k][2] * rf * wf[k][2], o[k][3] * rf * wf[k][3]};
            }
        }
    }
}

#ifndef MK_N_LAUNCHES
#define MK_N_LAUNCHES 1
#endif
constexpr int N_PHASES = 10;
struct Args { const float* in[24]; float* out; unsigned char* ws; int ph_lo, ph_hi; };
__global__ void __launch_bounds__(NWAVES * 64, 2) mega_fwd(Args args) {
    extern __shared__ __attribute__((aligned(16))) unsigned char lds[];
    Frame F;
    F.lds = (LAS unsigned char*)lds;
    F.MISC = (volatile LAS unsigned*)(F.lds + MISC_OFF);
    F.tid = threadIdx.x; F.lane = F.tid & 63; F.wave = __builtin_amdgcn_readfirstlane(F.tid >> 6);
    F.G = gridDim.x; { const int bx = blockIdx.x; F.vcu = (F.G % 8 == 0) ? (bx % 8) * (F.G / 8) + bx / 8 : bx; }
    unsigned char* ws = args.ws;
    F.ctl = (gu32*)(ws + WS_CTL);
#pragma unroll
    for (int i = 0; i < 24; ++i) F.in[i] = args.in[i];
    F.out = args.out;
    F.ROPE = (float*)(ws + WS_ROPE); F.SSQ = (float*)(ws + WS_SSQ);
    F.WIN = (bf16*)(ws + WS_WIN); F.PA = (bf16*)(ws + WS_PA); F.PB = (bf16*)(ws + WS_PB); F.WOUT = (bf16*)(ws + WS_WOUT); F.WQ = (bf16*)(ws + WS_WQ); F.LW = (bf16*)(ws + WS_LW);
    F.SK = (bf16*)(ws + WS_SK); F.U8 = ws + WS_U8; F.V8 = ws + WS_V8; F.XN = (bf16*)(ws + WS_XN); F.LA = (bf16*)(ws + WS_LA); F.YA = (bf16*)(ws + WS_YA);
    F.QKV = (bf16*)(ws + WS_QKV); F.YB = (bf16*)(ws + WS_YB); F.RKV = (bf16*)(ws + WS_RKV); F.HB = (bf16*)(ws + WS_HB); F.LORA = (bf16*)(ws + WS_LORA);
    F.GA = (bf16*)(ws + WS_GA); F.GB = (bf16*)(ws + WS_GB); F.DAG = (bf16*)(ws + WS_DAG); F.QP = (bf16*)(ws + WS_QP);
    F.IDX = (int*)(ws + WS_IDX); F.GATE = (float*)(ws + WS_GATE);
    for (int u = F.tid; u < (LDS_BYTES - LDSCTL_OFF) / 4; u += NWAVES * 64) ((LAS unsigned*)(F.lds + LDSCTL_OFF))[u] = 0u;
    __syncthreads();
    XcdBarrier bar; bar.bar = (unsigned*)(F.ctl + CW_BAR); bar.x = 0; bar.st = nullptr;
    const bool multi = (args.ph_hi - args.ph_lo) > 1;
    if (multi) bar = xcd_barrier_post((unsigned*)(F.ctl + CW_BAR), F.MISC + 8);
    const int lo = args.ph_lo, hi = args.ph_hi;
#ifndef PH_MASK
#define PH_MASK 0x3ff
#endif
#define IN(k) ((((PH_MASK) >> (k)) & 1) && lo <= (k) && (k) < hi)
#define SEAM(k) do { if (IN(k) && IN((k) + 1)) xcd_barrier(bar); } while (0)
    if (IN(0)) { p0_prologue(F); if (DUP_PHASE == 0) p0_prologue(F); }
    SEAM(0);
    if (IN(1)) {
        pg8::Gemm g{F.XN, F.WIN, M, NZ, D}; pg8::StaticOrder S; S.init(M, NZ, F.G, (int)blockIdx.x);
        pg8::EpiZ E{F.QKV, F.RKV, F.LORA, F.GA, F.GB, F.ROPE, QSCALE};
        pg8::gemm_phase<pg8::EpiZ, pg8::StaticOrder, true, true>(F.lds, g, S, E);
        if (DUP_PHASE == 1) pg8::gemm_phase<pg8::EpiZ, pg8::StaticOrder, true, true>(F.lds, g, S, E);
    }
    SEAM(1);
    if (IN(2)) { attn_phase(F); lora_prep_phase(F); if (DUP_PHASE == 2) attn_phase(F); if (DUP_PHASE == 22) lora_prep_phase(F); }
    SEAM(2);
    if (IN(3)) {
#ifndef P3_NO_A
        { pg8::Gemm g{F.LA, F.LW, M, 1536, 384}; pg8::StaticOrder S; S.init(M, 1536, F.G, (int)blockIdx.x);
          pg8::EpiDAG E{F.DAG, F.in[I_W0], F.in[I_A0]};
          pg8::gemm_phase<pg8::EpiDAG, pg8::StaticOrder, true, true>(F.lds, g, S, E);
          if (DUP_PHASE == 3) pg8::gemm_phase<pg8::EpiDAG, pg8::StaticOrder, true, true>(F.lds, g, S, E); }
#endif
#ifndef P3_NO_B
        { pg8::Gemm g{F.YA, F.PA, M, 1024, 512}; pg8::StaticOrder S; S.init(M, 1024, F.G, (int)blockIdx.x);
          pg8::EpiGate<0> E{F.GA, nullptr};
          pg8::gemm_phase<pg8::EpiGate<0>, pg8::StaticOrder, true, true>(F.lds, g, S, E); }
#endif
    }
    SEAM(3);
    if (IN(4)) { scan_phase(F); if (DUP_PHASE == 4) scan_phase(F); }
    SEAM(4);
    if (IN(5)) {
        pg8::Gemm g{F.YB, F.PB, M, 1024, 512}; pg8::StaticOrder S; S.init(M, 1024, F.G, (int)blockIdx.x);
        pg8::EpiGate<1> E{F.GA, F.GB};
        pg8::gemm_phase<pg8::EpiGate<1>, pg8::StaticOrder, true, true>(F.lds, g, S, E);
    }
    SEAM(5);
    if (IN(6)) {
        pg8::Gemm g{F.GA, F.WOUT, M, 1024, 1024}; pg8::StaticOrder S; S.init(M, 1024, F.G, (int)blockIdx.x);
        pg8::EpiH E{F.in[I_X], F.out, F.HB, F.SSQ};
        pg8::gemm_phase<pg8::EpiH, pg8::StaticOrder, true, true>(F.lds, g, S, E);
    }
    SEAM(6);
    if (IN(7)) {
        pg8::Gemm g{F.HB, F.WQ, M, 1024, 1024}; pg8::StaticOrder S; S.init(M, 1024, F.G, (int)blockIdx.x);
        pg8::EpiPlain E{F.QP, 1024};
        pg8::gemm_phase<pg8::EpiPlain, pg8::StaticOrder, true, true>(F.lds, g, S, E);
        if (DUP_PHASE == 7) pg8::gemm_phase<pg8::EpiPlain, pg8::StaticOrder, true, true>(F.lds, g, S, E);
    }
    SEAM(7);
    if (IN(8)) { peer_topk_phase(F); if (DUP_PHASE == 8) peer_topk_phase(F); }
    SEAM(8);
    if (IN(9)) { F.rnd_nloc = multi ? __builtin_amdgcn_readfirstlane((int)F.MISC[8]) : 0; F.rnd_x = __builtin_amdgcn_readfirstlane((int)bar.x); peer_gather_phase(F); if (DUP_PHASE == 9) { F.rnd_nloc = 0; peer_gather_phase(F); } }
#undef IN
#undef SEAM
}

extern "C" void kernel_launch(void* const* d_in, const int* in_sizes, int n_in, void* d_out, int out_size, void* d_ws, size_t ws_size, hipStream_t stream) {
    static int grid = 0;
    if (grid == 0) {
        if (n_in != 24 || in_sizes[0] != M * D || out_size != M * D || ws_size < WS_END) { fprintf(stderr, "kernel_launch: unexpected problem (n_in %d, in0 %d, out %d, ws %zu < %zu); nothing launched\n", n_in, n_in > 0 ? in_sizes[0] : -1, out_size, ws_size, (size_t)WS_END); grid = -1; return; }
        int dev = 0, cus = 0, per_cu = 0;
        if (hipGetDevice(&dev) != hipSuccess || hipDeviceGetAttribute(&cus, hipDeviceAttributeMultiprocessorCount, dev) != hipSuccess) { fprintf(stderr, "kernel_launch: device query failed\n"); grid = -1; return; }
        if (hipFuncSetAttribute((const void*)mega_fwd, hipFuncAttributeMaxDynamicSharedMemorySize, LDS_BYTES) != hipSuccess) { fprintf(stderr, "kernel_launch: hipFuncSetAttribute failed\n"); grid = -1; return; }
        if (hipOccupancyMaxActiveBlocksPerMultiprocessor(&per_cu, (const void*)mega_fwd, NWAVES * 64, LDS_BYTES) != hipSuccess || per_cu < 1)
            fprintf(stderr, "kernel_launch: note: occupancy query reports %d workgroups per CU\n", per_cu);
        (void)hipGetLastError();
        grid = cus;
    }
    if (grid < 0) return;
    if (hipMemsetAsync((char*)d_ws + WS_CTL, 0, CTL_ZERO_BYTES, stream) != hipSuccess) { fprintf(stderr, "kernel_launch: memset failed\n"); return; }
    Args a{};
    for (int i = 0; i < 24; ++i) a.in[i] = (const float*)d_in[i];
    a.out = (float*)d_out; a.ws = (unsigned char*)d_ws;
#if MK_N_LAUNCHES == 1
    a.ph_lo = 0; a.ph_hi = N_PHASES;
    hipLaunchKernelGGL(mega_fwd, dim3(grid), dim3(NWAVES * 64), LDS_BYTES, stream, a);
#else
    for (int p = 0; p < N_PHASES; ++p) { a.ph_lo = p; a.ph_hi = p + 1; hipLaunchKernelGGL(mega_fwd, dim3(grid), dim3(NWAVES * 64), LDS_BYTES, stream, a); }
#endif
    const hipError_t le = hipPeekAtLastError();
    if (le != hipSuccess) fprintf(stderr, "kernel_launch: launch failed: %s\n", hipGetErrorName(le));
}
```

```cpp
#include <hip/hip_runtime.h>
#include <cstdio>
#include <cstdint>
namespace pg8 {
#define PG8_LAS __attribute__((address_space(3)))
typedef unsigned short bf16_t;
typedef short bf16x8 __attribute__((ext_vector_type(8)));
typedef float f32x4 __attribute__((ext_vector_type(4)));
typedef unsigned u32x4 __attribute__((ext_vector_type(4)));
constexpr int BM = 256, BK = 64, HALF = 128, HTB = HALF * BK * 2  , STAGE_BYTES = 8 * HTB, NXCD = 8, WGM = 8;

__host__ __device__ __forceinline__ int lds_byte(int r, int c) { const int st = (r >> 4) * 2 + (c >> 5), rr = r & 15, cc = c & 31, ob = rr * 64 + cc * 2; return st * 1024 + (ob ^ (((ob >> 9) & 1) << 5)); }
__host__ __device__ __forceinline__ void stage_rc(int b, int& R, int& C) { const int st = b / 1024, sb = b % 1024, swz = sb ^ (((sb >> 9) & 1) << 5); R = (st >> 1) * 16 + swz / 64; C = (st & 1) * 32 + (swz % 64) / 2; }
__host__ __device__ __forceinline__ int perm32(int rho) { const int n = rho >> 4, i = rho & 15; return 8 * (i >> 2) + 4 * n + (i & 3); }

struct Unit { int pm, pn; };
struct Gemm { const bf16_t* A; const bf16_t* Bt; int M, N, K; };

struct StaticOrder {
    int nM, nN, nwg, G, c;
    __host__ __device__ void init(int M, int N, int G_, int c_) { nM = M / BM; nN = N / BM; nwg = nM * nN; G = G_; c = c_; }
    __host__ __device__ bool next(int i, Unit& u) const {
        const long L = (long)i * G + c; if (L >= nwg) return false;
        int wgid = (int)L; { const int q = nwg / NXCD, r = nwg % NXCD, xcd = wgid % NXCD, off = wgid / NXCD; wgid = (xcd < r ? xcd * (q + 1) : r * (q + 1) + (xcd - r) * q) + off; }
        const int nig = WGM * nN, gid = wgid / nig, fm = gid * WGM, gsz = (nM - fm) < WGM ? (nM - fm) : WGM;
        u.pm = fm + ((wgid % nig) % gsz); u.pn = (wgid % nig) / gsz; return true;
    }
    __device__ __forceinline__ void a_ready(const Unit&) const {}
    __device__ __forceinline__ void done(const Unit&) const {}
};

__device__ __forceinline__ unsigned cvt_pk_bf16(float lo, float hi) { unsigned r; asm volatile("v_cvt_pk_bf16_f32 %0, %1, %2" : "=v"(r) : "v"(lo), "v"(hi)); return r; }
typedef float f32x2 __attribute__((ext_vector_type(2)));
__device__ __forceinline__ f32x2 gelu_pk(f32x2 v) {
    const f32x2 av = __builtin_elementwise_abs(v), d = av * 0.2316418882f + 1.0f;
    f32x2 t; t.x = __builtin_amdgcn_rcpf(d.x); t.y = __builtin_amdgcn_rcpf(d.y);
    f32x2 q = t * 0.5307027145f + (-0.7265760135f); q = q * t + 0.7107068705f; q = q * t + (-0.142248368f); q = q * t + 0.127414796f; q = q * t;
    const f32x2 s = (v * v) * (-0.72134752044f);
    f32x2 e; e.x = __builtin_amdgcn_exp2f(s.x); e.y = __builtin_amdgcn_exp2f(s.y);
    const f32x2 m = v * (q * e), r = v - m;
    f32x2 o; o.x = v.x < 0.f ? m.x : r.x; o.y = v.y < 0.f ? m.y : r.y; return o;
}

__device__ __forceinline__ float sigm(float x) { return __builtin_amdgcn_rcpf(1.0f + __builtin_amdgcn_exp2f(-1.4426950408889634f * x)); }
__device__ __forceinline__ u32x4 pack8(const f32x4 v0, const f32x4 v1) { u32x4 w; w.x = cvt_pk_bf16(v0[0], v0[1]); w.y = cvt_pk_bf16(v0[2], v0[3]); w.z = cvt_pk_bf16(v1[0], v1[1]); w.w = cvt_pk_bf16(v1[2], v1[3]); return w; }
__device__ __forceinline__ float bflo(unsigned w) { return __builtin_bit_cast(float, w << 16); }
__device__ __forceinline__ float bfhi(unsigned w) { return __builtin_bit_cast(float, w & 0xffff0000u); }

struct EpiZ {
    static constexpr bool PERM = true, AFTER_DRAIN = false;
    bf16_t *QKV, *RKV, *LORA, *GA, *GB; const float* cs; float qscale;
    __device__ __forceinline__ void operator()(const f32x4 (&acc)[2][2][4][2], const Unit& u, int wr, int wc, int fr, int fq) const {
        const int pn = u.pn;
        bf16_t* base; int ld, colt, mode;
        if (pn < 3)       { base = QKV;  ld = 768;  colt = pn * 256;        mode = (pn < 2) ? 1 : 2; }
        else if (pn < 9)  { base = RKV;  ld = 1536; colt = (pn - 3) * 256;  mode = 0; }
        else if (pn < 11) { base = LORA; ld = 512;  colt = (pn - 9) * 256;  mode = 0; }
        else if (pn < 15) { base = GA;   ld = 1024; colt = (pn - 11) * 256; mode = 3; }
        else              { base = GB;   ld = 1024; colt = (pn - 15) * 256; mode = 3; }
        const int row0 = u.pm * BM + wr * 64 + fr, col0 = colt + wc * 32 + 8 * fq;
        const int i0 = 16 * (wc & 1) + 4 * fq;
#pragma unroll
        for (int ai = 0; ai < 2; ++ai)
#pragma unroll
            for (int m = 0; m < 4; ++m) {
                const int row = row0 + ai * HALF + m * 16;
                bf16_t* rowp = base + (size_t)row * ld + col0;
                f32x4 c0 = (f32x4){1.f, 0.f, 1.f, 0.f}, c1 = c0;
                if (mode == 1 || mode == 2) { const f32x4* cp = (const f32x4*)(cs + ((size_t)(row & 2047) * 32 + i0) * 2); c0 = cp[0]; c1 = cp[1]; }
#pragma unroll
                for (int bj = 0; bj < 2; ++bj) {
                    f32x4 v0 = acc[ai][bj][m][0], v1 = acc[ai][bj][m][1];
                    if (mode == 1 || (mode == 2 && bj == 0)) {
                        f32x4 r0, r1;
                        r0[0] = v0[0] * c0[0] - v0[1] * c0[1]; r0[1] = v0[1] * c0[0] + v0[0] * c0[1];
                        r0[2] = v0[2] * c0[2] - v0[3] * c0[3]; r0[3] = v0[3] * c0[2] + v0[2] * c0[3];
                        r1[0] = v1[0] * c1[0] - v1[1] * c1[1]; r1[1] = v1[1] * c1[0] + v1[0] * c1[1];
                        r1[2] = v1[2] * c1[2] - v1[3] * c1[3]; r1[3] = v1[3] * c1[2] + v1[2] * c1[3];
                        if (mode == 1) { r0 = r0 * qscale; r1 = r1 * qscale; }
                        v0 = r0; v1 = r1;
                    } else if (mode == 3) {
#pragma unroll
                        for (int e = 0; e < 4; ++e) { v0[e] = sigm(v0[e]); v1[e] = sigm(v1[e]); }
                    }
                    if (base == RKV) {
                        const int j = col0 + bj * HALF, which = j >> 9, hh = (j >> 6) & 7, d = j & 63;
                        *(u32x4*)(RKV + ((size_t)(((row >> 11) * 8 + hh) * 2048 + (row & 2047))) * 192 + which * 64 + d) = pack8(v0, v1);
                    } else if (base != LORA || col0 + bj * HALF < 288)
                    *(u32x4*)(rowp + bj * HALF) = pack8(v0, v1);
                }
            }
    }
};
struct EpiDAG {
    static constexpr bool PERM = true, AFTER_DRAIN = false;
    bf16_t* DAG; const float* w0; const float* a0;
    __device__ __forceinline__ void operator()(const f32x4 (&acc)[2][2][4][2], const Unit& u, int wr, int wc, int fr, int fq) const {
        const int pn = u.pn, mode = pn >> 1;
        const int row0 = u.pm * BM + wr * 64 + fr, col0 = pn * BM + wc * 32 + 8 * fq;
#pragma unroll
        for (int bj = 0; bj < 2; ++bj) {
            f32x4 b0 = (f32x4){0.f, 0.f, 0.f, 0.f}, b1 = b0;
            if (mode == 0) { b0 = *(const f32x4*)(w0 + col0 + bj * HALF); b1 = *(const f32x4*)(w0 + col0 + bj * HALF + 4); }
            else if (mode == 1) { b0 = *(const f32x4*)(a0 + (col0 - 512) + bj * HALF); b1 = *(const f32x4*)(a0 + (col0 - 512) + bj * HALF + 4); }
            const float sc = (mode == 0) ? 0.6065306597126334f : 1.0f;
#pragma unroll
            for (int ai = 0; ai < 2; ++ai)
#pragma unroll
                for (int m = 0; m < 4; ++m) {
                    const int row = row0 + ai * HALF + m * 16, j = col0 + bj * HALF;
                    bf16_t* rowp = DAG + ((size_t)(((row >> 11) * 8 + ((j >> 6) & 7)) * 2048 + (row & 2047))) * 192 + (j >> 9) * 64 + (j & 63);
                    f32x4 v0 = acc[ai][bj][m][0] + b0, v1 = acc[ai][bj][m][1] + b1;
                    if (mode < 2) {
#pragma unroll
                        for (int e = 0; e < 4; ++e) { v0[e] = sigm(v0[e]) * sc; v1[e] = sigm(v1[e]) * sc; }
                    }
                    *(u32x4*)rowp = pack8(v0, v1);
                    asm volatile("" ::: "memory");
                }
        }
    }
};
template <int SECOND> struct EpiGate {
    static constexpr bool PERM = true, AFTER_DRAIN = false;
    bf16_t* G; const bf16_t* G2;
    __device__ __forceinline__ void operator()(const f32x4 (&acc)[2][2][4][2], const Unit& u, int wr, int wc, int fr, int fq) const {
        const int row0 = u.pm * BM + wr * 64 + fr, col0 = u.pn * BM + wc * 32 + 8 * fq;
#pragma unroll
        for (int ai = 0; ai < 2; ++ai) {
            u32x4 gq[4][2], hq[4][2];
#pragma unroll
            for (int m = 0; m < 4; ++m)
#pragma unroll
                for (int bj = 0; bj < 2; ++bj) {
                    const size_t off = (size_t)(row0 + ai * HALF + m * 16) * 1024 + col0 + bj * HALF;
                    gq[m][bj] = *(const u32x4*)(G + off);
                    if (SECOND) hq[m][bj] = *(const u32x4*)(G2 + off);
                }
#pragma unroll
            for (int m = 0; m < 4; ++m) {
                const size_t off = (size_t)(row0 + ai * HALF + m * 16) * 1024 + col0;
#pragma unroll
                for (int bj = 0; bj < 2; ++bj) {
                    const u32x4 g = gq[m][bj];
                    f32x4 v0 = acc[ai][bj][m][0], v1 = acc[ai][bj][m][1];
                    if (SECOND) {
                        const u32x4 h = hq[m][bj];
                        v0[0] = bflo(g.x) + bflo(h.x) * v0[0]; v0[1] = bfhi(g.x) + bfhi(h.x) * v0[1]; v0[2] = bflo(g.y) + bflo(h.y) * v0[2]; v0[3] = bfhi(g.y) + bfhi(h.y) * v0[3];
                        v1[0] = bflo(g.z) + bflo(h.z) * v1[0]; v1[1] = bfhi(g.z) + bfhi(h.z) * v1[1]; v1[2] = bflo(g.w) + bflo(h.w) * v1[2]; v1[3] = bfhi(g.w) + bfhi(h.w) * v1[3];
                    } else {
                        v0[0] *= bflo(g.x); v0[1] *= bfhi(g.x); v0[2] *= bflo(g.y); v0[3] *= bfhi(g.y);
                        v1[0] *= bflo(g.z); v1[1] *= bfhi(g.z); v1[2] *= bflo(g.w); v1[3] *= bfhi(g.w);
                    }
                    *(u32x4*)(G + off + bj * HALF) = pack8(v0, v1);
                }
            }
        }
    }
};
struct EpiH {
    static constexpr bool PERM = true, AFTER_DRAIN = false;
    const float* X; float* Hf; bf16_t* HB; float* ssq;
    __device__ __forceinline__ void operator()(const f32x4 (&acc)[2][2][4][2], const Unit& u, int wr, int wc, int fr, int fq) const {
        const int row0 = u.pm * BM + wr * 64 + fr, col0 = u.pn * BM + wc * 32 + 8 * fq;
#pragma unroll
        for (int ai = 0; ai < 2; ++ai) {
            f32x4 xv[4][2][2];
#pragma unroll
            for (int m = 0; m < 4; ++m)
#pragma unroll
                for (int bj = 0; bj < 2; ++bj) {
                    const float* xp = X + (size_t)(row0 + ai * HALF + m * 16) * 1024 + col0 + bj * HALF;
                    xv[m][bj][0] = *(const f32x4*)xp; xv[m][bj][1] = *(const f32x4*)(xp + 4);
                }
#pragma unroll
            for (int m = 0; m < 4; ++m) {
                const int row = row0 + ai * HALF + m * 16;
                const size_t off = (size_t)row * 1024 + col0;
                float s = 0.f;
#pragma unroll
                for (int bj = 0; bj < 2; ++bj) {
#ifdef DBG_NO_MIX
                    const f32x4 v0 = xv[m][bj][0], v1 = xv[m][bj][1];
#else
                    const f32x4 v0 = acc[ai][bj][m][0] + xv[m][bj][0], v1 = acc[ai][bj][m][1] + xv[m][bj][1];
#endif
                    *(u32x4*)(HB + off + bj * HALF) = pack8(v0, v1);
                    s += (v0[0] * v0[0] + v0[1] * v0[1]) + (v0[2] * v0[2] + v0[3] * v0[3]) + (v1[0] * v1[0] + v1[1] * v1[1]) + (v1[2] * v1[2] + v1[3] * v1[3]);
                }
                s += __shfl_xor(s, 16); s += __shfl_xor(s, 32);
                if (fq == 0) unsafeAtomicAdd(ssq + row, s);
            }
        }
    }
};
struct EpiPlain {
    static constexpr bool PERM = true, AFTER_DRAIN = false;
    bf16_t* O; int ldc;
    __device__ __forceinline__ void operator()(const f32x4 (&acc)[2][2][4][2], const Unit& u, int wr, int wc, int fr, int fq) const {
        const int row0 = u.pm * BM + wr * 64 + fr, col0 = u.pn * BM + wc * 32 + 8 * fq;
#pragma unroll
        for (int ai = 0; ai < 2; ++ai)
#pragma unroll
            for (int m = 0; m < 4; ++m) { bf16_t* rowp = O + (size_t)(row0 + ai * HALF + m * 16) * ldc + col0;
#pragma unroll
                for (int bj = 0; bj < 2; ++bj) *(u32x4*)(rowp + bj * HALF) = pack8(acc[ai][bj][m][0], acc[ai][bj][m][1]); }
    }
};

template <class Epi, class Sched, bool ALIGN_EPI = false, bool SP2 = false>
__device__ __forceinline__ void gemm_phase(PG8_LAS unsigned char* lds, const Gemm g, const Sched& S, const Epi& E) {
    const int tid = threadIdx.x, wid = __builtin_amdgcn_readfirstlane(tid >> 6), lane = tid & 63, wr = wid >> 2, wc = wid & 3, fr = lane & 15, fq = lane >> 4;
    const int K = g.K, nt = K / BK;
    unsigned voffA[2], voffB[2];
#pragma unroll
    for (int i = 0; i < 2; ++i) { int R, C; stage_rc(tid * 16 + i * 8192, R, C); const int Rb = Epi::PERM ? ((R & ~31) + perm32(R & 31)) : R;
        voffA[i] = (unsigned)(R * K + C) * 2u; voffB[i] = (unsigned)(Rb * K + C) * 2u; }
    const size_t kstep = (size_t)(BK * 2);
    const size_t hstep = (size_t)HALF * K * 2;
    const size_t tstep = 2 * hstep;
    const unsigned ldsw = (unsigned)wid * 1024u;
    const int aoff = lds_byte(wr * 64 + fr, fq * 8), boff = lds_byte(wc * 32 + fr, fq * 8);
#define PG8_SA(b, h) (((b) * 2 + (h)) * HTB)
#define PG8_SB(b, h) ((4 + (b) * 2 + (h)) * HTB)
#define PG8_STAGE(bufoff, gbase, voff) do { _Pragma("unroll") for (int _i = 0; _i < 2; ++_i) \
        __builtin_amdgcn_global_load_lds((const unsigned*)((const char*)(gbase) + (voff)[_i]), (PG8_LAS unsigned*)(lds + (bufoff) + ldsw + _i * 8192), 16, 0, 0); } while (0)
#define PG8_LDA(dst, b, h) do { _Pragma("unroll") for (int m = 0; m < 4; ++m) _Pragma("unroll") for (int k = 0; k < 2; ++k) dst[m][k] = *(const PG8_LAS bf16x8*)(lds + PG8_SA(b, h) + aoff + m * 2048 + k * 1024); } while (0)
#define PG8_LDB(dst, b, h) do { _Pragma("unroll") for (int n = 0; n < 2; ++n) _Pragma("unroll") for (int k = 0; k < 2; ++k) dst[n][k] = *(const PG8_LAS bf16x8*)(lds + PG8_SB(b, h) + boff + n * 2048 + k * 1024); } while (0)
#define PG8_MMA(ai, bj, At, Bt) do { __builtin_amdgcn_s_setprio(1); _Pragma("unroll") for (int m = 0; m < 4; ++m) _Pragma("unroll") for (int n = 0; n < 2; ++n) _Pragma("unroll") for (int k = 0; k < 2; ++k) \
        acc[ai][bj][m][n] = __builtin_amdgcn_mfma_f32_16x16x32_bf16(Bt[n][k], At[m][k], acc[ai][bj][m][n], 0, 0, 0); __builtin_amdgcn_s_setprio(0); } while (0)
#define PG8_WAIT_V(n) asm volatile("s_waitcnt vmcnt(" #n ")" ::: "memory")
#define PG8_WAIT_L(n) asm volatile("s_waitcnt lgkmcnt(" #n ")" ::: "memory")
#define PG8_BAR __builtin_amdgcn_s_barrier()
#define PG8_SCHED __builtin_amdgcn_sched_barrier(0)
    Unit cur, nxt; int ui = 0;
    if (!S.next(0, cur)) return;
    f32x4 acc[2][2][4][2];
#pragma unroll
    for (int a = 0; a < 2; ++a)
#pragma unroll
        for (int b = 0; b < 2; ++b)
#pragma unroll
            for (int m = 0; m < 4; ++m)
#pragma unroll
                for (int n = 0; n < 2; ++n) acc[a][b][m][n] = (f32x4){0.f, 0.f, 0.f, 0.f};
    bf16x8 At[4][2], B0[2][2], B1[2][2];
    const char* cA = (const char*)g.A + (size_t)cur.pm * tstep; const char* cB = (const char*)g.Bt + (size_t)cur.pn * tstep;
    S.a_ready(cur);
    if constexpr (SP2) {
        PG8_STAGE(PG8_SB(0, 0), cB, voffB); PG8_STAGE(PG8_SB(0, 1), cB + hstep, voffB); PG8_STAGE(PG8_SA(0, 0), cA, voffA); PG8_STAGE(PG8_SA(0, 1), cA + hstep, voffA);
        if (wr == 1) PG8_BAR;
        PG8_WAIT_V(2); PG8_BAR;
        PG8_STAGE(PG8_SB(1, 0), cB + kstep, voffB); PG8_STAGE(PG8_SA(1, 0), cA + kstep, voffA); PG8_STAGE(PG8_SB(1, 1), cB + hstep + kstep, voffB);
        PG8_WAIT_V(6); PG8_BAR;
    } else {
        PG8_STAGE(PG8_SB(0, 0), cB, voffB); PG8_STAGE(PG8_SA(0, 0), cA, voffA); PG8_STAGE(PG8_SB(0, 1), cB + hstep, voffB); PG8_STAGE(PG8_SA(0, 1), cA + hstep, voffA);
        if (wr == 1) PG8_BAR;
        PG8_WAIT_V(4); PG8_BAR;
        PG8_STAGE(PG8_SB(1, 0), cB + kstep, voffB); PG8_STAGE(PG8_SA(1, 0), cA + kstep, voffA); PG8_STAGE(PG8_SB(1, 1), cB + hstep + kstep, voffB);
        PG8_WAIT_V(6); PG8_BAR;
    }
    for (;;) {
        const bool has_next = S.next(ui + 1, nxt);
        const char* nA = has_next ? (const char*)g.A + (size_t)nxt.pm * tstep : cA; const char* nB = has_next ? (const char*)g.Bt + (size_t)nxt.pn * tstep : cB;
#pragma unroll 1
        for (int t = 0; t < nt; t += 2) {
            const bool last = (t == nt - 2);
            const char* a1 = cA + (size_t)(t + 1) * kstep;
            const char* a2 = last ? nA : cA + (size_t)(t + 2) * kstep; const char* b2 = last ? nB : cB + (size_t)(t + 2) * kstep;
            const char* a3 = a2 + kstep; const char* b3 = b2 + kstep;
            if (last && has_next) S.a_ready(nxt);
            if constexpr (SP2) {
            PG8_LDB(B0, 0, 0); PG8_LDB(B1, 0, 1); PG8_SCHED; PG8_LDA(At, 0, 0); PG8_STAGE(PG8_SA(1, 1), a1 + hstep, voffA);
            PG8_WAIT_V(8); PG8_WAIT_L(0); PG8_BAR; PG8_MMA(0, 0, At, B0); PG8_MMA(0, 1, At, B1); PG8_BAR; PG8_SCHED;
            PG8_LDA(At, 0, 1); PG8_STAGE(PG8_SB(0, 0), b2, voffB); PG8_STAGE(PG8_SB(0, 1), b2 + hstep, voffB); PG8_STAGE(PG8_SA(0, 0), a2, voffA);
            PG8_WAIT_V(8); PG8_WAIT_L(0); PG8_BAR; PG8_MMA(1, 0, At, B0); PG8_MMA(1, 1, At, B1); PG8_BAR; PG8_SCHED;
            PG8_LDB(B0, 1, 0); PG8_LDB(B1, 1, 1); PG8_SCHED; PG8_LDA(At, 1, 0); PG8_STAGE(PG8_SA(0, 1), a2 + hstep, voffA);
            PG8_WAIT_V(8); PG8_WAIT_L(0); PG8_BAR; PG8_MMA(0, 0, At, B0); PG8_MMA(0, 1, At, B1); PG8_BAR; PG8_SCHED;
            PG8_LDA(At, 1, 1); PG8_STAGE(PG8_SB(1, 0), b3, voffB); PG8_STAGE(PG8_SB(1, 1), b3 + hstep, voffB); PG8_STAGE(PG8_SA(1, 0), a3, voffA);
            PG8_WAIT_V(8); PG8_WAIT_L(0); PG8_BAR; PG8_MMA(1, 0, At, B0); PG8_MMA(1, 1, At, B1); PG8_BAR; PG8_SCHED;
            } else {
            PG8_LDB(B0, 0, 0); PG8_SCHED; PG8_LDA(At, 0, 0); PG8_STAGE(PG8_SA(1, 1), a1 + hstep, voffA);
            PG8_WAIT_L(8); PG8_BAR; PG8_WAIT_L(0); PG8_MMA(0, 0, At, B0); PG8_BAR; PG8_SCHED;
            PG8_LDB(B1, 0, 1); PG8_STAGE(PG8_SB(0, 0), b2, voffB);
            PG8_BAR; PG8_WAIT_L(0); PG8_MMA(0, 1, At, B1); PG8_BAR;
            PG8_LDA(At, 0, 1); PG8_STAGE(PG8_SA(0, 0), a2, voffA);
            PG8_BAR; PG8_WAIT_L(0); PG8_MMA(1, 0, At, B0); PG8_BAR; PG8_SCHED;
            PG8_STAGE(PG8_SB(0, 1), b2 + hstep, voffB);
            PG8_WAIT_V(6); PG8_BAR; PG8_MMA(1, 1, At, B1); PG8_BAR;
            PG8_LDB(B0, 1, 0); PG8_SCHED; PG8_LDA(At, 1, 0); PG8_STAGE(PG8_SA(0, 1), a2 + hstep, voffA);
            PG8_WAIT_L(8); PG8_BAR; PG8_WAIT_L(0); PG8_MMA(0, 0, At, B0); PG8_BAR; PG8_SCHED;
            PG8_LDB(B1, 1, 1); PG8_STAGE(PG8_SB(1, 0), b3, voffB);
            PG8_BAR; PG8_WAIT_L(0); PG8_MMA(0, 1, At, B1); PG8_BAR;
            PG8_LDA(At, 1, 1); PG8_STAGE(PG8_SA(1, 0), a3, voffA);
            PG8_BAR; PG8_WAIT_L(0); PG8_MMA(1, 0, At, B0); PG8_BAR; PG8_SCHED;
            PG8_STAGE(PG8_SB(1, 1), b3 + hstep, voffB);
            PG8_WAIT_V(6); PG8_BAR; PG8_MMA(1, 1, At, B1); PG8_BAR;
            }
        }
        if constexpr (ALIGN_EPI) { if (wr == 0) PG8_BAR; }
        if constexpr (!Epi::AFTER_DRAIN) { E(acc, cur, wr, wc, fr, fq); S.done(cur); }
        if (!has_next) break;
#pragma unroll
        for (int a = 0; a < 2; ++a)
#pragma unroll
            for (int b = 0; b < 2; ++b)
#pragma unroll
                for (int m = 0; m < 4; ++m)
#pragma unroll
                    for (int n = 0; n < 2; ++n) acc[a][b][m][n] = (f32x4){0.f, 0.f, 0.f, 0.f};
        cur = nxt; cA = nA; cB = nB; ++ui;
        if constexpr (ALIGN_EPI) { if (wr == 1) PG8_BAR; }
    }
    PG8_WAIT_V(0);
    if constexpr (!ALIGN_EPI) { if (wr == 0) PG8_BAR; }
    PG8_BAR;
    if constexpr (Epi::AFTER_DRAIN) { E.fused(acc, cur, wr, wc, fr, fq, lds, wid, lane); S.done(cur); }
#undef PG8_SA
#undef PG8_SB
#undef PG8_STAGE
#undef PG8_LDA
#undef PG8_LDB
#undef PG8_MMA
#undef PG8_WAIT_V
#undef PG8_WAIT_L
#undef PG8_BAR
#undef PG8_SCHED
}
}
#define GAS __attribute__((address_space(1)))
#define LAS __attribute__((address_space(3)))
typedef unsigned short bf16;
typedef unsigned v4u __attribute__((ext_vector_type(4)));
typedef float f32x4 __attribute__((ext_vector_type(4)));
typedef short bf16x8 __attribute__((ext_vector_type(8)));
typedef GAS unsigned gu32;
typedef GAS unsigned long long gu64;
#define RLX_AGENT __ATOMIC_RELAXED, __HIP_MEMORY_SCOPE_AGENT
#define LDS_WAIT() asm volatile("s_waitcnt lgkmcnt(0)" ::: "memory")
#define VM_WAIT() asm volatile("s_waitcnt vmcnt(0)" ::: "memory")
__device__ __forceinline__ unsigned long long rt() { return __builtin_amdgcn_s_memrealtime(); }
__device__ __forceinline__ unsigned f2bf(float f) { unsigned u = __builtin_bit_cast(unsigned, f); return (u + 0x7fffu + ((u >> 16) & 1u)) >> 16; }
__device__ __forceinline__ unsigned pk2(float lo, float hi) { return f2bf(lo) | (f2bf(hi) << 16); }

#define XB_TMO      128
#define XB_XCNT(j)  (256  + 64 * (j))
#define XB_XSUB(j)  (1280 + 64 * (j))
#define XB_XGEN(j)  (2304 + 64 * (j))
#define XB_TOP      3328
#define XB_TOPGEN   3392
#define XCD_BAR_WORDS 3456
#define XB_SPIN_CAP (1u << 22)

__device__ __forceinline__ unsigned xb_ld(unsigned* p)              { return __hip_atomic_load(p, __ATOMIC_RELAXED, __HIP_MEMORY_SCOPE_AGENT); }
__device__ __forceinline__ unsigned xb_add(unsigned* p, unsigned v) { return __hip_atomic_fetch_add(p, v, __ATOMIC_RELAXED, __HIP_MEMORY_SCOPE_AGENT); }
__device__ __forceinline__ unsigned xb_xcc_id() { return (unsigned)__builtin_amdgcn_s_getreg((3 << 11) | 20) & 0xFu; }
#define XB_SPIN(cond, bar) do { unsigned _sp = 0; while (cond) { __builtin_amdgcn_s_sleep(1); \
    if ((++_sp & 255u) == 0u) { if (xb_ld(&(bar)[XB_TMO])) break; if (_sp > XB_SPIN_CAP) { atomicAdd(&(bar)[XB_TMO], 1u); break; } } } } while (0)

struct XcdBarrier {
    unsigned* bar; unsigned x;
    volatile LAS unsigned* st;
};

__device__ __forceinline__ XcdBarrier xcd_barrier_post(unsigned* bar, volatile LAS unsigned* st) {
    XcdBarrier b; b.bar = bar; b.x = xb_xcc_id(); b.st = st;
    if (threadIdx.x == 0) (void)xb_add(&bar[XB_XCNT(b.x)], 1u);
    return b;
}
__device__ __forceinline__ void xcd_barrier_complete(unsigned* bar, unsigned x, unsigned& nloc, unsigned& nx) {
    const unsigned G = gridDim.x * gridDim.y * gridDim.z;
    unsigned sum, cnt, mine, sp = 0u;
    for (;;) {
        sum = 0u; cnt = 0u; mine = 0u;
#pragma unroll
        for (unsigned j = 0; j < 16; ++j) { const unsigned c = xb_ld(&bar[XB_XCNT(j)]); sum += c; cnt += (c > 0u) ? 1u : 0u; mine = (j == x) ? c : mine; }
        if (sum == G) break;
        __builtin_amdgcn_s_sleep(1);
        if ((++sp & 255u) == 0u) { if (xb_ld(&bar[XB_TMO])) break; if (sp > XB_SPIN_CAP) { atomicAdd(&bar[XB_TMO], 1u); break; } }
    }
    nloc = mine > 0u ? mine : 1u; nx = cnt > 0u ? cnt : 1u;
}

__device__ __forceinline__ void xcd_barrier(const XcdBarrier& b) {
    asm volatile("s_waitcnt vmcnt(0)" ::: "memory");
    __syncthreads();
    if (threadIdx.x == 0) {
        unsigned* bar = b.bar;
        __builtin_amdgcn_s_waitcnt(0);
        unsigned nloc = b.st[0], nx = b.st[1];
        if (nloc == 0u) { xcd_barrier_complete(bar, b.x, nloc, nx); b.st[0] = nloc; b.st[1] = nx; }
        const unsigned old = xb_add(&bar[XB_XSUB(b.x)], 1u);
        const unsigned gen = old / nloc;
        if (old + 1u == (gen + 1u) * nloc) {
            __builtin_amdgcn_fence(__ATOMIC_RELEASE, "agent");
            asm volatile("s_waitcnt vmcnt(0)" ::: "memory");
            const unsigned og = xb_add(&bar[XB_TOP], 1u);
            const unsigned tg = og / nx;
            if (og + 1u == (tg + 1u) * nx) xb_add(&bar[XB_TOPGEN], 1u);
            else XB_SPIN(xb_ld(&bar[XB_TOPGEN]) == tg, bar);
            __builtin_amdgcn_fence(__ATOMIC_ACQUIRE, "agent");
            xb_add(&bar[XB_XGEN(b.x)], 1u);
            asm volatile("s_waitcnt vmcnt(0)" ::: "memory");
        } else {
            XB_SPIN(xb_ld(&bar[XB_XGEN(b.x)]) == gen, bar);
            __builtin_amdgcn_fence(__ATOMIC_ACQUIRE, "agent");
            asm volatile("s_waitcnt vmcnt(0)" ::: "memory");
        }
    }
    __syncthreads();
}

#ifndef DUP_PHASE
#define DUP_PHASE -1
#endif
constexpr int NWAVES = 8;
constexpr int BATCH = 32, SEQ = 2048, D = 1024, M = BATCH * SEQ;
constexpr int IN_COLS = 4640, NZ = 4864;
constexpr int NEXP = 16384;
constexpr float NORM_EPS = 1e-5f, GN_EPS = 64e-5f, LOG2E = 1.4426950408889634f;
constexpr float QSCALE = 0.125f * LOG2E;
constexpr float U6_SCALE = 64.0f, V6_SCALE = 5.656854249f, H8_SCALE = 16.0f, A8_SCALE = 64.0f;
#ifndef U_FP4
#define U_FP4 1
#endif
#ifndef V_FP4
#define V_FP4 1
#endif
constexpr int U_ROW = U_FP4 ? 512 : 768, V_ROW = V_FP4 ? 512 : 768;

constexpr size_t MiB = 1u << 20;
constexpr size_t WS_CTL = 0, CTL_ZERO_BYTES = 64 * 1024;
constexpr size_t WS_ROPE = 1 * MiB;
constexpr size_t WS_SSQ = 1 * MiB + 512 * 1024;
constexpr size_t WS_WIN = 2 * MiB;
constexpr size_t WS_PA = 12 * MiB, WS_PB = 13 * MiB, WS_WOUT = 14 * MiB, WS_WQ = 16 * MiB, WS_LW = 18 * MiB;
constexpr size_t WS_SK = 19 * MiB + 512 * 1024;
constexpr size_t WS_U8 = 20 * MiB, WS_V8 = 36 * MiB;
constexpr size_t WS_XN = 84 * MiB;
constexpr size_t WS_LA = 84 * MiB;
constexpr size_t WS_YA = 132 * MiB;
constexpr size_t WS_IDX = 84 * MiB, WS_GATE = 116 * MiB;
constexpr size_t WS_QKV = 212 * MiB;
constexpr size_t WS_YB = 212 * MiB;
constexpr size_t WS_RKV = 308 * MiB;
constexpr size_t WS_HB = 308 * MiB;
constexpr size_t WS_LORA = 500 * MiB;
constexpr size_t WS_GA = 564 * MiB, WS_GB = 692 * MiB;
constexpr size_t WS_DAG = 820 * MiB;
constexpr size_t WS_QP = 820 * MiB;
constexpr size_t WS_END = 1012 * MiB;
constexpr int CW_BAR = 4096, CW_RND = 8192;

constexpr int RING_BYTES = 131072;
constexpr int LDSCTL_OFF = RING_BYTES, MISC_OFF = LDSCTL_OFF + 320;
constexpr int LDS_BYTES = 147456;

typedef float f32x2 __attribute__((ext_vector_type(2)));
typedef float f32x16 __attribute__((ext_vector_type(16)));
typedef unsigned u32x2 __attribute__((ext_vector_type(2)));
typedef __bf16 bf16x2_t __attribute__((ext_vector_type(2)));
typedef float v16f __attribute__((ext_vector_type(16)));
typedef float v32f __attribute__((ext_vector_type(32)));
typedef unsigned v6u __attribute__((ext_vector_type(6)));

__device__ __forceinline__ float bf2f(unsigned b) { return __builtin_bit_cast(float, b << 16); }
__device__ __forceinline__ float bf_lo(unsigned w) { return __builtin_bit_cast(float, w << 16); }
__device__ __forceinline__ float bf_hi(unsigned w) { return __builtin_bit_cast(float, w & 0xffff0000u); }
template <int CTRL> __device__ __forceinline__ float dppf(float x) { return __builtin_bit_cast(float, __builtin_amdgcn_update_dpp(0, __builtin_bit_cast(int, x), CTRL, 0xF, 0xF, true)); }
__device__ __forceinline__ float allreduce16(float x) { x += dppf<0xB1>(x); x += dppf<0x4E>(x); x += dppf<0x141>(x); x += dppf<0x140>(x); return x; }
__device__ __forceinline__ float wave_sum(float v) {
#pragma unroll
    for (int o = 1; o < 64; o <<= 1) v += __shfl_xor(v, o);
    return v;
}
__device__ __forceinline__ bf16x2_t as_bf2(unsigned w) { return __builtin_bit_cast(bf16x2_t, w); }
__device__ __forceinline__ float u2f(unsigned w) { return __builtin_bit_cast(float, w); }
__device__ __forceinline__ unsigned f2u(float f) { return __builtin_bit_cast(unsigned, f); }
__device__ __forceinline__ float wave_allreduce(float x) {
    x = allreduce16(x);
    { const auto r = __builtin_amdgcn_permlane16_swap(f2u(x), f2u(x), false, false); const unsigned a = r[0], b = r[1]; x = u2f(a) + u2f(b); }
    { const auto r = __builtin_amdgcn_permlane32_swap(f2u(x), f2u(x), false, false); const unsigned a = r[0], b = r[1]; x = u2f(a) + u2f(b); }
    return x;
}
__device__ __forceinline__ float gelu_erf(float v) {
    const float av = __builtin_fabsf(v), t = __builtin_amdgcn_rcpf(av * 0.2316418882f + 1.0f);
    float q = t * 0.5307027145f + (-0.7265760135f); q = q * t + 0.7107068705f; q = q * t + (-0.142248368f); q = q * t + 0.127414796f; q = q * t;
    const float e = __builtin_amdgcn_exp2f((v * v) * (-0.72134752044f));
    const float m = v * (q * e);
    return v < 0.f ? m : v - m;
}

__device__ __forceinline__ float sfma(float a, float b, float c) { float d; asm("v_fma_f32 %0, %1, %2, %3" : "=v"(d) : "v"(a), "v"(b), "v"(c)); return d; }
__device__ __forceinline__ float smul(float a, float b) { float d; asm("v_mul_f32 %0, %1, %2" : "=v"(d) : "v"(a), "v"(b)); return d; }
__device__ __forceinline__ v6u pack_fp6(const v16f x, const v16f y) { v6u p = __builtin_amdgcn_cvt_scalef32_2xpk16_fp6_f32(x, y, 1.0f); asm volatile("" : "+v"(p) : "v"(x), "v"(y)); return p; }
__device__ __forceinline__ v32f unpack_fp6(const v6u p) { const v32f f = __builtin_amdgcn_cvt_scalef32_pk32_f32_fp6(p, 1.0f); asm volatile("" :: "v"(p)); return f; }
struct Frame {
    LAS unsigned char* lds;
    volatile LAS unsigned* MISC;
    gu32* ctl;
    int tid, lane, wave, vcu, G, rnd_nloc, rnd_x;
    const float* in[24]; float* out;
    float *ROPE, *SSQ;
    bf16 *WIN, *PA, *PB, *WOUT, *WQ, *LW, *SK, *XN, *LA, *YA, *QKV, *YB, *RKV, *HB, *LORA, *GA, *GB, *DAG, *QP;
    int* IDX; float* GATE; unsigned char *U8, *V8;
};
enum { I_X = 0, I_NMW, I_WIN, I_MU, I_SINK, I_W0, I_W2, I_A0, I_A2, I_G2, I_KK, I_KA, I_RK, I_LNW, I_LNB, I_PA, I_PB, I_WOUT, I_NFW, I_WQ, I_SUBK, I_U, I_V, I_NFINAL };

struct SrcWin { const float* w; __device__ __forceinline__ float operator()(int k, int n) const {
    int src;
    if (n < 640) { const int hd = n >> 6, j = n & 63; src = hd * 64 + ((j & 1) ? 32 + (j >> 1) : (j >> 1)); }
    else if (n < 2592) src = n;
    else if (n < 2816) return 0.f;
    else src = n - 224;
    return w[(size_t)k * IN_COLS + src]; } };
struct SrcPlain { const float* w; int N; __device__ __forceinline__ float operator()(int k, int n) const { return w[(size_t)k * N + n]; } };
struct SrcWq { const float* w; const float* s; __device__ __forceinline__ float operator()(int k, int n) const { return w[(size_t)k * 1024 + n] * s[k]; } };
struct SrcLora { const float *w2, *a2, *g2; __device__ __forceinline__ float operator()(int k, int n) const {
    if (n < 512) return k < 64 ? w2[k * 512 + n] : 0.f;
    if (n < 1024) return (k >= 64 && k < 128) ? a2[(k - 64) * 512 + (n - 512)] : 0.f;
    return (k >= 128 && k < 288) ? g2[(k - 128) * 512 + (n - 1024)] : 0.f; } };
template <int N, int K, class F_> __device__ __forceinline__ void transpose_w(bf16* dst, const F_& f, int gtid, int nthr) {
#pragma unroll 1
    for (int id = gtid; id < N * (K / 8); id += 2 * nthr) {
        const int id2 = id + nthr; const bool has2 = id2 < N * (K / 8);
        const int n = id % N, k0 = (id / N) * 8, n2 = (has2 ? id2 : id) % N, k2 = ((has2 ? id2 : id) / N) * 8;
        float v[8], w[8];
#pragma unroll
        for (int j = 0; j < 8; ++j) { v[j] = f(k0 + j, n); w[j] = f(k2 + j, n2); }
        v4u o; o.x = pk2(v[0], v[1]); o.y = pk2(v[2], v[3]); o.z = pk2(v[4], v[5]); o.w = pk2(v[6], v[7]);
        *(v4u*)(dst + (size_t)n * K + k0) = o;
        if (has2) { v4u p; p.x = pk2(w[0], w[1]); p.y = pk2(w[2], w[3]); p.z = pk2(w[4], w[5]); p.w = pk2(w[6], w[7]); *(v4u*)(dst + (size_t)n2 * K + k2) = p; }
    }
}
__device__ __forceinline__ void p0_prologue(Frame& F) {
    const int gtid = F.vcu * (NWAVES * 64) + F.tid, nthr = F.G * NWAVES * 64;
    const int gw = F.vcu * NWAVES + F.wave, NGW = F.G * NWAVES;
    transpose_w<NZ, 1024>(F.WIN, SrcWin{F.in[I_WIN]}, gtid, nthr);
    transpose_w<1024, 512>(F.PA, SrcPlain{F.in[I_PA], 1024}, gtid, nthr);
    transpose_w<1024, 512>(F.PB, SrcPlain{F.in[I_PB], 1024}, gtid, nthr);
    transpose_w<1024, 1024>(F.WOUT, SrcPlain{F.in[I_WOUT], 1024}, gtid, nthr);
    transpose_w<1024, 1024>(F.WQ, SrcWq{F.in[I_WQ], F.in[I_NFW]}, gtid, nthr);
    transpose_w<1536, 384>(F.LW, SrcLora{F.in[I_W2], F.in[I_A2], F.in[I_G2]}, gtid, nthr);
    for (int id = gtid; id < 16 * 128 * 64 / 8; id += nthr) {
        const f32x4 a = *(const f32x4*)(F.in[I_SUBK] + (size_t)id * 8), b = *(const f32x4*)(F.in[I_SUBK] + (size_t)id * 8 + 4);
        v4u o; o.x = pk2(a[0], a[1]); o.y = pk2(a[2], a[3]); o.z = pk2(b[0], b[1]); o.w = pk2(b[2], b[3]);
        *(v4u*)(F.SK + (size_t)id * 8) = o;
    }
    for (int id = gtid; id < NEXP * 32; id += nthr) {
        const int e = id >> 5, c = (id >> 1) & 15, g = id & 1;
        const size_t eb = (size_t)e * 1024 + c * 64 + g * 32;
        const float* wn = F.in[I_NFW] + c * 64 + g * 32;
        v16f ux, uy, vx_, vy_;
#pragma unroll
        for (int j = 0; j < 8; ++j) {
            const f32x4 a0 = *(const f32x4*)(F.in[I_U] + eb + 4 * j) * *(const f32x4*)(wn + 4 * j) * U6_SCALE;
            const f32x4 b0 = *(const f32x4*)(F.in[I_V] + eb + 4 * j) * V6_SCALE;
            ux[2 * j] = a0[0]; uy[2 * j] = a0[1]; ux[2 * j + 1] = a0[2]; uy[2 * j + 1] = a0[3];
            vx_[2 * j] = b0[0]; vy_[2 * j] = b0[1]; vx_[2 * j + 1] = b0[2]; vy_[2 * j + 1] = b0[3];
        }
        const int G = 2 * c + g;
#if U_FP4
        {
            v4u pk;
            { unsigned w = 0; w = __builtin_amdgcn_cvt_scalef32_pk_fp4_f32(w, ux[0], uy[0], 1.0f, 0); w = __builtin_amdgcn_cvt_scalef32_pk_fp4_f32(w, ux[1], uy[1], 1.0f, 1); w = __builtin_amdgcn_cvt_scalef32_pk_fp4_f32(w, ux[2], uy[2], 1.0f, 2); w = __builtin_amdgcn_cvt_scalef32_pk_fp4_f32(w, ux[3], uy[3], 1.0f, 3); pk.x = w; }
            { unsigned w = 0; w = __builtin_amdgcn_cvt_scalef32_pk_fp4_f32(w, ux[4], uy[4], 1.0f, 0); w = __builtin_amdgcn_cvt_scalef32_pk_fp4_f32(w, ux[5], uy[5], 1.0f, 1); w = __builtin_amdgcn_cvt_scalef32_pk_fp4_f32(w, ux[6], uy[6], 1.0f, 2); w = __builtin_amdgcn_cvt_scalef32_pk_fp4_f32(w, ux[7], uy[7], 1.0f, 3); pk.y = w; }
            { unsigned w = 0; w = __builtin_amdgcn_cvt_scalef32_pk_fp4_f32(w, ux[8], uy[8], 1.0f, 0); w = __builtin_amdgcn_cvt_scalef32_pk_fp4_f32(w, ux[9], uy[9], 1.0f, 1); w = __builtin_amdgcn_cvt_scalef32_pk_fp4_f32(w, ux[10], uy[10], 1.0f, 2); w = __builtin_amdgcn_cvt_scalef32_pk_fp4_f32(w, ux[11], uy[11], 1.0f, 3); pk.z = w; }
            { unsigned w = 0; w = __builtin_amdgcn_cvt_scalef32_pk_fp4_f32(w, ux[12], uy[12], 1.0f, 0); w = __builtin_amdgcn_cvt_scalef32_pk_fp4_f32(w, ux[13], uy[13], 1.0f, 1); w = __builtin_amdgcn_cvt_scalef32_pk_fp4_f32(w, ux[14], uy[14], 1.0f, 2); w = __builtin_amdgcn_cvt_scalef32_pk_fp4_f32(w, ux[15], uy[15], 1.0f, 3); pk.w = w; }
            *(v4u*)(F.U8 + (size_t)e * U_ROW + 16 * G) = pk;
        }
#else
        {
            const v6u pu = pack_fp6(ux, uy);
            unsigned char* ur = F.U8 + (size_t)e * U_ROW;
            *(v4u*)(ur + 16 * G) = (v4u){pu[0], pu[1], pu[2], pu[3]}; *(u32x2*)(ur + 512 + 8 * G) = (u32x2){pu[4], pu[5]};
        }
#endif
#if V_FP4
        {
            v4u pk;
            { unsigned w = 0; w = __builtin_amdgcn_cvt_scalef32_pk_fp4_f32(w, vx_[0], vy_[0], 1.0f, 0); w = __builtin_amdgcn_cvt_scalef32_pk_fp4_f32(w, vx_[1], vy_[1], 1.0f, 1); w = __builtin_amdgcn_cvt_scalef32_pk_fp4_f32(w, vx_[2], vy_[2], 1.0f, 2); w = __builtin_amdgcn_cvt_scalef32_pk_fp4_f32(w, vx_[3], vy_[3], 1.0f, 3); pk.x = w; }
            { unsigned w = 0; w = __builtin_amdgcn_cvt_scalef32_pk_fp4_f32(w, vx_[4], vy_[4], 1.0f, 0); w = __builtin_amdgcn_cvt_scalef32_pk_fp4_f32(w, vx_[5], vy_[5], 1.0f, 1); w = __builtin_amdgcn_cvt_scalef32_pk_fp4_f32(w, vx_[6], vy_[6], 1.0f, 2); w = __builtin_amdgcn_cvt_scalef32_pk_fp4_f32(w, vx_[7], vy_[7], 1.0f, 3); pk.y = w; }
            { unsigned w = 0; w = __builtin_amdgcn_cvt_scalef32_pk_fp4_f32(w, vx_[8], vy_[8], 1.0f, 0); w = __builtin_amdgcn_cvt_scalef32_pk_fp4_f32(w, vx_[9], vy_[9], 1.0f, 1); w = __builtin_amdgcn_cvt_scalef32_pk_fp4_f32(w, vx_[10], vy_[10], 1.0f, 2); w = __builtin_amdgcn_cvt_scalef32_pk_fp4_f32(w, vx_[11], vy_[11], 1.0f, 3); pk.z = w; }
            { unsigned w = 0; w = __builtin_amdgcn_cvt_scalef32_pk_fp4_f32(w, vx_[12], vy_[12], 1.0f, 0); w = __builtin_amdgcn_cvt_scalef32_pk_fp4_f32(w, vx_[13], vy_[13], 1.0f, 1); w = __builtin_amdgcn_cvt_scalef32_pk_fp4_f32(w, vx_[14], vy_[14], 1.0f, 2); w = __builtin_amdgcn_cvt_scalef32_pk_fp4_f32(w, vx_[15], vy_[15], 1.0f, 3); pk.w = w; }
            *(v4u*)(F.V8 + (size_t)e * V_ROW + 16 * G) = pk;
        }
#else
        {
            const v6u pv = pack_fp6(vx_, vy_);
            const int hf_ = G >> 4, i_ = G & 15;
            unsigned char* vb = F.V8 + (size_t)e * V_ROW + 384 * hf_;
            *(v4u*)(vb + 16 * i_) = (v4u){pv[0], pv[1], pv[2], pv[3]}; *(u32x2*)(vb + 256 + 8 * i_) = (u32x2){pv[4], pv[5]};
        }
#endif
    }
    for (int id = gtid; id < SEQ * 32; id += nthr) {
        const int t = id >> 5, i = id & 31;
        const double inv = exp2(-(double)i * (13.287712379549449 / 32.0));
        double rev = (double)t * inv * 0.15915494309189535; rev -= floor(rev);
        F.ROPE[2 * id] = __builtin_amdgcn_cosf((float)rev); F.ROPE[2 * id + 1] = __builtin_amdgcn_sinf((float)rev);
    }
    for (int id = gtid; id < M; id += nthr) F.SSQ[id] = 0.f;
    const GAS f32x4* wv = (const GAS f32x4*)F.in[I_NMW] + F.lane;
    f32x4 nw[4];
#pragma unroll
    for (int j = 0; j < 4; ++j) nw[j] = wv[64 * j];
    f32x4 va[4], vb[4];
    {
        const GAS f32x4* x0 = (const GAS f32x4*)(F.in[I_X] + (size_t)gw * D) + F.lane;
        const GAS f32x4* x1 = (const GAS f32x4*)(F.in[I_X] + (size_t)(gw + NGW < M ? gw + NGW : gw) * D) + F.lane;
#pragma unroll
        for (int j = 0; j < 4; ++j) { va[j] = x0[64 * j]; vb[j] = x1[64 * j]; }
    }
#define XN_ROW(m_, V_) do { float s = 0.f; f32x4 v[4]; \
        _Pragma("unroll") for (int j = 0; j < 4; ++j) { v[j] = V_[j]; s += (v[j].x * v[j].x + v[j].y * v[j].y) + (v[j].z * v[j].z + v[j].w * v[j].w); } \
        { const int mn_ = (m_) + 2 * NGW < M ? (m_) + 2 * NGW : (m_); const GAS f32x4* xn_ = (const GAS f32x4*)(F.in[I_X] + (size_t)mn_ * D) + F.lane; \
          _Pragma("unroll") for (int j = 0; j < 4; ++j) V_[j] = xn_[64 * j]; } \
        const float rstd = 1.0f / sqrtf(wave_sum(s) * (1.f / D) + NORM_EPS); \
        GAS unsigned long long* o8 = (GAS unsigned long long*)(F.XN + (size_t)(m_) * D) + F.lane; \
        _Pragma("unroll") for (int j = 0; j < 4; ++j) { const f32x4 y = v[j] * rstd * nw[j]; o8[64 * j] = (unsigned long long)pk2(y.x, y.y) | ((unsigned long long)pk2(y.z, y.w) << 32); } } while (0)
#pragma unroll 1
    for (int m = gw; m < M; m += 2 * NGW) {
        XN_ROW(m, va);
        if (m + NGW < M) XN_ROW(m + NGW, vb);
    }
#undef XN_ROW
}

__device__ __forceinline__ void attn_phase(Frame& F) {
    LAS bf16* Ks = (LAS bf16*)F.lds;
    LAS bf16* Vt = (LAS bf16*)(F.lds + 256 * 144);
    const int lane = F.lane, wave = F.wave, r32 = lane & 31, hh = lane >> 5;
    for (int unit = F.vcu; unit < BATCH * 2 * 16; unit += F.G) {
        const int b = unit >> 5, kvh = (unit >> 4) & 1, qb = unit & 15;
        const size_t rowbase = (size_t)b * SEQ + qb * 128;
        v4u kq[4], vq[4];
#pragma unroll
        for (int i = 0; i < 4; ++i) {
            const int c = F.tid + 512 * i, key = c >> 3, piece = c & 7;
            const bool okr = (qb > 0 || key >= 128);
            const bf16* src = F.QKV + (rowbase + (okr ? key - 128 : 0)) * 768 + kvh * 64 + piece * 8;
            kq[i] = *(const v4u*)(src + 512); vq[i] = *(const v4u*)(src + 640);
        }
#pragma unroll
        for (int i = 0; i < 4; ++i) {
            const int c = F.tid + 512 * i, key = c >> 3, piece = c & 7;
            const bool okr = (qb > 0 || key >= 128);
            const v4u z4 = (v4u){0u, 0u, 0u, 0u};
            const v4u kv = okr ? kq[i] : z4, vv = okr ? vq[i] : z4;
            *(LAS v4u*)(Ks + key * 72 + piece * 8) = kv;
            LAS bf16* vd = Vt + (piece * 8) * 260 + key;
            vd[0 * 260] = (bf16)(vv.x & 0xffffu); vd[1 * 260] = (bf16)(vv.x >> 16); vd[2 * 260] = (bf16)(vv.y & 0xffffu); vd[3 * 260] = (bf16)(vv.y >> 16);
            vd[4 * 260] = (bf16)(vv.z & 0xffffu); vd[5 * 260] = (bf16)(vv.z >> 16); vd[6 * 260] = (bf16)(vv.w & 0xffffu); vd[7 * 260] = (bf16)(vv.w >> 16);
        }
        __syncthreads();
        const int head = kvh * 4 + (wave >> 1);
        const float sink2 = F.in[I_SINK][head] * LOG2E;
#pragma unroll 1
        for (int qq = 0; qq < 2; ++qq) {
            const int qg = (wave & 1) * 64 + qq * 32, qi = qg + r32;
            const bf16* qp = F.QKV + (rowbase + qi) * 768 + head * 64 + 8 * hh;
            bf16x8 bq[4];
#pragma unroll
            for (int s = 0; s < 4; ++s) bq[s] = *(const bf16x8*)(qp + 16 * s);
            const int kt0 = qg >> 5;
            f32x16 sc[5];
#pragma unroll
            for (int i = 0; i < 5; ++i) {
                f32x16 a_ = {};
#pragma unroll
                for (int s = 0; s < 4; ++s) { const bf16x8 ka = *(const LAS bf16x8*)(Ks + ((kt0 + i) * 32 + r32) * 72 + 16 * s + 8 * hh); a_ = __builtin_amdgcn_mfma_f32_32x32x16_bf16(ka, bq[s], a_, 0, 0, 0); }
                sc[i] = a_;
            }
            float mx = sink2;
#pragma unroll
            for (int i = 0; i < 5; ++i)
#pragma unroll
                for (int r = 0; r < 16; ++r) {
                    const int kj = (kt0 + i) * 32 + (r & 3) + 8 * (r >> 2) + 4 * hh, dk = kj - qi;
                    const bool ok = (dk >= 1) && (dk <= 128) && (qb > 0 || kj >= 128);
                    const float s = ok ? sc[i][r] : -1e30f; sc[i][r] = s; mx = fmaxf(mx, s);
                }
            mx = fmaxf(mx, __shfl_xor(mx, 32));
            float sum = 0.f;
#pragma unroll
            for (int i = 0; i < 5; ++i)
#pragma unroll
                for (int r = 0; r < 16; ++r) { const float p = __builtin_amdgcn_exp2f(sc[i][r] - mx); sc[i][r] = p; sum += p; }
            sum += __shfl_xor(sum, 32); sum += __builtin_amdgcn_exp2f(sink2 - mx);
            const float inv = 1.0f / sum;
            f32x16 o0 = {}, o1 = {};
#pragma unroll
            for (int i = 0; i < 5; ++i)
#pragma unroll
                for (int s2 = 0; s2 < 2; ++s2) {
                    v4u pw;
                    pw.x = pk2(sc[i][8 * s2 + 0] * inv, sc[i][8 * s2 + 1] * inv); pw.y = pk2(sc[i][8 * s2 + 2] * inv, sc[i][8 * s2 + 3] * inv);
                    pw.z = pk2(sc[i][8 * s2 + 4] * inv, sc[i][8 * s2 + 5] * inv); pw.w = pk2(sc[i][8 * s2 + 6] * inv, sc[i][8 * s2 + 7] * inv);
                    const bf16x8 pa = __builtin_bit_cast(bf16x8, pw);
                    const int kb = (kt0 + i) * 32 + 16 * s2 + 4 * hh;
                    const u32x2 l0 = *(const LAS u32x2*)(Vt + r32 * 260 + kb), h0 = *(const LAS u32x2*)(Vt + r32 * 260 + kb + 8);
                    const u32x2 l1 = *(const LAS u32x2*)(Vt + (32 + r32) * 260 + kb), h1 = *(const LAS u32x2*)(Vt + (32 + r32) * 260 + kb + 8);
                    const bf16x8 b0 = __builtin_bit_cast(bf16x8, (v4u){l0.x, l0.y, h0.x, h0.y}), b1 = __builtin_bit_cast(bf16x8, (v4u){l1.x, l1.y, h1.x, h1.y});
                    o0 = __builtin_amdgcn_mfma_f32_32x32x16_bf16(pa, b0, o0, 0, 0, 0);
                    o1 = __builtin_amdgcn_mfma_f32_32x32x16_bf16(pa, b1, o1, 0, 0, 0);
                }
            {
                LAS bf16* Ot = (LAS bf16*)(F.lds + 73728) + wave * (32 * 72);
#pragma unroll
                for (int r = 0; r < 16; ++r) {
                    const int qrow = (r & 3) + 8 * (r >> 2) + 4 * hh;
                    Ot[qrow * 72 + r32] = (bf16)f2bf(o0[r]); Ot[qrow * 72 + 32 + r32] = (bf16)f2bf(o1[r]);
                }
                const int orow = lane >> 1, ohalf = lane & 1;
                const LAS v4u* src = (const LAS v4u*)(Ot + orow * 72 + ohalf * 32);
                v4u* dst = (v4u*)(F.YA + (rowbase + qg + orow) * 512 + head * 64 + ohalf * 32);
#pragma unroll
                for (int k = 0; k < 4; ++k) dst[k] = src[k];
            }
        }
        __syncthreads();
    }
}

__device__ __forceinline__ void lora_prep_phase(Frame& F) {
    const int gtid = F.vcu * (NWAVES * 64) + F.tid, nthr = F.G * NWAVES * 64;
#pragma unroll 1
    for (int id0 = gtid; id0 < M * 48; id0 += 4 * nthr) {
        v4u zc[4], zp[4]; f32x4 mu0[4], mu1[4];
#pragma unroll
        for (int u = 0; u < 4; ++u) {
            const int id = id0 + u * nthr, idc = id < M * 48 ? id : gtid;
            const int row = idc / 48, ch = idc - row * 48, c0 = ch < 36 ? ch * 8 : 0;
            zc[u] = *(const v4u*)(F.LORA + (size_t)row * 512 + c0);
            zp[u] = *(const v4u*)(F.LORA + (size_t)((row & (SEQ - 1)) != 0 ? row - 1 : row) * 512 + c0);
            mu0[u] = *(const f32x4*)(F.in[I_MU] + 1536 + c0); mu1[u] = *(const f32x4*)(F.in[I_MU] + 1536 + c0 + 4);
        }
#pragma unroll
        for (int u = 0; u < 4; ++u) {
            const int id = id0 + u * nthr;
            if (id < M * 48) {
                const int row = id / 48, ch = id - row * 48, c0 = ch * 8;
                v4u o = (v4u){0u, 0u, 0u, 0u};
                if (c0 < 288) {
                    const bool first = (row & (SEQ - 1)) == 0;
                    const unsigned zcw[4] = {zc[u].x, zc[u].y, zc[u].z, zc[u].w}, zpw[4] = {zp[u].x, zp[u].y, zp[u].z, zp[u].w};
                    const float mu[8] = {mu0[u][0], mu0[u][1], mu0[u][2], mu0[u][3], mu1[u][0], mu1[u][1], mu1[u][2], mu1[u][3]};
                    float v[8];
#pragma unroll
                    for (int j = 0; j < 8; ++j) {
                        const float zc_ = (j & 1) ? bf_hi(zcw[j >> 1]) : bf_lo(zcw[j >> 1]), zp_ = first ? 0.f : ((j & 1) ? bf_hi(zpw[j >> 1]) : bf_lo(zpw[j >> 1]));
                        const float z = zc_ + mu[j] * (zp_ - zc_);
                        float f;
                        if (c0 < 64) f = 1.0f - 2.0f * __builtin_amdgcn_rcpf(__builtin_amdgcn_exp2f(2.0f * LOG2E * z) + 1.0f);
                        else if (c0 < 128) f = z;
                        else f = __builtin_amdgcn_rcpf(1.0f + __builtin_amdgcn_exp2f(-LOG2E * z));
                        v[j] = f;
                    }
                    o.x = pk2(v[0], v[1]); o.y = pk2(v[2], v[3]); o.z = pk2(v[4], v[5]); o.w = pk2(v[6], v[7]);
                }
                *(v4u*)(F.LA + (size_t)row * 384 + c0) = o;
            }
        }
    }
}

namespace ck {
constexpr int RS = 136, TS = 40, AS = 40;
constexpr int VB_KT = 0, VB_RT = 16 * RS, VB_KS = 2 * 16 * RS, VB_BS = 3 * 16 * RS, VB_KK = 4 * 16 * RS, VB_BT = VB_KK + 64 * TS, VB_VT = VB_BT + 64 * TS,
              VB_DC = VB_VT + 64 * TS, VB_SIZE = ((VB_DC + 256 + 127) / 128) * 128;
constexpr int VR_V16 = 0, VR_BON = 2048, VR_G = 2048 + 128, VR_SIZE = 2048 + 128 + 2048;
constexpr int RAW_RKV = 0, RAW_DAG = 16 * 384, RAW_SIZE = 2 * 16 * 384;
constexpr int AB_A2 = 0, AB_A3 = 16 * AS, AB_A4 = 2 * 16 * AS, AB_T = 3 * 16 * AS, AB_SIZE = 4 * 16 * AS;
constexpr int OFF_VB = 0, OFF_AB = 3 * VB_SIZE, OFF_Y = OFF_AB + 2 * AB_SIZE, OFF_VR = OFF_Y + 2 * 4096, OFF_RAW = OFF_VR + 4 * VR_SIZE, OFF_PFX = OFF_RAW + 3 * RAW_SIZE, OFF_WT = OFF_PFX + 2 * 4096, LDS_TOTAL = OFF_WT + 2 * 1024;
static_assert(LDS_TOTAL <= 131072 && (OFF_RAW % 16) == 0 && (OFF_PFX % 16) == 0 && (VB_KK % 8) == 0 && (OFF_VR % 16) == 0 && (VB_DC % 16) == 0 && (AB_SIZE % 16) == 0 && (OFF_AB % 16) == 0, "chunked scan LDS map");
}
__device__ __forceinline__ unsigned cvtpk(float lo, float hi) { typedef float f2_ __attribute__((ext_vector_type(2))); typedef __bf16 b2_ __attribute__((ext_vector_type(2))); const f2_ v = {lo, hi}; const b2_ b = __builtin_convertvector(v, b2_); return __builtin_bit_cast(unsigned, b); }
#define SCAN_BAR() do { asm volatile("s_waitcnt lgkmcnt(0)" ::: "memory"); __builtin_amdgcn_s_barrier(); asm volatile("" ::: "memory"); } while (0)
__device__ __forceinline__ void scan_phase(Frame& F) {
    using namespace ck;
    LAS unsigned char* L = F.lds;
    constexpr int NCH = SEQ / 16;
    const int tid = F.tid, lane = F.lane, wave = F.wave;
    const bool helper = wave >= 4;
    const int r16 = lane & 15, g = lane >> 4;
    const int htid = tid & 255, tt = htid >> 4, d4 = (htid & 15) * 4;
    for (int unit = F.vcu; unit < BATCH * 8; unit += F.G) {
        const int b = unit >> 3, h = unit & 7, hc = h * 64 + d4;
        u32x2 rq[6];
#define UP4(W_) ((f32x4){bf_lo((W_).x), bf_hi((W_).x), bf_lo((W_).y), bf_hi((W_).y)})
#define H_ISSUE(c) do { const size_t tk_ = ((size_t)(b * 8 + h) * SEQ + (size_t)(c) * 16 + tt) * 192 + d4; const bf16* rp_ = F.RKV + tk_; const bf16* dp_ = F.DAG + tk_; \
            rq[0] = *(const u32x2*)(rp_); rq[1] = *(const u32x2*)(rp_ + 64); rq[2] = *(const u32x2*)(rp_ + 128); rq[3] = *(const u32x2*)(dp_); rq[4] = *(const u32x2*)(dp_ + 64); rq[5] = *(const u32x2*)(dp_ + 128); } while (0)
#define H_LAND(c) do { LAS unsigned char* rw_ = L + OFF_RAW + (int)((unsigned)(c) % 3u) * RAW_SIZE + tt * 384 + d4 * 2; \
            *(LAS u32x2*)(rw_ + RAW_RKV) = rq[0]; *(LAS u32x2*)(rw_ + RAW_RKV + 128) = rq[1]; *(LAS u32x2*)(rw_ + RAW_RKV + 256) = rq[2]; \
            *(LAS u32x2*)(rw_ + RAW_DAG) = rq[3]; *(LAS u32x2*)(rw_ + RAW_DAG + 128) = rq[4]; *(LAS u32x2*)(rw_ + RAW_DAG + 256) = rq[5]; \
              \
            const f32x4 ex_ = UP4(rq[3]); f32x4 pre_, tot_; \
            _Pragma("unroll") for (int i_ = 0; i_ < 4; ++i_) { const float x_ = ex_[i_]; \
                const auto s1_ = __builtin_amdgcn_permlane16_swap(f2u(x_), f2u(x_), false, false); const unsigned s10_ = s1_[0], s11_ = s1_[1]; const float pt_ = u2f(s10_) + u2f(s11_);        \
                const auto s2_ = __builtin_amdgcn_permlane32_swap(f2u(pt_), f2u(pt_), false, false); const unsigned s20_ = s2_[0], s21_ = s2_[1]; \
                float p_ = (lane & 16) ? pt_ : x_; if (lane & 32) p_ += u2f(s20_); pre_[i_] = p_; tot_[i_] = u2f(s20_) + u2f(s21_); } \
            *(LAS f32x4*)(L + OFF_PFX + ((c) & 1) * 4096 + tt * 256 + d4 * 4) = pre_; \
            if (lane < 16) *(LAS f32x4*)(L + OFF_WT + ((c) & 1) * 1024 + (wave - 4) * 256 + d4 * 4) = tot_; } while (0)
#define PK4(V_) ((u32x2){cvtpk((V_).x, (V_).y), cvtpk((V_).z, (V_).w)})
#define H_PREP(c) do { int tt_ = tt, d4_ = d4; asm volatile("" : "+v"(tt_), "+v"(d4_));   \
            LAS unsigned char* vb_ = L + OFF_VB + (int)((unsigned)(c) % 3u) * VB_SIZE; LAS unsigned char* vr_ = L + OFF_VR + ((c) & 3) * VR_SIZE; \
            const LAS unsigned char* raw_ = L + OFF_RAW + (int)((unsigned)(c) % 3u) * RAW_SIZE + d4_ * 2; \
            f32x4 ltv_ = *(const LAS f32x4*)(L + OFF_PFX + ((c) & 1) * 4096 + tt_ * 256 + d4_ * 4);        \
            for (int w_ = 0; w_ < wave - 4; ++w_) ltv_ = ltv_ + *(const LAS f32x4*)(L + OFF_WT + ((c) & 1) * 1024 + w_ * 256 + d4_ * 4); \
            const float lt[4] = {ltv_[0], ltv_[1], ltv_[2], ltv_[3]}; \
            const LAS unsigned char* own_ = raw_ + tt_ * 384; \
            const u32x2 zr = *(const LAS u32x2*)(own_ + RAW_RKV), zk = *(const LAS u32x2*)(own_ + RAW_RKV + 128), zv = *(const LAS u32x2*)(own_ + RAW_RKV + 256); \
            const u32x2 ew = *(const LAS u32x2*)(own_ + RAW_DAG), aa = *(const LAS u32x2*)(own_ + RAW_DAG + 128), gw_ = *(const LAS u32x2*)(own_ + RAW_DAG + 256); \
              \
            const LAS unsigned char* prv_ = (tt_ > 0) ? (own_ - 384) : (L + OFF_RAW + (int)((unsigned)((c) + 2) % 3u) * RAW_SIZE + d4_ * 2 + 15 * 384); \
            u32x2 pr = *(const LAS u32x2*)(prv_ + RAW_RKV), pk = *(const LAS u32x2*)(prv_ + RAW_RKV + 128), pv = *(const LAS u32x2*)(prv_ + RAW_RKV + 256); \
            if ((c) == 0 && tt_ == 0) { pr = (u32x2){0u, 0u}; pk = pr; pv = pr; } \
            const f32x4 r0_ = UP4(zr), k0_ = UP4(zk), v0_ = UP4(zv); \
            const f32x4 r_ = r0_ + c_mur * (UP4(pr) - r0_), k_ = k0_ + c_muk * (UP4(pk) - k0_), v_ = v0_ + c_muv * (UP4(pv) - v0_); \
            const f32x4 a_ = UP4(aa), e_ = UP4(ew); \
            f32x4 kk_ = k_ * c_kk; const float n2_ = allreduce16((kk_.x * kk_.x + kk_.y * kk_.y) + (kk_.z * kk_.z + kk_.w * kk_.w)); \
            kk_ = kk_ * (1.0f / fmaxf(sqrtf(n2_), 1e-12f)); \
            const f32x4 kp_ = k_ * (1.0f + (a_ - 1.0f) * c_ka); \
            const f32x4 rk_ = r_ * kp_ * c_rk; const float bon_ = allreduce16((rk_.x + rk_.y) + (rk_.z + rk_.w)); \
            f32x4 dt_, dtm_, idt_;   \
            _Pragma("unroll") for (int i_ = 0; i_ < 4; ++i_) { dt_[i_] = __builtin_amdgcn_exp2f(-LOG2E * lt[i_]); dtm_[i_] = __builtin_amdgcn_exp2f(-LOG2E * (lt[i_] - e_[i_])); idt_[i_] = __builtin_amdgcn_exp2f(LOG2E * lt[i_]); } \
            const f32x4 kt_ = kk_ * dtm_, rt_ = r_ * dt_, ks_ = kp_ * idt_, bs_ = kk_ * a_ * idt_; \
            *(LAS u32x2*)(vb_ + VB_KT + tt_ * RS + d4_ * 2) = PK4(kt_); *(LAS u32x2*)(vb_ + VB_RT + tt_ * RS + d4_ * 2) = PK4(rt_); \
            *(LAS u32x2*)(vb_ + VB_KS + tt_ * RS + d4_ * 2) = PK4(ks_); *(LAS u32x2*)(vb_ + VB_BS + tt_ * RS + d4_ * 2) = PK4(bs_); \
            { const u32x2 ksp_ = PK4(ks_), vp_ = PK4(v_); const f32x4 nb_ = -bs_; const u32x2 bsp_ = PK4(nb_); \
              LAS unsigned char* t0_ = vb_ + d4_ * TS + tt_ * 2; \
              *(LAS bf16*)(t0_ + VB_KK) = (bf16)(ksp_.x & 0xffffu); *(LAS bf16*)(t0_ + VB_KK + TS) = (bf16)(ksp_.x >> 16); *(LAS bf16*)(t0_ + VB_KK + 2 * TS) = (bf16)(ksp_.y & 0xffffu); *(LAS bf16*)(t0_ + VB_KK + 3 * TS) = (bf16)(ksp_.y >> 16); \
              *(LAS bf16*)(t0_ + VB_BT) = (bf16)(bsp_.x & 0xffffu); *(LAS bf16*)(t0_ + VB_BT + TS) = (bf16)(bsp_.x >> 16); *(LAS bf16*)(t0_ + VB_BT + 2 * TS) = (bf16)(bsp_.y & 0xffffu); *(LAS bf16*)(t0_ + VB_BT + 3 * TS) = (bf16)(bsp_.y >> 16); \
              *(LAS bf16*)(t0_ + VB_VT) = (bf16)(vp_.x & 0xffffu); *(LAS bf16*)(t0_ + VB_VT + TS) = (bf16)(vp_.x >> 16); *(LAS bf16*)(t0_ + VB_VT + 2 * TS) = (bf16)(vp_.y & 0xffffu); *(LAS bf16*)(t0_ + VB_VT + 3 * TS) = (bf16)(vp_.y >> 16); } \
            *(LAS u32x2*)(vr_ + VR_V16 + tt_ * 128 + d4_ * 2) = PK4(v_); \
            if ((d4_ == 0)) *(LAS float*)(vr_ + VR_BON + tt_ * 4) = bon_; \
            *(LAS u32x2*)(vr_ + VR_G + tt_ * 128 + d4_ * 2) = gw_; \
            if (tt_ == 15) *(LAS f32x4*)(vb_ + VB_DC + d4_ * 4) = dt_; } while (0)
#define H_PROD(c) do { int r_ = r16, g_ = g; asm volatile("" : "+v"(r_), "+v"(g_)); \
            LAS unsigned char* vb_ = L + OFF_VB + (int)((unsigned)(c) % 3u) * VB_SIZE; LAS unsigned char* ab_ = L + OFF_AB + ((c) & 1) * AB_SIZE; const int hw_ = wave - 4;        \
            const LAS unsigned char* X_ = vb_ + ((hw_ & 1) ? VB_KS : VB_BS) + r_ * RS + g_ * 16; const LAS unsigned char* Y_ = vb_ + ((hw_ & 2) ? VB_RT : VB_KT) + r_ * RS + g_ * 16; \
            f32x4 p_ = (f32x4){0.f, 0.f, 0.f, 0.f}; \
            p_ = __builtin_amdgcn_mfma_f32_16x16x32_bf16(*(const LAS bf16x8*)(X_), *(const LAS bf16x8*)(Y_), p_, 0, 0, 0); \
            p_ = __builtin_amdgcn_mfma_f32_16x16x32_bf16(*(const LAS bf16x8*)(X_ + 64), *(const LAS bf16x8*)(Y_ + 64), p_, 0, 0, 0); \
            _Pragma("unroll") for (int q_ = 0; q_ < 4; ++q_) { const int s_ = 4 * g_ + q_; const bool keep_ = (hw_ & 2) ? (s_ <= r_) : (s_ < r_); p_[q_] = keep_ ? p_[q_] : 0.f; } \
            if (hw_ != 0) { \
                const float sg_ = (hw_ == 2) ? -1.0f : 1.0f; const int off_ = (hw_ == 1) ? AB_A2 : (hw_ == 2) ? AB_A3 : AB_A4; \
                *(LAS u32x2*)(ab_ + off_ + r_ * AS + g_ * 8) = (u32x2){cvtpk(sg_ * p_[0], sg_ * p_[1]), cvtpk(sg_ * p_[2], sg_ * p_[3])}; \
            } } while (0)
#define S_TINV(c) do { int r_ = r16, g_ = g; asm volatile("" : "+v"(r_), "+v"(g_)); \
            LAS unsigned char* vb_ = L + OFF_VB + (int)((unsigned)(c) % 3u) * VB_SIZE; LAS unsigned char* ab_ = L + OFF_AB + ((c) & 1) * AB_SIZE; \
            const LAS unsigned char* X_ = vb_ + VB_BS + r_ * RS + g_ * 16; const LAS unsigned char* Y_ = vb_ + VB_KT + r_ * RS + g_ * 16; \
            f32x4 p_ = (f32x4){0.f, 0.f, 0.f, 0.f}; \
            p_ = __builtin_amdgcn_mfma_f32_16x16x32_bf16(*(const LAS bf16x8*)(X_), *(const LAS bf16x8*)(Y_), p_, 0, 0, 0); \
            p_ = __builtin_amdgcn_mfma_f32_16x16x32_bf16(*(const LAS bf16x8*)(X_ + 64), *(const LAS bf16x8*)(Y_ + 64), p_, 0, 0, 0); \
            _Pragma("unroll") for (int q_ = 0; q_ < 4; ++q_) p_[q_] = (4 * g_ + q_ < r_) ? p_[q_] : 0.f; \
                  \
                  \
                f32x4 p2_ = (f32x4){0.f, 0.f, 0.f, 0.f}; \
                p2_ = __builtin_amdgcn_mfma_f32_16x16x32_bf16(*(const LAS bf16x8*)(Y_), *(const LAS bf16x8*)(X_), p2_, 0, 0, 0); \
                p2_ = __builtin_amdgcn_mfma_f32_16x16x32_bf16(*(const LAS bf16x8*)(Y_ + 64), *(const LAS bf16x8*)(X_ + 64), p2_, 0, 0, 0); \
                f32x4 Pa_, Pb_, Ta_, Tb_; \
                _Pragma("unroll") for (int q_ = 0; q_ < 4; ++q_) { const int o_ = 4 * g_ + q_; Pa_[q_] = -p_[q_]; Pb_[q_] = (r_ < o_) ? -p2_[q_] : 0.f; const float d_ = (r_ == o_) ? 1.0f : 0.0f; Ta_[q_] = d_ + Pa_[q_]; Tb_[q_] = d_ + Pb_[q_]; } \
                _Pragma("unroll") for (int it_ = 0; it_ < 3; ++it_) { \
                    const s16x4 a8_ = K16(((u32x2){cvtpk(Pa_[0], Pa_[1]), cvtpk(Pa_[2], Pa_[3])})), b8_ = K16(((u32x2){cvtpk(Pb_[0], Pb_[1]), cvtpk(Pb_[2], Pb_[3])})); \
                    const f32x4 z_ = (f32x4){0.f, 0.f, 0.f, 0.f}; \
                    Pb_ = __builtin_amdgcn_mfma_f32_16x16x16bf16_1k(a8_, b8_, z_, 0, 0, 0); Pa_ = __builtin_amdgcn_mfma_f32_16x16x16bf16_1k(b8_, a8_, z_, 0, 0, 0); \
                    const s16x4 t8_ = K16(((u32x2){cvtpk(Ta_[0], Ta_[1]), cvtpk(Ta_[2], Ta_[3])})), p8_ = K16(((u32x2){cvtpk(Pb_[0], Pb_[1]), cvtpk(Pb_[2], Pb_[3])})); \
                    const f32x4 nTb_ = __builtin_amdgcn_mfma_f32_16x16x16bf16_1k(t8_, p8_, Tb_, 0, 0, 0), nTa_ = __builtin_amdgcn_mfma_f32_16x16x16bf16_1k(p8_, t8_, Ta_, 0, 0, 0); \
                    Ta_ = nTa_; Tb_ = nTb_; } \
                *(LAS u32x2*)(ab_ + AB_T + r_ * AS + g_ * 8) = (u32x2){cvtpk(Ta_[0], Ta_[1]), cvtpk(Ta_[2], Ta_[3])}; \
            } while (0)
#define H_POST(c) do { int tt_ = tt, d4_ = d4; asm volatile("" : "+v"(tt_), "+v"(d4_)); const size_t row_ = (size_t)b * SEQ + (size_t)(c) * 16 + tt; const LAS unsigned char* vr_ = L + OFF_VR + ((c) & 3) * VR_SIZE; \
            const f32x4 y_ = *(const LAS f32x4*)(L + OFF_Y + ((c) & 1) * 4096 + tt_ * 256 + d4_ * 4); \
            const float mean_ = allreduce16((y_.x + y_.y) + (y_.z + y_.w)) * (1.f / 64.f); const f32x4 dy_ = y_ - mean_; \
            const float var_ = allreduce16((dy_.x * dy_.x + dy_.y * dy_.y) + (dy_.z * dy_.z + dy_.w * dy_.w)) * (1.f / 64.f); const float rs_ = 1.0f / sqrtf(var_ + GN_EPS); \
            const u32x2 gq_ = *(const LAS u32x2*)(vr_ + VR_G + tt_ * 128 + d4_ * 2); const u32x2 vw_ = *(const LAS u32x2*)(vr_ + VR_V16 + tt_ * 128 + d4_ * 2); const f32x4 vsh_ = UP4(vw_); const float bo_ = *(const LAS float*)(vr_ + VR_BON + tt_ * 4); \
            const f32x4 o_ = (dy_ * rs_ * c_lnw + c_lnb + bo_ * vsh_) * UP4(gq_); \
            *(u32x2*)(F.YB + row_ * 512 + hc) = PK4(o_); } while (0)
        const f32x4 c_mur = *(const f32x4*)(F.in[I_MU] + hc), c_muk = *(const f32x4*)(F.in[I_MU] + 512 + hc), c_muv = *(const f32x4*)(F.in[I_MU] + 1024 + hc);
        const f32x4 c_kk = *(const f32x4*)(F.in[I_KK] + hc), c_ka = *(const f32x4*)(F.in[I_KA] + hc), c_rk = *(const f32x4*)(F.in[I_RK] + hc), c_lnw = *(const f32x4*)(F.in[I_LNW] + hc), c_lnb = *(const f32x4*)(F.in[I_LNB] + hc);
        f32x4 St[4];
#pragma unroll
        for (int i = 0; i < 4; ++i) St[i] = (f32x4){0.f, 0.f, 0.f, 0.f};
#define FR2(lo_, hi_) __builtin_bit_cast(bf16x8, (v4u){(lo_).x, (lo_).y, (hi_).x, (hi_).y})
typedef short s16x4 __attribute__((ext_vector_type(4)));
#define K16(w_) __builtin_bit_cast(s16x4, (w_))
#define SCAN_CHAIN(c) do { int r_ = r16, g_ = g; asm volatile("" : "+v"(r_), "+v"(g_)); \
                const LAS unsigned char* vb = L + OFF_VB + (int)((unsigned)(c) % 3u) * VB_SIZE; const LAS unsigned char* ab = L + OFF_AB + ((c) & 1) * AB_SIZE; \
                const int v = 16 * wave + r_; \
                const bf16x8 sb01 = __builtin_bit_cast(bf16x8, (v4u){cvtpk(St[0][0], St[0][1]), cvtpk(St[0][2], St[0][3]), cvtpk(St[1][0], St[1][1]), cvtpk(St[1][2], St[1][3])}); \
                const bf16x8 sb23 = __builtin_bit_cast(bf16x8, (v4u){cvtpk(St[2][0], St[2][1]), cvtpk(St[2][2], St[2][3]), cvtpk(St[3][0], St[3][1]), cvtpk(St[3][2], St[3][3])}); \
                const LAS unsigned char* ktp = vb + VB_KT + r_ * RS + g_ * 8; const LAS unsigned char* rtp = vb + VB_RT + r_ * RS + g_ * 8; \
                const bf16x8 kt01 = FR2(*(const LAS u32x2*)(ktp), *(const LAS u32x2*)(ktp + 32)), kt23 = FR2(*(const LAS u32x2*)(ktp + 64), *(const LAS u32x2*)(ktp + 96)); \
                const bf16x8 rt01 = FR2(*(const LAS u32x2*)(rtp), *(const LAS u32x2*)(rtp + 32)), rt23 = FR2(*(const LAS u32x2*)(rtp + 64), *(const LAS u32x2*)(rtp + 96)); \
                const s16x4 a2f = K16(*(const LAS u32x2*)(ab + AB_A2 + r_ * AS + g_ * 8)), a3f = K16(*(const LAS u32x2*)(ab + AB_A3 + r_ * AS + g_ * 8)); \
                const s16x4 a4f = K16(*(const LAS u32x2*)(ab + AB_A4 + r_ * AS + g_ * 8)), tf = K16(*(const LAS u32x2*)(ab + AB_T + r_ * AS + g_ * 8)); \
                const s16x4 vf = K16(*(const LAS u32x2*)(vb + VB_VT + v * TS + g_ * 8)); \
                f32x4 G = (f32x4){0.f, 0.f, 0.f, 0.f}; \
                G = __builtin_amdgcn_mfma_f32_16x16x32_bf16(kt01, sb01, G, 0, 0, 0); \
                G = __builtin_amdgcn_mfma_f32_16x16x32_bf16(kt23, sb23, G, 0, 0, 0); \
                G = __builtin_amdgcn_mfma_f32_16x16x16bf16_1k(a2f, vf, G, 0, 0, 0);        \
                const s16x4 gb = K16(((u32x2){cvtpk(G[0], G[1]), cvtpk(G[2], G[3])})); \
                const f32x4 E = __builtin_amdgcn_mfma_f32_16x16x16bf16_1k(tf, gb, (f32x4){0.f, 0.f, 0.f, 0.f}, 0, 0, 0); \
                const s16x4 eb = K16(((u32x2){cvtpk(E[0], E[1]), cvtpk(E[2], E[3])})); \
                f32x4 Yt = (f32x4){0.f, 0.f, 0.f, 0.f}; \
                Yt = __builtin_amdgcn_mfma_f32_16x16x32_bf16(rt01, sb01, Yt, 0, 0, 0); \
                Yt = __builtin_amdgcn_mfma_f32_16x16x32_bf16(rt23, sb23, Yt, 0, 0, 0); \
                Yt = __builtin_amdgcn_mfma_f32_16x16x16bf16_1k(a4f, vf, Yt, 0, 0, 0); \
                Yt = __builtin_amdgcn_mfma_f32_16x16x16bf16_1k(a3f, eb, Yt, 0, 0, 0); \
                _Pragma("unroll") \
                for (int rt = 0; rt < 4; ++rt) { \
                    const s16x4 kkf = K16(*(const LAS u32x2*)(vb + VB_KK + (16 * rt + r_) * TS + g_ * 8)), btf = K16(*(const LAS u32x2*)(vb + VB_BT + (16 * rt + r_) * TS + g_ * 8)); \
                    St[rt] = __builtin_amdgcn_mfma_f32_16x16x16bf16_1k(kkf, vf, St[rt], 0, 0, 0); \
                    St[rt] = __builtin_amdgcn_mfma_f32_16x16x16bf16_1k(btf, eb, St[rt], 0, 0, 0); \
                    St[rt] = St[rt] * *(const LAS f32x4*)(vb + VB_DC + (16 * rt + 4 * g_) * 4); \
                } \
                LAS float* yo = (LAS float*)(L + OFF_Y + ((c) & 1) * 4096) + (4 * g_) * 64 + v; \
                yo[0] = Yt[0]; yo[64] = Yt[1]; yo[128] = Yt[2]; yo[192] = Yt[3]; \
            } while (0)
        if (helper) { H_ISSUE(0); H_LAND(0); H_ISSUE(1); H_LAND(1); H_ISSUE(2); }
        SCAN_BAR();
        if (helper) { H_PREP(0); H_PREP(1); }
        SCAN_BAR();
        if (helper) { H_LAND(2); H_ISSUE(3); if (wave != 4) { H_PROD(0); } } else if (wave == 0) S_TINV(0);
        SCAN_BAR();
#define ITER(c) do { \
            if (helper) { \
                if ((c) + 3 < NCH) H_LAND((c) + 3); \
                if ((c) + 4 < NCH) H_ISSUE((c) + 4); \
                if ((c) + 1 < NCH && wave != 4) { H_PROD((c) + 1); } \
                if ((c) + 2 < NCH) { H_PREP((c) + 2); if (DUP_PHASE == 41) { H_PREP((c) + 2); } } \
            } else { \
                if ((c) < NCH) { SCAN_CHAIN(c); } \
                if ((c) >= 1) { H_POST((c) - 1); if (DUP_PHASE == 43) { H_POST((c) - 1); } } \
                if (wave == 0 && (c) + 1 < NCH) { __builtin_amdgcn_s_setprio(2); S_TINV((c) + 1); __builtin_amdgcn_s_setprio(0); } \
            } \
            SCAN_BAR(); } while (0)
#pragma unroll 1
        for (int c = 0; c <= NCH; ++c) ITER(c);
#undef ITER
        __syncthreads();
#undef H_ISSUE
#undef H_LAND
#undef UP4
#undef PK4
#undef H_PREP
#undef H_PROD
#undef S_TINV
#undef H_POST
    }
}

#define CE(i, j) do { const unsigned a_ = x[i], b_ = x[j]; x[i] = a_ > b_ ? a_ : b_; x[j] = a_ > b_ ? b_ : a_; } while (0)
__device__ __forceinline__ void sort16(unsigned (&x)[16]) {
    CE(0,1); CE(2,3); CE(0,2); CE(1,3); CE(1,2); CE(4,5); CE(6,7); CE(4,6); CE(5,7); CE(5,6); CE(0,4); CE(2,6); CE(2,4); CE(1,5); CE(3,7); CE(3,5); CE(1,2); CE(3,4); CE(5,6);
    CE(8,9); CE(10,11); CE(8,10); CE(9,11); CE(9,10); CE(12,13); CE(14,15); CE(12,14); CE(13,15); CE(13,14); CE(8,12); CE(10,14); CE(10,12); CE(9,13); CE(11,15); CE(11,13); CE(9,10); CE(11,12); CE(13,14);
    CE(0,8); CE(4,12); CE(4,8); CE(2,10); CE(6,14); CE(6,10); CE(2,4); CE(6,8); CE(10,12); CE(1,9); CE(5,13); CE(5,9); CE(3,11); CE(7,15); CE(7,11); CE(3,5); CE(7,9); CE(11,13);
    CE(1,2); CE(3,4); CE(5,6); CE(7,8); CE(9,10); CE(11,12); CE(13,14);
}
__device__ __forceinline__ void merge16(unsigned (&x)[16], const unsigned (&y)[16]) {
#pragma unroll
    for (int i = 0; i < 16; ++i) x[i] = x[i] > y[15 - i] ? x[i] : y[15 - i];
    CE(0,8); CE(1,9); CE(2,10); CE(3,11); CE(4,12); CE(5,13); CE(6,14); CE(7,15); CE(0,4); CE(1,5); CE(2,6); CE(3,7); CE(8,12); CE(9,13); CE(10,14); CE(11,15);
    CE(0,2); CE(1,3); CE(4,6); CE(5,7); CE(8,10); CE(9,11); CE(12,14); CE(13,15); CE(0,1); CE(2,3); CE(4,5); CE(6,7); CE(8,9); CE(10,11); CE(12,13); CE(14,15);
}
#undef CE
__device__ __forceinline__ unsigned f2key(float f) { const unsigned u = __builtin_bit_cast(unsigned, f); return u ^ ((unsigned)((int)u >> 31) | 0x80000000u); }
__device__ __forceinline__ float key2f(unsigned k) { return __builtin_bit_cast(float, (k & 0x80000000u) ? (k ^ 0x80000000u) : ~k); }
__device__ __forceinline__ unsigned lut16(const unsigned (&p)[4], unsigned i) {
    const unsigned q = i >> 2; const unsigned w = q == 0 ? p[0] : q == 1 ? p[1] : q == 2 ? p[2] : p[3];
    return (w >> ((i & 3u) * 8u)) & 0xffu;
}
__device__ __forceinline__ void peer_half_topk(const bf16* SKhp, const bf16* SKn, const bf16* qn, int r32, int hh, bf16x8 (&bq)[4], bf16x8 (&ak)[4], unsigned (&T)[16]) {
    unsigned G_[16];
#pragma unroll
    for (int i = 0; i < 16; ++i) T[i] = 0u;
#pragma unroll 1
    for (int nt = 0; nt < 4; ++nt) {
        f32x16 acc = {};
        __builtin_amdgcn_s_setprio(1);
#pragma unroll
        for (int s = 0; s < 4; ++s) acc = __builtin_amdgcn_mfma_f32_32x32x16_bf16(ak[s], bq[s], acc, 0, 0, 0);
        __builtin_amdgcn_s_setprio(0);
        { const bf16* src = nt < 3 ? SKhp + ((nt + 1) * 32 + r32) * 64 : SKn + r32 * 64;
#pragma unroll
          for (int s = 0; s < 4; ++s) ak[s] = *(const bf16x8*)(src + 16 * s + 8 * hh); }
        if (nt == 3) {
#pragma unroll
            for (int s = 0; s < 4; ++s) bq[s] = *(const bf16x8*)(qn + 16 * s + 8 * hh);
        }
#pragma unroll
        for (int r = 0; r < 16; ++r) { const unsigned n = nt * 32 + (r & 3) + 8 * (r >> 2) + 4 * hh; G_[r] = (f2key(acc[r]) & ~0x7fu) | n; }
        sort16(G_);
        merge16(T, G_);
    }
#pragma unroll
    for (int i = 0; i < 16; ++i) G_[i] = (unsigned)__shfl_xor((int)T[i], 32);
    merge16(T, G_);
}
__device__ __forceinline__ void peer_topk_phase(Frame& F) {
    const int lane = F.lane, wave = F.wave, r32 = lane & 31, hh = lane >> 5;
    for (int unit = F.vcu; unit < M / 256; unit += F.G) {
        const int tok = unit * 256 + wave * 32 + r32;
        const float rstd = 1.0f / sqrtf(F.SSQ[tok] * (1.f / D) + NORM_EPS);
        bf16x8 bq[4], ak[4];
#pragma unroll
        for (int s = 0; s < 4; ++s) { bq[s] = *(const bf16x8*)(F.QP + (size_t)tok * 1024 + 16 * s + 8 * hh); ak[s] = *(const bf16x8*)(F.SK + r32 * 64 + 16 * s + 8 * hh); }
#pragma unroll 1
        for (int h = 0; h < 8; ++h) {
            unsigned T1[16], T2[16];
            const int hn = h < 7 ? h + 1 : 7;
            peer_half_topk(F.SK + (size_t)(h * 2 + 0) * 128 * 64, F.SK + (size_t)(h * 2 + 1) * 128 * 64, F.QP + (size_t)tok * 1024 + h * 128 + 64, r32, hh, bq, ak, T1);
            peer_half_topk(F.SK + (size_t)(h * 2 + 1) * 128 * 64, F.SK + (size_t)(hn * 2 + 0) * 128 * 64, F.QP + (size_t)tok * 1024 + hn * 128, r32, hh, bq, ak, T2);
            float v1[16], v2[16]; unsigned p1[4] = {0u, 0u, 0u, 0u}, p2[4] = {0u, 0u, 0u, 0u};
#pragma unroll
            for (int i = 0; i < 16; ++i) { v1[i] = key2f(T1[i] & ~0x7fu); v2[i] = key2f(T2[i] & ~0x7fu); p1[i >> 2] |= (T1[i] & 0x7fu) << ((i & 3) * 8); p2[i >> 2] |= (T2[i] & 0x7fu) << ((i & 3) * 8); }
            unsigned C[16], Gc[16];
#define CK(i, j) ((f2key(v1[i] + v2[j]) & ~0xffu) | (unsigned)((i) * 16 + (j)))
            Gc[0] = CK(0,0); Gc[1] = CK(0,1); Gc[2] = CK(0,2); Gc[3] = CK(0,3); Gc[4] = CK(0,4); Gc[5] = CK(0,5); Gc[6] = CK(0,6); Gc[7] = CK(0,7); Gc[8] = CK(0,8); Gc[9] = CK(0,9); Gc[10] = CK(0,10); Gc[11] = CK(0,11); Gc[12] = CK(0,12); Gc[13] = CK(0,13); Gc[14] = CK(0,14); Gc[15] = CK(0,15);
            sort16(Gc);
            _Pragma("unroll") for (int e = 0; e < 16; ++e) C[e] = Gc[e];
            Gc[0] = CK(1,0); Gc[1] = CK(1,1); Gc[2] = CK(1,2); Gc[3] = CK(1,3); Gc[4] = CK(1,4); Gc[5] = CK(1,5); Gc[6] = CK(1,6); Gc[7] = CK(1,7); Gc[8] = CK(2,0); Gc[9] = CK(2,1); Gc[10] = CK(2,2); Gc[11] = CK(2,3); Gc[12] = CK(2,4); Gc[13] = CK(3,0); Gc[14] = CK(3,1); Gc[15] = CK(3,2);
            sort16(Gc);
            merge16(C, Gc);
            Gc[0] = CK(3,3); Gc[1] = CK(4,0); Gc[2] = CK(4,1); Gc[3] = CK(4,2); Gc[4] = CK(5,0); Gc[5] = CK(5,1); Gc[6] = CK(6,0); Gc[7] = CK(6,1); Gc[8] = CK(7,0); Gc[9] = CK(7,1); Gc[10] = CK(8,0); Gc[11] = CK(9,0); Gc[12] = CK(10,0); Gc[13] = CK(11,0); Gc[14] = CK(12,0); Gc[15] = CK(13,0);
            sort16(Gc);
            merge16(C, Gc);
            Gc[0] = CK(14,0); Gc[1] = CK(15,0); Gc[2] = 0u; Gc[3] = 0u; Gc[4] = 0u; Gc[5] = 0u; Gc[6] = 0u; Gc[7] = 0u; Gc[8] = 0u; Gc[9] = 0u; Gc[10] = 0u; Gc[11] = 0u; Gc[12] = 0u; Gc[13] = 0u; Gc[14] = 0u; Gc[15] = 0u;
            sort16(Gc);
            merge16(C, Gc);
#undef CK
            float gsum = 0.f, gv[16]; int ex[16];
            const float top = key2f(C[0] & ~0xffu) * rstd;
#pragma unroll
            for (int k = 0; k < 16; ++k) {
                const float e = __builtin_amdgcn_exp2f((key2f(C[k] & ~0xffu) * rstd - top) * LOG2E); gv[k] = e; gsum += e;
                ex[k] = (int)(lut16(p1, (C[k] >> 4) & 15u) * 128u + lut16(p2, C[k] & 15u));
            }
            const float ginv = 1.0f / gsum;
            int* ip = F.IDX + (size_t)tok * 128 + h * 16 + hh * 8;
            typedef int i32x4 __attribute__((ext_vector_type(4)));
            i32x4 i0, i1;
#pragma unroll
            for (int k = 0; k < 4; ++k) {
                const int ea = hh ? ex[8 + k] : ex[k], eb = hh ? ex[12 + k] : ex[4 + k];
                const float ga = (hh ? gv[8 + k] : gv[k]) * ginv, gb = (hh ? gv[12 + k] : gv[4 + k]) * ginv;
                i0[k] = (ea << 18) | (int)(ga * 262143.0f + 0.5f); i1[k] = (eb << 18) | (int)(gb * 262143.0f + 0.5f);
            }
            *(i32x4*)ip = i0; *(i32x4*)(ip + 4) = i1;
        }
    }
}

typedef int v8i_t __attribute__((ext_vector_type(8)));
#define H8C(x) __builtin_amdgcn_fmed3f((x), -448.f, 448.f)
__device__ __forceinline__ void peer_gather_phase(Frame& F) {
    const int lane = F.lane, rw = lane >> 4, c = lane & 15;
    const int gw = F.vcu * NWAVES + F.wave, NGW = F.G * NWAVES;
    const float* wfin = F.in[I_NFINAL];
    LAS unsigned* SW = (LAS unsigned*)F.lds + F.wave * 512;
    LAS float* AW = (LAS float*)(F.lds + 16384) + F.wave * 512;
    LAS unsigned char* AT = F.lds + 32768 + F.wave * 4096;
    LAS unsigned char* HS = F.lds + 65536 + F.wave * 8192;
    int round = 0;
#pragma unroll 1
    for (int tbase = gw * 4; tbase < M; tbase += NGW * 4, ++round) {
#ifdef ROUND_SYNC
        if (F.rnd_nloc > 0) {
            __syncthreads();
            if (F.tid == 0) {
                gu32* cw = F.ctl + CW_RND + 64 * F.rnd_x;
                __hip_atomic_fetch_add(cw, 1u, RLX_AGENT);
                const unsigned want = (unsigned)F.rnd_nloc * (unsigned)(round + 1);
                for (int sp = 0; sp < 20000 && __hip_atomic_load(cw, RLX_AGENT) < want; ++sp) __builtin_amdgcn_s_sleep(2);
            }
            __syncthreads();
        }
#endif
#pragma unroll 1
        for (int j = 0; j < 4; ++j) {
            int lo_ = lane; asm volatile("" : "+v"(lo_));
            unsigned id0 = (unsigned)F.IDX[(size_t)(tbase + j) * 128 + lo_], id1 = (unsigned)F.IDX[(size_t)(tbase + j) * 128 + 64 + lo_];
#define BSTEP(k_, j_, OTH0, OTH1) do { const unsigned o0_ = (OTH0), o1_ = (OTH1); const bool low_ = (lane & (j_)) == 0; \
            const bool up0_ = ((lane & (k_)) == 0), up1_ = (((64 + lane) & (k_)) == 0); \
            const unsigned mn0_ = id0 < o0_ ? id0 : o0_, mx0_ = id0 < o0_ ? o0_ : id0, mn1_ = id1 < o1_ ? id1 : o1_, mx1_ = id1 < o1_ ? o1_ : id1; \
            id0 = (up0_ == low_) ? mn0_ : mx0_; id1 = (up1_ == low_) ? mn1_ : mx1_; } while (0)
#define BSWZ(k_, j_) BSTEP(k_, j_, (unsigned)__builtin_amdgcn_ds_swizzle((int)id0, ((j_) << 10) | 0x1f), (unsigned)__builtin_amdgcn_ds_swizzle((int)id1, ((j_) << 10) | 0x1f))
#define B32(k_) do { const auto p0_ = __builtin_amdgcn_permlane32_swap(id0, id0, false, false); const unsigned p00_ = p0_[0], p01_ = p0_[1]; \
            const auto p1_ = __builtin_amdgcn_permlane32_swap(id1, id1, false, false); const unsigned p10_ = p1_[0], p11_ = p1_[1]; \
            BSTEP(k_, 32, (lane < 32 ? p01_ : p00_), (lane < 32 ? p11_ : p10_)); } while (0)
            BSWZ(2, 1);
            BSWZ(4, 2); BSWZ(4, 1);
            BSWZ(8, 4); BSWZ(8, 2); BSWZ(8, 1);
            BSWZ(16, 8); BSWZ(16, 4); BSWZ(16, 2); BSWZ(16, 1);
            BSWZ(32, 16); BSWZ(32, 8); BSWZ(32, 4); BSWZ(32, 2); BSWZ(32, 1);
            B32(64); BSWZ(64, 16); BSWZ(64, 8); BSWZ(64, 4); BSWZ(64, 2); BSWZ(64, 1);
            { const unsigned mn_ = id0 < id1 ? id0 : id1, mx_ = id0 < id1 ? id1 : id0; id0 = mn_; id1 = mx_; }
            B32(128); BSWZ(128, 16); BSWZ(128, 8); BSWZ(128, 4); BSWZ(128, 2); BSWZ(128, 1);
#undef BSTEP
#undef BSWZ
#undef B32
            SW[j * 128 + lane] = id0; SW[j * 128 + 64 + lane] = id1;
        }
        const int tok = tbase + rw;
        int c1 = c; asm volatile("" : "+v"(c1));
        const bf16* hb = F.HB + (size_t)tok * 1024 + c1 * 64;
        const float rstd = 1.0f / sqrtf(F.SSQ[tok] * (1.f / D) + NORM_EPS);
        const float hscale = rstd * (1.0f / U6_SCALE);
        const LAS unsigned* sw = SW + rw * 128;
        LAS float* aw = AW + rw * 128;
        const unsigned vlo = c * 16; const LAS unsigned* swr = SW + rw;
        constexpr int VFMT = V_FP4 ? 4 : 2;
        struct VSet { v4u l4; u32x2 l2; v4u h4; u32x2 h2; };
        VSet sa[4], sb[4];
#define PV_LOAD(q_, T_, S_) do { const unsigned e_ = swr[(T_) * 128 + 4 * (q_)] >> 18; const unsigned char* vb_ = F.V8 + (size_t)(e_ * (unsigned)V_ROW + vlo);        \
            if (V_FP4) { S_.l4 = *(const v4u*)(vb_); S_.h4 = *(const v4u*)(vb_ + 256); } \
            else { S_.l4 = *(const v4u*)(vb_); S_.l2 = *(const u32x2*)(vb_ + 256 - 8 * c); S_.h4 = *(const v4u*)(vb_ + 384); S_.h2 = *(const u32x2*)(vb_ + 640 - 8 * c); } } while (0)
        {
            v4u hraw[4][4];
#pragma unroll
            for (int t_ = 0; t_ < 4; ++t_) {
                const bf16* hq = F.HB + (size_t)(tbase + t_) * 1024 + (c & 7) * 128 + rw * 16;
#pragma unroll
                for (int q = 0; q < 4; ++q) hraw[t_][q] = *(const v4u*)(hq + (q >> 1) * 64 + (q & 1) * 8);
            }
            if (c < 8) {
#pragma unroll
                for (int t_ = 0; t_ < 4; ++t_)
#pragma unroll
                    for (int q = 0; q < 4; ++q) *(LAS v4u*)(HS + t_ * 2048 + (c * 128 + rw * 16 + (q >> 1) * 64 + (q & 1) * 8) * 2) = hraw[t_][q];
            }
            const unsigned ulo = 16 * (4 * (c & 7) + rw); const LAS unsigned* swl8 = SW + (c >> 3);
            const int uoff2 = 512 - 8 * (4 * (c & 7) + rw);
            constexpr int UFMT = U_FP4 ? 4 : 2;
            const bool dkeep = (c < 8) && ((rw & 1) == (c >> 2));
            struct USet { v4u a; u32x2 b; };
            USet ua[8], ub[8];
#define UA_LOAD(b_, X_, S_) do { const unsigned e_ = swl8[((X_) >> 1) * 128 + 4 * (b_) + 2 * ((X_) & 1)] >> 18; \
                const unsigned char* up_ = F.U8 + (size_t)(e_ * (unsigned)U_ROW + ulo); S_.a = *(const v4u*)(up_); if (!U_FP4) S_.b = *(const u32x2*)(up_ + uoff2); } while (0)
#define UA_COMP(X_, S_) do { const v8i_t a8 = {(int)S_.a.x, (int)S_.a.y, (int)S_.a.z, (int)S_.a.w, U_FP4 ? 0 : (int)S_.b.x, U_FP4 ? 0 : (int)S_.b.y, 0, 0}; \
                const f32x4 d_ = __builtin_amdgcn_mfma_scale_f32_16x16x128_f8f6f4(a8, hbT[(X_) >> 1], (f32x4){0.f, 0.f, 0.f, 0.f}, UFMT, 0, 0, 0x7f7f7f7f, 0, 0x7f7f7f7f); \
                sx[X_] = d_[(X_) & 3] + dppf<0x39>(d_[((X_) + 1) & 3]) + dppf<0x4E>(d_[((X_) + 2) & 3]) + dppf<0x93>(d_[((X_) + 3) & 3]); } while (0)
#define UA_ITER(b_, SETS_) do { float sx[8]; \
                UA_COMP(0, SETS_[0]); UA_LOAD((b_) + 2, 0, SETS_[0]); UA_COMP(1, SETS_[1]); UA_LOAD((b_) + 2, 1, SETS_[1]); \
                UA_COMP(2, SETS_[2]); UA_LOAD((b_) + 2, 2, SETS_[2]); UA_COMP(3, SETS_[3]); UA_LOAD((b_) + 2, 3, SETS_[3]); \
                UA_COMP(4, SETS_[4]); UA_LOAD((b_) + 2, 4, SETS_[4]); UA_COMP(5, SETS_[5]); UA_LOAD((b_) + 2, 5, SETS_[5]); \
                UA_COMP(6, SETS_[6]); UA_LOAD((b_) + 2, 6, SETS_[6]); UA_COMP(7, SETS_[7]); UA_LOAD((b_) + 2, 7, SETS_[7]); \
                const int l3_ = c & 3; \
                float w0_ = l3_ == 0 ? sx[0] : l3_ == 1 ? sx[1] : l3_ == 2 ? sx[2] : sx[3], w1_ = l3_ == 0 ? sx[4] : l3_ == 1 ? sx[5] : l3_ == 2 ? sx[6] : sx[7]; \
                w0_ = dkeep ? w0_ : 0.f; w1_ = dkeep ? w1_ : 0.f;                    \
                w0_ += dppf<0x124>(w0_); w1_ += dppf<0x124>(w1_); w0_ += dppf<0x128>(w0_); w1_ += dppf<0x128>(w1_);        \
                { const auto sw_ = __builtin_amdgcn_permlane16_swap(f2u(w0_), f2u(w0_), false, false); const unsigned s0_ = sw_[0], s1_ = sw_[1]; w0_ = u2f(s0_) + u2f(s1_); } \
                { const auto sw_ = __builtin_amdgcn_permlane16_swap(f2u(w1_), f2u(w1_), false, false); const unsigned s0_ = sw_[0], s1_ = sw_[1]; w1_ = u2f(s0_) + u2f(s1_); } \
                const float dsel = (c & 4) ? w1_ : w0_;                              \
                  \
                const int wi_ = ((c >> 1) & 3) * 128 + 4 * (b_) + 2 * (c & 1) + (rw >> 1); \
                const unsigned wg_ = SW[wi_]; \
                const float act_ = gelu_erf(dsel * (1.0f / (U6_SCALE * H8_SCALE))) * ((float)(wg_ & 0x3ffffu) * (1.0f / (262143.0f * V6_SCALE))); \
                if (c < 8 && (rw & 1) == 0) AW[wi_] = act_; } while (0)
#pragma unroll
            for (int x_ = 0; x_ < 8; ++x_) UA_LOAD(0, x_, ua[x_]);
#pragma unroll
            for (int x_ = 0; x_ < 8; ++x_) UA_LOAD(1, x_, ub[x_]);
            PV_LOAD(0, 0, sa[0]); PV_LOAD(0, 1, sa[1]); PV_LOAD(0, 2, sa[2]); PV_LOAD(0, 3, sa[3]);
            PV_LOAD(1, 0, sb[0]); PV_LOAD(1, 1, sb[1]); PV_LOAD(1, 2, sb[2]); PV_LOAD(1, 3, sb[3]);
            v8i_t hbT[4];
#pragma unroll
            for (int t_ = 0; t_ < 4; ++t_) {
                const float bs = H8_SCALE / sqrtf(F.SSQ[tbase + t_] * (1.f / D) + NORM_EPS);
#pragma unroll
                for (int q = 0; q < 4; ++q) {
                    const v4u w = hraw[t_][q];
                    int d0 = __builtin_amdgcn_cvt_pk_fp8_f32(H8C(bf_lo(w.x) * bs), H8C(bf_hi(w.x) * bs), 0, false); d0 = __builtin_amdgcn_cvt_pk_fp8_f32(H8C(bf_lo(w.y) * bs), H8C(bf_hi(w.y) * bs), d0, true);
                    int d1 = __builtin_amdgcn_cvt_pk_fp8_f32(H8C(bf_lo(w.z) * bs), H8C(bf_hi(w.z) * bs), 0, false); d1 = __builtin_amdgcn_cvt_pk_fp8_f32(H8C(bf_lo(w.w) * bs), H8C(bf_hi(w.w) * bs), d1, true);
                    hbT[t_][2 * q] = d0; hbT[t_][2 * q + 1] = d1;
                }
            }
#pragma unroll 1
            for (int b = 0; b < 32; b += 2) {
                if ((b & 3) == 0) __builtin_amdgcn_s_barrier();
                UA_ITER(b, ua);
                UA_ITER(b + 1, ub);
            }
#undef UA_LOAD
#undef UA_COMP
#undef UA_ITER
        }
        f32x4 dd[4][4];
#pragma unroll
        for (int t_ = 0; t_ < 4; ++t_)
#pragma unroll
            for (int x_ = 0; x_ < 4; ++x_) dd[t_][x_] = (f32x4){0.f, 0.f, 0.f, 0.f};
        {
            const unsigned selA = 0x0c0c0c0cu ^ (0x0cu << (8 * (c & 3))), selB = selA | (1u << (8 * (c & 3)));
            unsigned mk[2][4];
#pragma unroll
            for (int s_ = 0; s_ < 2; ++s_)
#pragma unroll
                for (int d_ = 0; d_ < 4; ++d_) mk[s_][d_] = ((c >> 2) == d_ && (rw & 1) == s_) ? 0xffffffffu : 0u;
#define PV_COMP(q_, T_, S_) do { const LAS float* ap_ = AW + (T_) * 128 + 4 * (q_) + (rw >> 1); \
                const float a0_ = __builtin_amdgcn_fmed3f(ap_[0] * A8_SCALE, -448.f, 448.f), a1_ = __builtin_amdgcn_fmed3f(ap_[2] * A8_SCALE, -448.f, 448.f); \
                const unsigned w_ = (unsigned)__builtin_amdgcn_cvt_pk_fp8_f32(a0_, a1_, 0, false); \
                const unsigned x0_ = __builtin_amdgcn_perm(w_, w_, selA), x1_ = __builtin_amdgcn_perm(w_, w_, selB); \
                const v8i_t b0_ = {(int)(x0_ & mk[0][0]), (int)(x0_ & mk[0][1]), (int)(x0_ & mk[0][2]), (int)(x0_ & mk[0][3]), (int)(x1_ & mk[0][0]), (int)(x1_ & mk[0][1]), (int)(x1_ & mk[0][2]), (int)(x1_ & mk[0][3])}; \
                const v8i_t b1_ = {(int)(x0_ & mk[1][0]), (int)(x0_ & mk[1][1]), (int)(x0_ & mk[1][2]), (int)(x0_ & mk[1][3]), (int)(x1_ & mk[1][0]), (int)(x1_ & mk[1][1]), (int)(x1_ & mk[1][2]), (int)(x1_ & mk[1][3])}; \
                const v8i_t al_ = {(int)S_.l4.x, (int)S_.l4.y, (int)S_.l4.z, (int)S_.l4.w, V_FP4 ? 0 : (int)S_.l2.x, V_FP4 ? 0 : (int)S_.l2.y, 0, 0}; \
                const v8i_t ah_ = {(int)S_.h4.x, (int)S_.h4.y, (int)S_.h4.z, (int)S_.h4.w, V_FP4 ? 0 : (int)S_.h2.x, V_FP4 ? 0 : (int)S_.h2.y, 0, 0}; \
                __builtin_amdgcn_s_setprio(1); \
                dd[T_][0] = __builtin_amdgcn_mfma_scale_f32_16x16x128_f8f6f4(al_, b0_, dd[T_][0], VFMT, 0, 0, 0x7f7f7f7f, 0, 0x7f7f7f7f); \
                dd[T_][1] = __builtin_amdgcn_mfma_scale_f32_16x16x128_f8f6f4(al_, b1_, dd[T_][1], VFMT, 0, 0, 0x7f7f7f7f, 0, 0x7f7f7f7f); \
                dd[T_][2] = __builtin_amdgcn_mfma_scale_f32_16x16x128_f8f6f4(ah_, b0_, dd[T_][2], VFMT, 0, 0, 0x7f7f7f7f, 0, 0x7f7f7f7f); \
                dd[T_][3] = __builtin_amdgcn_mfma_scale_f32_16x16x128_f8f6f4(ah_, b1_, dd[T_][3], VFMT, 0, 0, 0x7f7f7f7f, 0, 0x7f7f7f7f); __builtin_amdgcn_s_setprio(0); } while (0)
#pragma unroll 1
            for (int q = 0; q < 32; q += 2) {
                if ((q & 3) == 0) __builtin_amdgcn_s_barrier();
                PV_COMP(q, 0, sa[0]); PV_LOAD(q + 2, 0, sa[0]); PV_COMP(q, 1, sa[1]); PV_LOAD(q + 2, 1, sa[1]);
                PV_COMP(q, 2, sa[2]); PV_LOAD(q + 2, 2, sa[2]); PV_COMP(q, 3, sa[3]); PV_LOAD(q + 2, 3, sa[3]);
                PV_COMP(q + 1, 0, sb[0]); PV_LOAD(q + 3, 0, sb[0]); PV_COMP(q + 1, 1, sb[1]); PV_LOAD(q + 3, 1, sb[1]);
                PV_COMP(q + 1, 2, sb[2]); PV_LOAD(q + 3, 2, sb[2]); PV_COMP(q + 1, 3, sb[3]); PV_LOAD(q + 3, 3, sb[3]);
            }
#undef PV_LOAD
#undef PV_COMP
        }
        {
            LAS float* OT = (LAS float*)AT;
            int l2 = lane; asm volatile("" : "+v"(l2));
            u32x2 hw[4][4]; f32x4 wf[4];
#pragma unroll
            for (int t_ = 0; t_ < 4; ++t_)
#pragma unroll
                for (int k = 0; k < 4; ++k) hw[t_][k] = *(const LAS u32x2*)(HS + t_ * 2048 + (256 * k + 4 * l2) * 2);
#pragma unroll
            for (int k = 0; k < 4; ++k) wf[k] = *(const f32x4*)(wfin + 256 * k + 4 * l2);
#pragma unroll
            for (int t_ = 0; t_ < 4; ++t_) {
                const int tok = tbase + t_;
#pragma unroll
                for (int x_ = 0; x_ < 4; ++x_)
#pragma unroll
                    for (int r_ = 0; r_ < 4; ++r_) OT[512 * (x_ >> 1) + 32 * (4 * rw + r_) + 16 * (x_ & 1) + c] = dd[t_][x_][r_];
                f32x4 o[4]; float ss = 0.f;
#pragma unroll
                for (int k = 0; k < 4; ++k) {
                    const f32x4 ov = *(const LAS f32x4*)(OT + 256 * k + 4 * l2);
                    const u32x2 hwk = hw[t_][k];
                    o[k] = (f32x4){ov[0] * (1.0f / A8_SCALE) + bf_lo(hwk.x), ov[1] * (1.0f / A8_SCALE) + bf_hi(hwk.x), ov[2] * (1.0f / A8_SCALE) + bf_lo(hwk.y), ov[3] * (1.0f / A8_SCALE) + bf_hi(hwk.y)};
                    ss += (o[k][0] * o[k][0] + o[k][1] * o[k][1]) + (o[k][2] * o[k][2] + o[k][3] * o[k][3]);
                }
                const float rf = 1.0f / sqrtf(wave_allreduce(ss) * (1.f / D) + NORM_EPS);
#pragma unroll
                for (int k = 0; k < 4; ++k)
                    *(f32x4*)(F.out + (size_t)tok * 1024 + 256 * k + 4 * l2) = (f32x4){o[k][0] * rf * wf[k][0], o[k][1] * rf * wf[k][1], o[k][2] * rf * wf[k][2], o[k][3] * rf * wf[k][3]};
            }
        }
    }
}

#ifndef MK_N_LAUNCHES
#define MK_N_LAUNCHES 1
#endif
constexpr int N_PHASES = 10;
struct Args { const float* in[24]; float* out; unsigned char* ws; int ph_lo, ph_hi; };
__global__ void __launch_bounds__(NWAVES * 64, 2) mega_fwd(Args args) {
    extern __shared__ __attribute__((aligned(16))) unsigned char lds[];
    Frame F;
    F.lds = (LAS unsigned char*)lds;
    F.MISC = (volatile LAS unsigned*)(F.lds + MISC_OFF);
    F.tid = threadIdx.x; F.lane = F.tid & 63; F.wave = __builtin_amdgcn_readfirstlane(F.tid >> 6);
    F.G = gridDim.x; { const int bx = blockIdx.x; F.vcu = (F.G % 8 == 0) ? (bx % 8) * (F.G / 8) + bx / 8 : bx; }
    unsigned char* ws = args.ws;
    F.ctl = (gu32*)(ws + WS_CTL);
#pragma unroll
    for (int i = 0; i < 24; ++i) F.in[i] = args.in[i];
    F.out = args.out;
    F.ROPE = (float*)(ws + WS_ROPE); F.SSQ = (float*)(ws + WS_SSQ);
    F.WIN = (bf16*)(ws + WS_WIN); F.PA = (bf16*)(ws + WS_PA); F.PB = (bf16*)(ws + WS_PB); F.WOUT = (bf16*)(ws + WS_WOUT); F.WQ = (bf16*)(ws + WS_WQ); F.LW = (bf16*)(ws + WS_LW);
    F.SK = (bf16*)(ws + WS_SK); F.U8 = ws + WS_U8; F.V8 = ws + WS_V8; F.XN = (bf16*)(ws + WS_XN); F.LA = (bf16*)(ws + WS_LA); F.YA = (bf16*)(ws + WS_YA);
    F.QKV = (bf16*)(ws + WS_QKV); F.YB = (bf16*)(ws + WS_YB); F.RKV = (bf16*)(ws + WS_RKV); F.HB = (bf16*)(ws + WS_HB); F.LORA = (bf16*)(ws + WS_LORA);
    F.GA = (bf16*)(ws + WS_GA); F.GB = (bf16*)(ws + WS_GB); F.DAG = (bf16*)(ws + WS_DAG); F.QP = (bf16*)(ws + WS_QP);
    F.IDX = (int*)(ws + WS_IDX); F.GATE = (float*)(ws + WS_GATE);
    for (int u = F.tid; u < (LDS_BYTES - LDSCTL_OFF) / 4; u += NWAVES * 64) ((LAS unsigned*)(F.lds + LDSCTL_OFF))[u] = 0u;
    __syncthreads();
    XcdBarrier bar; bar.bar = (unsigned*)(F.ctl + CW_BAR); bar.x = 0; bar.st = nullptr;
    const bool multi = (args.ph_hi - args.ph_lo) > 1;
    if (multi) bar = xcd_barrier_post((unsigned*)(F.ctl + CW_BAR), F.MISC + 8);
    const int lo = args.ph_lo, hi = args.ph_hi;
#ifndef PH_MASK
#define PH_MASK 0x3ff
#endif
#define IN(k) ((((PH_MASK) >> (k)) & 1) && lo <= (k) && (k) < hi)
#define SEAM(k) do { if (IN(k) && IN((k) + 1)) xcd_barrier(bar); } while (0)
    if (IN(0)) { p0_prologue(F); if (DUP_PHASE == 0) p0_prologue(F); }
    SEAM(0);
    if (IN(1)) {
        pg8::Gemm g{F.XN, F.WIN, M, NZ, D}; pg8::StaticOrder S; S.init(M, NZ, F.G, (int)blockIdx.x);
        pg8::EpiZ E{F.QKV, F.RKV, F.LORA, F.GA, F.GB, F.ROPE, QSCALE};
        pg8::gemm_phase<pg8::EpiZ, pg8::StaticOrder, true, true>(F.lds, g, S, E);
        if (DUP_PHASE == 1) pg8::gemm_phase<pg8::EpiZ, pg8::StaticOrder, true, true>(F.lds, g, S, E);
    }
    SEAM(1);
    if (IN(2)) { attn_phase(F); lora_prep_phase(F); if (DUP_PHASE == 2) attn_phase(F); if (DUP_PHASE == 22) lora_prep_phase(F); }
    SEAM(2);
    if (IN(3)) {
#ifndef P3_NO_A
        { pg8::Gemm g{F.LA, F.LW, M, 1536, 384}; pg8::StaticOrder S; S.init(M, 1536, F.G, (int)blockIdx.x);
          pg8::EpiDAG E{F.DAG, F.in[I_W0], F.in[I_A0]};
          pg8::gemm_phase<pg8::EpiDAG, pg8::StaticOrder, true, true>(F.lds, g, S, E);
          if (DUP_PHASE == 3) pg8::gemm_phase<pg8::EpiDAG, pg8::StaticOrder, true, true>(F.lds, g, S, E); }
#endif
#ifndef P3_NO_B
        { pg8::Gemm g{F.YA, F.PA, M, 1024, 512}; pg8::StaticOrder S; S.init(M, 1024, F.G, (int)blockIdx.x);
          pg8::EpiGate<0> E{F.GA, nullptr};
          pg8::gemm_phase<pg8::EpiGate<0>, pg8::StaticOrder, true, true>(F.lds, g, S, E); }
#endif
    }
    SEAM(3);
    if (IN(4)) { scan_phase(F); if (DUP_PHASE == 4) scan_phase(F); }
    SEAM(4);
    if (IN(5)) {
        pg8::Gemm g{F.YB, F.PB, M, 1024, 512}; pg8::StaticOrder S; S.init(M, 1024, F.G, (int)blockIdx.x);
        pg8::EpiGate<1> E{F.GA, F.GB};
        pg8::gemm_phase<pg8::EpiGate<1>, pg8::StaticOrder, true, true>(F.lds, g, S, E);
    }
    SEAM(5);
    if (IN(6)) {
        pg8::Gemm g{F.GA, F.WOUT, M, 1024, 1024}; pg8::StaticOrder S; S.init(M, 1024, F.G, (int)blockIdx.x);
        pg8::EpiH E{F.in[I_X], F.out, F.HB, F.SSQ};
        pg8::gemm_phase<pg8::EpiH, pg8::StaticOrder, true, true>(F.lds, g, S, E);
    }
    SEAM(6);
    if (IN(7)) {
        pg8::Gemm g{F.HB, F.WQ, M, 1024, 1024}; pg8::StaticOrder S; S.init(M, 1024, F.G, (int)blockIdx.x);
        pg8::EpiPlain E{F.QP, 1024};
        pg8::gemm_phase<pg8::EpiPlain, pg8::StaticOrder, true, true>(F.lds, g, S, E);
        if (DUP_PHASE == 7) pg8::gemm_phase<pg8::EpiPlain, pg8::StaticOrder, true, true>(F.lds, g, S, E);
    }
    SEAM(7);
    if (IN(8)) { peer_topk_phase(F); if (DUP_PHASE == 8) peer_topk_phase(F); }
    SEAM(8);
    if (IN(9)) { F.rnd_nloc = multi ? __builtin_amdgcn_readfirstlane((int)F.MISC[8]) : 0; F.rnd_x = __builtin_amdgcn_readfirstlane((int)bar.x); peer_gather_phase(F); if (DUP_PHASE == 9) { F.rnd_nloc = 0; peer_gather_phase(F); } }
#undef IN
#undef SEAM
}

extern "C" void kernel_launch(void* const* d_in, const int* in_sizes, int n_in, void* d_out, int out_size, void* d_ws, size_t ws_size, hipStream_t stream) {
    static int grid = 0;
    if (grid == 0) {
        if (n_in != 24 || in_sizes[0] != M * D || out_size != M * D || ws_size < WS_END) { fprintf(stderr, "kernel_launch: unexpected problem (n_in %d, in0 %d, out %d, ws %zu < %zu); nothing launched\n", n_in, n_in > 0 ? in_sizes[0] : -1, out_size, ws_size, (size_t)WS_END); grid = -1; return; }
        int dev = 0, cus = 0, per_cu = 0;
        if (hipGetDevice(&dev) != hipSuccess || hipDeviceGetAttribute(&cus, hipDeviceAttributeMultiprocessorCount, dev) != hipSuccess) { fprintf(stderr, "kernel_launch: device query failed\n"); grid = -1; return; }
        if (hipFuncSetAttribute((const void*)mega_fwd, hipFuncAttributeMaxDynamicSharedMemorySize, LDS_BYTES) != hipSuccess) { fprintf(stderr, "kernel_launch: hipFuncSetAttribute failed\n"); grid = -1; return; }
        if (hipOccupancyMaxActiveBlocksPerMultiprocessor(&per_cu, (const void*)mega_fwd, NWAVES * 64, LDS_BYTES) != hipSuccess || per_cu < 1)
            fprintf(stderr, "kernel_launch: note: occupancy query reports %d workgroups per CU\n", per_cu);
        (void)hipGetLastError();
        grid = cus;
    }
    if (grid < 0) return;
    if (hipMemsetAsync((char*)d_ws + WS_CTL, 0, CTL_ZERO_BYTES, stream) != hipSuccess) { fprintf(stderr, "kernel_launch: memset failed\n"); return; }
    Args a{};
    for (int i = 0; i < 24; ++i) a.in[i] = (const float*)d_in[i];
    a.out = (float*)d_out; a.ws = (unsigned char*)d_ws;
#if MK_N_LAUNCHES == 1
    a.ph_lo = 0; a.ph_hi = N_PHASES;
    hipLaunchKernelGGL(mega_fwd, dim3(grid), dim3(NWAVES * 64), LDS_BYTES, stream, a);
#else
    for (int p = 0; p < N_PHASES; ++p) { a.ph_lo = p; a.ph_hi = p + 1; hipLaunchKernelGGL(mega_fwd, dim3(grid), dim3(NWAVES * 64), LDS_BYTES, stream, a); }
#endif
    const hipError_t le = hipPeekAtLastError();
    if (le != hipSuccess) fprintf(stderr, "kernel_launch: launch failed: %s\n", hipGetErrorName(le));
}
```
